# Optimizing an MI355X kernel written in HIP

```python
import jax, jax.numpy as jnp
from jax import lax
import numpy as np

D_MODEL = 2048
BATCH = 4
SEQ = 4096
DEPTH = 1

HEAD_DIM = 128
ATTN_WIDTH = D_MODEL // 2
ATTN_HEADS = ATTN_WIDTH // HEAD_DIM
CONV_WIDTH = D_MODEL - ATTN_WIDTH
CONV_GROUPS = CONV_WIDTH // HEAD_DIM
MIX_WIDTH = ATTN_WIDTH + CONV_WIDTH
IN_WIDTH = 3 * ATTN_WIDTH + 2 * CONV_WIDTH
DILATED_PATTERNS = ((128, 1), (512, 4), (2048, 16))
CONV_KERNEL = 31
D_FF = 5632
ROPE_THETA = 10000.0
NORM_EPS = 1e-6
N_MOD = 9
MASK_VALUE = -1e30

kernel_name = "hybrid_dilated_attn_conformer_conv_macaron"


def rms_norm(x, g):
    xf = x.astype(jnp.float32)
    y = xf * lax.rsqrt(jnp.mean(xf * xf, axis=-1, keepdims=True) + NORM_EPS)
    return (y * g.astype(jnp.float32)).astype(x.dtype)


def layer_norm(x, g, b):
    xf = x.astype(jnp.float32)
    mu = jnp.mean(xf, axis=-1, keepdims=True)
    xc = xf - mu
    y = xc * lax.rsqrt(jnp.mean(xc * xc, axis=-1, keepdims=True) + NORM_EPS)
    return (y * g.astype(jnp.float32) + b.astype(jnp.float32)).astype(x.dtype)


def modulate(h, shift, scale):
    return h * (1.0 + scale[:, None, :]) + shift[:, None, :]


def rope(t, pos):
    half = HEAD_DIM // 2
    inv_freq = ROPE_THETA ** (-jnp.arange(half, dtype=jnp.float32) / half)
    ang = pos.astype(jnp.float32)[:, None] * inv_freq[None, :]
    cos = jnp.cos(ang)[None, :, None, :]
    sin = jnp.sin(ang)[None, :, None, :]
    tf = t.astype(jnp.float32)
    t1, t2 = tf[..., :half], tf[..., half:]
    return jnp.concatenate([t1 * cos - t2 * sin, t2 * cos + t1 * sin], axis=-1).astype(t.dtype)


def dilated_window_attention(q, k, v, dilation, n_side):
    B, S, H, Dh = q.shape
    L = S // dilation
    blk = n_side
    nb = -(-L // blk)
    Lp = nb * blk

    def to_classes(t):
        return t.reshape(B, L, dilation, H, Dh).transpose(0, 2, 3, 1, 4)

    qc = jnp.pad(to_classes(q), ((0, 0), (0, 0), (0, 0), (0, Lp - L), (0, 0)))
    qb = qc.reshape(B, dilation, H, nb, blk, Dh)

    def key_blocks(t):
        tp = jnp.pad(to_classes(t), ((0, 0), (0, 0), (0, 0), (blk, Lp - L + blk), (0, 0)))
        tb = tp.reshape(B, dilation, H, nb + 2, blk, Dh)
        return jnp.concatenate([tb[:, :, :, :-2], tb[:, :, :, 1:-1], tb[:, :, :, 2:]], axis=4)

    kb = key_blocks(k)
    vb = key_blocks(v)

    m_q = jnp.arange(nb)[:, None] * blk + jnp.arange(blk)[None, :]
    m_k = jnp.arange(nb)[:, None] * blk - blk + jnp.arange(3 * blk)[None, :]
    rel = m_k[:, None, :] - m_q[:, :, None]
    valid = (jnp.abs(rel) <= n_side) & (m_k[:, None, :] >= 0) & (m_k[:, None, :] < L)

    s = jnp.einsum('bdhnqe,bdhnke->bdhnqk', qb, kb,
                   preferred_element_type=jnp.float32) * (Dh ** -0.5)
    s = jnp.where(valid, s, MASK_VALUE)
    lse = jax.nn.logsumexp(s, axis=-1)
    p = jnp.exp(s - lse[..., None])
    o = jnp.einsum('bdhnqk,bdhnke->bdhnqe', p, vb.astype(jnp.float32))

    o = o.reshape(B, dilation, H, Lp, Dh)[:, :, :, :L]
    o = o.transpose(0, 3, 1, 2, 4).reshape(B, S, H, Dh)
    lse = lse.reshape(B, dilation, H, Lp)[..., :L]
    lse = lse.transpose(0, 3, 1, 2).reshape(B, S, H)
    return o, lse


def swiglu(h, w_gate, w_up, w_down):
    return (jax.nn.silu(h @ w_gate) * (h @ w_up)) @ w_down


def setup_inputs(seed: int = 0) -> dict:
    key = jax.random.key(seed)
    ks = jax.random.split(key, 32)
    f32 = jnp.float32

    def nrm(k, shape, fan_in):
        return jax.random.normal(k, shape, f32) * (fan_in ** -0.5)

    def gain(k, n):
        return 1.0 + 0.01 * jax.random.normal(k, (DEPTH, n), f32)

    def small(k, n):
        return 0.01 * jax.random.normal(k, (DEPTH, n), f32)

    return {
        "x": jax.random.normal(ks[0], (BATCH, SEQ, D_MODEL), f32),
        "c": jax.random.normal(ks[1], (BATCH, D_MODEL), f32),
        "w_ada": nrm(ks[2], (DEPTH, D_MODEL, N_MOD * D_MODEL), D_MODEL),
        "b_ada": small(ks[3], N_MOD * D_MODEL),
        "ffn1_pre_g": gain(ks[4], D_MODEL),
        "ffn1_w_gate": nrm(ks[5], (DEPTH, D_MODEL, D_FF), D_MODEL),
        "ffn1_w_up": nrm(ks[6], (DEPTH, D_MODEL, D_FF), D_MODEL),
        "ffn1_w_down": nrm(ks[7], (DEPTH, D_FF, D_MODEL), D_FF),
        "ffn1_post_g": gain(ks[8], D_MODEL),
        "mix_pre_g": gain(ks[9], D_MODEL),
        "w_in": nrm(ks[10], (DEPTH, D_MODEL, IN_WIDTH), D_MODEL),
        "conv_w": nrm(ks[11], (DEPTH, CONV_KERNEL, CONV_WIDTH), CONV_KERNEL),
        "conv_b": small(ks[12], CONV_WIDTH),
        "conv_ln_g": gain(ks[13], CONV_WIDTH),
        "conv_ln_b": small(ks[14], CONV_WIDTH),
        "attn_out_g": gain(ks[15], ATTN_WIDTH),
        "conv_out_g": gain(ks[16], CONV_WIDTH),
        "w_out": nrm(ks[17], (DEPTH, MIX_WIDTH, D_MODEL), MIX_WIDTH),
        "mix_post_g": gain(ks[18], D_MODEL),
        "ffn2_pre_g": gain(ks[19], D_MODEL),
        "ffn2_w_gate": nrm(ks[20], (DEPTH, D_MODEL, D_FF), D_MODEL),
        "ffn2_w_up": nrm(ks[21], (DEPTH, D_MODEL, D_FF), D_MODEL),
        "ffn2_w_down": nrm(ks[22], (DEPTH, D_FF, D_MODEL), D_FF),
        "ffn2_post_g": gain(ks[23], D_MODEL),
    }


def reference(x, c, w_ada, b_ada, ffn1_pre_g, ffn1_w_gate, ffn1_w_up, ffn1_w_down,
              ffn1_post_g, mix_pre_g, w_in, conv_w, conv_b, conv_ln_g, conv_ln_b,
              attn_out_g, conv_out_g, w_out, mix_post_g, ffn2_pre_g, ffn2_w_gate,
              ffn2_w_up, ffn2_w_down, ffn2_post_g):
    B, S, D = x.shape
    pos = jnp.arange(S, dtype=jnp.int32)
    c_act = jax.nn.silu(c)

    for l in range(DEPTH):
        mod = c_act @ w_ada[l] + b_ada[l]
        (sh1, sc1, g1, sh2, sc2, g2, sh3, sc3, g3) = jnp.split(mod, N_MOD, axis=-1)

        h = modulate(rms_norm(x, ffn1_pre_g[l]), sh1, sc1)
        f = swiglu(h, ffn1_w_gate[l], ffn1_w_up[l], ffn1_w_down[l])
        x = x + 0.5 * g1[:, None, :] * rms_norm(f, ffn1_post_g[l])

        h = modulate(rms_norm(x, mix_pre_g[l]), sh2, sc2)
        proj = h @ w_in[l]
        q, k, v, c_val, c_gate = jnp.split(
            proj, [ATTN_WIDTH, 2 * ATTN_WIDTH, 3 * ATTN_WIDTH, 3 * ATTN_WIDTH + CONV_WIDTH],
            axis=-1)
        q = rope(q.reshape(B, S, ATTN_HEADS, HEAD_DIM), pos)
        k = rope(k.reshape(B, S, ATTN_HEADS, HEAD_DIM), pos)
        v = v.reshape(B, S, ATTN_HEADS, HEAD_DIM)

        outs, lses = [], []
        for window, dilation in DILATED_PATTERNS:
            o_i, lse_i = dilated_window_attention(q, k, v, dilation, window // (2 * dilation))
            outs.append(o_i)
            lses.append(lse_i)
        wts = jax.nn.softmax(jnp.stack(lses, axis=0), axis=0)
        attn = jnp.einsum('pbsh,pbshe->bshe', wts, jnp.stack(outs, axis=0))
        attn = attn.reshape(B, S, ATTN_WIDTH).astype(x.dtype)

        u = c_val * jax.nn.sigmoid(c_gate)
        u = lax.conv_general_dilated(
            u, conv_w[l][:, None, :].astype(u.dtype), window_strides=(1,),
            padding=[((CONV_KERNEL - 1) // 2, (CONV_KERNEL - 1) // 2)],
            dimension_numbers=('NWC', 'WIO', 'NWC'),
            feature_group_count=CONV_WIDTH) + conv_b[l]
        u = jax.nn.silu(layer_norm(u, conv_ln_g[l], conv_ln_b[l]))

        merged = jnp.concatenate([rms_norm(attn, attn_out_g[l]),
                                  rms_norm(u, conv_out_g[l])], axis=-1) @ w_out[l]
        x = x + g2[:, None, :] * rms_norm(merged, mix_post_g[l])

        h = modulate(rms_norm(x, ffn2_pre_g[l]), sh3, sc3)
        f = swiglu(h, ffn2_w_gate[l], ffn2_w_up[l], ffn2_w_down[l])
        x = x + 0.5 * g3[:, None, :] * rms_norm(f, ffn2_post_g[l])

    return x
```

```cpp
#include <hip/hip_runtime.h>
#include <hip/hip_cooperative_groups.h>
#include <cstdio>
#include <cstdint>
namespace cg = cooperative_groups;
namespace pg8 {
#define PG8_LAS __attribute__((address_space(3)))
typedef unsigned short bf16_t;
typedef short bf16x8 __attribute__((ext_vector_type(8)));
typedef float f32x4 __attribute__((ext_vector_type(4)));
typedef unsigned u32x4 __attribute__((ext_vector_type(4)));
constexpr int BM = 256, BK = 64, HALF = 128, HTB = HALF * BK * 2  , STAGE_BYTES = 8 * HTB, NXCD = 8, WGM = 8;

__host__ __device__ __forceinline__ int lds_byte(int r, int c) { const int st = (r >> 4) * 2 + (c >> 5), rr = r & 15, cc = c & 31, ob = rr * 64 + cc * 2; return st * 1024 + (ob ^ (((ob >> 9) & 1) << 5)); }
__host__ __device__ __forceinline__ void stage_rc(int b, int& R, int& C) { const int st = b / 1024, sb = b % 1024, swz = sb ^ (((sb >> 9) & 1) << 5); R = (st >> 1) * 16 + swz / 64; C = (st & 1) * 32 + (swz % 64) / 2; }
__host__ __device__ __forceinline__ int perm32(int rho) { const int n = rho >> 4, i = rho & 15; return 8 * (i >> 2) + 4 * n + (i & 3); }

struct Unit { int pm, pn; };
struct Gemm { const bf16_t* A; const bf16_t* Bt; int M, N, K; };

struct StaticOrder {
    int nM, nN, nwg, G, c, wg = WGM;
    __host__ __device__ void init(int M, int N, int G_, int c_) { nM = M / BM; nN = N / BM; nwg = nM * nN; G = G_; c = c_; }
    __host__ __device__ bool next(int i, Unit& u) const {
        const long L = (long)i * G + c; if (L >= nwg) return false;
        int wgid = (int)L; { const int q = nwg / NXCD, r = nwg % NXCD, xcd = wgid % NXCD, off = wgid / NXCD; wgid = (xcd < r ? xcd * (q + 1) : r * (q + 1) + (xcd - r) * q) + off; }
        const int nig = wg * nN, gid = wgid / nig, fm = gid * wg, gsz = (nM - fm) < wg ? (nM - fm) : wg;
        u.pm = fm + ((wgid % nig) % gsz); u.pn = (wgid % nig) / gsz; return true;
    }
    __device__ __forceinline__ void a_ready(const Unit&) const {}
    __device__ __forceinline__ void done(const Unit&) const {}
};

typedef float f32x2_t __attribute__((ext_vector_type(2)));
typedef __bf16 bf16x2_t __attribute__((ext_vector_type(2)));
__device__ __forceinline__ unsigned pk_bf16(float lo, float hi) { f32x2_t v = {lo, hi}; bf16x2_t b = __builtin_convertvector(v, bf16x2_t); return __builtin_bit_cast(unsigned, b); }
__device__ __forceinline__ float sigmoid_f(float x) { return __builtin_amdgcn_rcpf(1.0f + __builtin_amdgcn_exp2f(-1.44269504089f * x)); }
typedef unsigned u32x2 __attribute__((ext_vector_type(2)));

template <int MODE> __device__ __forceinline__ void epi_glu_store(const f32x4 (&acc)[2][2][4][2], bf16_t* O, int ldc, int row0, int col0) {
#pragma unroll
    for (int ai = 0; ai < 2; ++ai)
#pragma unroll
        for (int m = 0; m < 4; ++m) {
            bf16_t* rowp = O + (size_t)(row0 + ai * HALF + m * 16) * ldc + col0;
            float r[8];
#pragma unroll
            for (int n = 0; n < 2; ++n)
#pragma unroll
                for (int e = 0; e < 4; ++e) { const float a = acc[ai][0][m][n][e], b = acc[ai][1][m][n][e];
                    r[4 * n + e] = (MODE == 0) ? (a * sigmoid_f(a)) * b : a * sigmoid_f(b); }
            u32x4 w; w.x = pk_bf16(r[0], r[1]); w.y = pk_bf16(r[2], r[3]); w.z = pk_bf16(r[4], r[5]); w.w = pk_bf16(r[6], r[7]);
            *(u32x4*)rowp = w; }
}
__device__ __forceinline__ void epi_plain_store(const f32x4 (&acc)[2][2][4][2], bf16_t* O, int ldc, int row0, int col0) {
#pragma unroll
    for (int ai = 0; ai < 2; ++ai)
#pragma unroll
        for (int m = 0; m < 4; ++m) {
            bf16_t* rowp = O + (size_t)(row0 + ai * HALF + m * 16) * ldc + col0;
#pragma unroll
            for (int bj = 0; bj < 2; ++bj) { const f32x4 v0 = acc[ai][bj][m][0], v1 = acc[ai][bj][m][1];
                u32x4 w; w.x = pk_bf16(v0[0], v0[1]); w.y = pk_bf16(v0[2], v0[3]); w.z = pk_bf16(v1[0], v1[1]); w.w = pk_bf16(v1[2], v1[3]);
                *(u32x4*)(rowp + bj * HALF) = w; } }
}
struct EpiSwiGLU {
    static constexpr bool PERM = false, AFTER_DRAIN = false;
    bf16_t* O; int ldc;
    __device__ __forceinline__ void operator()(const f32x4 (&acc)[2][2][4][2], const Unit& u, int wr, int wc, int fr, int fq) const {
        epi_glu_store<0>(acc, O, ldc, u.pm * BM + wr * 64 + fr, u.pn * HALF + wc * 32 + 8 * fq);
    }
};
struct EpiPlain {
    static constexpr bool PERM = false, AFTER_DRAIN = false;
    bf16_t* O; int ldc;
    __device__ __forceinline__ void operator()(const f32x4 (&acc)[2][2][4][2], const Unit& u, int wr, int wc, int fr, int fq) const {
        epi_plain_store(acc, O, ldc, u.pm * BM + wr * 64 + fr, u.pn * BM + wc * 32 + 8 * fq);
    }
};
struct EpiIn {
    static constexpr bool PERM = false, AFTER_DRAIN = false;
    bf16_t *Q, *K, *V, *U; const float* rope;
    float qscale;
    __device__ __forceinline__ void operator()(const f32x4 (&acc)[2][2][4][2], const Unit& u, int wr, int wc, int fr, int fq) const {
        const int row0 = u.pm * BM + wr * 64 + fr;
        if (u.pn >= 12) { epi_glu_store<1>(acc, U, 1024, row0, (u.pn - 12) * HALF + wc * 32 + 8 * fq); return; }
        if (u.pn >= 8) { epi_plain_store(acc, V, 1024, row0, (u.pn - 8) * BM + wc * 32 + 8 * fq); return; }
        const bool isq = u.pn < 4; bf16_t* base = isq ? Q : K; const float sc = isq ? qscale : 1.0f;
        const int d0 = 16 * wc + 4 * fq;
#pragma unroll
        for (int ai = 0; ai < 2; ++ai)
#pragma unroll
            for (int m = 0; m < 4; ++m) { const int row = row0 + ai * HALF + m * 16, pos = row & 4095;
                const f32x4 cs0 = *(const f32x4*)(rope + ((size_t)pos * 64 + d0) * 2), cs1 = *(const f32x4*)(rope + ((size_t)pos * 64 + d0) * 2 + 4);
                const float c[4] = {cs0[0], cs0[2], cs1[0], cs1[2]}, s[4] = {cs0[1], cs0[3], cs1[1], cs1[3]};
#pragma unroll
                for (int bj = 0; bj < 2; ++bj) { const int head = 2 * (u.pn & 3) + bj; bf16_t* p = base + (size_t)row * 1024 + head * 128 + d0;
                    float o1[4], o2[4];
#pragma unroll
                    for (int e = 0; e < 4; ++e) { const float t1 = acc[ai][bj][m][0][e], t2 = acc[ai][bj][m][1][e]; o1[e] = (t1 * c[e] - t2 * s[e]) * sc; o2[e] = (t2 * c[e] + t1 * s[e]) * sc; }
                    u32x2 w1, w2; w1.x = pk_bf16(o1[0], o1[1]); w1.y = pk_bf16(o1[2], o1[3]); w2.x = pk_bf16(o2[0], o2[1]); w2.y = pk_bf16(o2[2], o2[3]);
                    *(u32x2*)p = w1; *(u32x2*)(p + 64) = w2; } }
    }
};

template <class Epi, class Sched, bool ALIGN_EPI = false, bool SP2 = false>
__device__ __forceinline__ void gemm_phase(PG8_LAS unsigned char* lds, const Gemm g, const Sched& S, const Epi& E) {
    const int tid = threadIdx.x, wid = __builtin_amdgcn_readfirstlane(tid >> 6), lane = tid & 63, wr = wid >> 2, wc = wid & 3, fr = lane & 15, fq = lane >> 4;
    const int K = g.K, nt = K / BK;
    unsigned voffA[2], voffB[2];
#pragma unroll
    for (int i = 0; i < 2; ++i) { int R, C; stage_rc(tid * 16 + i * 8192, R, C); const int Rb = Epi::PERM ? ((R & ~31) + perm32(R & 31)) : R;
        voffA[i] = (unsigned)(R * K + C) * 2u; voffB[i] = (unsigned)(Rb * K + C) * 2u; }
    const size_t kstep = (size_t)(BK * 2);
    const size_t hstep = (size_t)HALF * K * 2;
    const size_t tstep = 2 * hstep;
    const unsigned ldsw = (unsigned)wid * 1024u;
    const int aoff = lds_byte(wr * 64 + fr, fq * 8), boff = lds_byte(wc * 32 + fr, fq * 8);
#define PG8_SA(b, h) (((b) * 2 + (h)) * HTB)
#define PG8_SB(b, h) ((4 + (b) * 2 + (h)) * HTB)
#define PG8_STAGE(bufoff, gbase, voff) do { _Pragma("unroll") for (int _i = 0; _i < 2; ++_i) \
        __builtin_amdgcn_global_load_lds((const unsigned*)((const char*)(gbase) + (voff)[_i]), (PG8_LAS unsigned*)(lds + (bufoff) + ldsw + _i * 8192), 16, 0, 0); } while (0)
#define PG8_LDA(dst, b, h) do { _Pragma("unroll") for (int m = 0; m < 4; ++m) _Pragma("unroll") for (int k = 0; k < 2; ++k) dst[m][k] = *(const PG8_LAS bf16x8*)(lds + PG8_SA(b, h) + aoff + m * 2048 + k * 1024); } while (0)
#define PG8_LDB(dst, b, h) do { _Pragma("unroll") for (int n = 0; n < 2; ++n) _Pragma("unroll") for (int k = 0; k < 2; ++k) dst[n][k] = *(const PG8_LAS bf16x8*)(lds + PG8_SB(b, h) + boff + n * 2048 + k * 1024); } while (0)
#define PG8_MMA(ai, bj, At, Bt) do { __builtin_amdgcn_s_setprio(1); _Pragma("unroll") for (int m = 0; m < 4; ++m) _Pragma("unroll") for (int n = 0; n < 2; ++n) _Pragma("unroll") for (int k = 0; k < 2; ++k) \
        acc[ai][bj][m][n] = __builtin_amdgcn_mfma_f32_16x16x32_bf16(Bt[n][k], At[m][k], acc[ai][bj][m][n], 0, 0, 0); __builtin_amdgcn_s_setprio(0); } while (0)
#define PG8_WAIT_V(n) asm volatile("s_waitcnt vmcnt(" #n ")" ::: "memory")
#define PG8_WAIT_L(n) asm volatile("s_waitcnt lgkmcnt(" #n ")" ::: "memory")
#define PG8_BAR __builtin_amdgcn_s_barrier()
#define PG8_SCHED __builtin_amdgcn_sched_barrier(0)
    Unit cur, nxt; int ui = 0;
    if (!S.next(0, cur)) return;
    f32x4 acc[2][2][4][2];
#pragma unroll
    for (int a = 0; a < 2; ++a)
#pragma unroll
        for (int b = 0; b < 2; ++b)
#pragma unroll
            for (int m = 0; m < 4; ++m)
#pragma unroll
                for (int n = 0; n < 2; ++n) acc[a][b][m][n] = (f32x4){0.f, 0.f, 0.f, 0.f};
    bf16x8 At[4][2], B0[2][2], B1[2][2];
    const char* cA = (const char*)g.A + (size_t)cur.pm * tstep; const char* cB = (const char*)g.Bt + (size_t)cur.pn * tstep;
    S.a_ready(cur);
    if constexpr (SP2) {
        PG8_STAGE(PG8_SB(0, 0), cB, voffB); PG8_STAGE(PG8_SB(0, 1), cB + hstep, voffB); PG8_STAGE(PG8_SA(0, 0), cA, voffA); PG8_STAGE(PG8_SA(0, 1), cA + hstep, voffA);
        if (wr == 1) PG8_BAR;
        PG8_WAIT_V(2); PG8_BAR;
        PG8_STAGE(PG8_SB(1, 0), cB + kstep, voffB); PG8_STAGE(PG8_SA(1, 0), cA + kstep, voffA); PG8_STAGE(PG8_SB(1, 1), cB + hstep + kstep, voffB);
        PG8_WAIT_V(6); PG8_BAR;
    } else {
        PG8_STAGE(PG8_SB(0, 0), cB, voffB); PG8_STAGE(PG8_SA(0, 0), cA, voffA); PG8_STAGE(PG8_SB(0, 1), cB + hstep, voffB); PG8_STAGE(PG8_SA(0, 1), cA + hstep, voffA);
        if (wr == 1) PG8_BAR;
        PG8_WAIT_V(4); PG8_BAR;
        PG8_STAGE(PG8_SB(1, 0), cB + kstep, voffB); PG8_STAGE(PG8_SA(1, 0), cA + kstep, voffA); PG8_STAGE(PG8_SB(1, 1), cB + hstep + kstep, voffB);
        PG8_WAIT_V(6); PG8_BAR;
    }
    for (;;) {
        const bool has_next = S.next(ui + 1, nxt);
        const char* nA = has_next ? (const char*)g.A + (size_t)nxt.pm * tstep : cA; const char* nB = has_next ? (const char*)g.Bt + (size_t)nxt.pn * tstep : cB;
        for (int t = 0; t < nt; t += 2) {
            const bool last = (t == nt - 2);
            const char* a1 = cA + (size_t)(t + 1) * kstep;
            const char* a2 = last ? nA : cA + (size_t)(t + 2) * kstep; const char* b2 = last ? nB : cB + (size_t)(t + 2) * kstep;
            const char* a3 = a2 + kstep; const char* b3 = b2 + kstep;
            if (last && has_next) S.a_ready(nxt);
            if constexpr (SP2) {
            PG8_LDB(B0, 0, 0); PG8_LDB(B1, 0, 1); PG8_SCHED; PG8_LDA(At, 0, 0); PG8_STAGE(PG8_SA(1, 1), a1 + hstep, voffA);
            PG8_WAIT_V(8); PG8_WAIT_L(0); PG8_BAR; PG8_MMA(0, 0, At, B0); PG8_MMA(0, 1, At, B1); PG8_BAR; PG8_SCHED;
            PG8_LDA(At, 0, 1); PG8_STAGE(PG8_SB(0, 0), b2, voffB); PG8_STAGE(PG8_SB(0, 1), b2 + hstep, voffB); PG8_STAGE(PG8_SA(0, 0), a2, voffA);
            PG8_WAIT_V(8); PG8_WAIT_L(0); PG8_BAR; PG8_MMA(1, 0, At, B0); PG8_MMA(1, 1, At, B1); PG8_BAR; PG8_SCHED;
            PG8_LDB(B0, 1, 0); PG8_LDB(B1, 1, 1); PG8_SCHED; PG8_LDA(At, 1, 0); PG8_STAGE(PG8_SA(0, 1), a2 + hstep, voffA);
            PG8_WAIT_V(8); PG8_WAIT_L(0); PG8_BAR; PG8_MMA(0, 0, At, B0); PG8_MMA(0, 1, At, B1); PG8_BAR; PG8_SCHED;
            PG8_LDA(At, 1, 1); PG8_STAGE(PG8_SB(1, 0), b3, voffB); PG8_STAGE(PG8_SB(1, 1), b3 + hstep, voffB); PG8_STAGE(PG8_SA(1, 0), a3, voffA);
            PG8_WAIT_V(8); PG8_WAIT_L(0); PG8_BAR; PG8_MMA(1, 0, At, B0); PG8_MMA(1, 1, At, B1); PG8_BAR; PG8_SCHED;
            } else {
            PG8_LDB(B0, 0, 0); PG8_SCHED; PG8_LDA(At, 0, 0); PG8_STAGE(PG8_SA(1, 1), a1 + hstep, voffA);
            PG8_WAIT_L(8); PG8_BAR; PG8_WAIT_L(0); PG8_MMA(0, 0, At, B0); PG8_BAR; PG8_SCHED;
            PG8_LDB(B1, 0, 1); PG8_STAGE(PG8_SB(0, 0), b2, voffB);
            PG8_BAR; PG8_WAIT_L(0); PG8_MMA(0, 1, At, B1); PG8_BAR;
            PG8_LDA(At, 0, 1); PG8_STAGE(PG8_SA(0, 0), a2, voffA);
            PG8_BAR; PG8_WAIT_L(0); PG8_MMA(1, 0, At, B0); PG8_BAR; PG8_SCHED;
            PG8_STAGE(PG8_SB(0, 1), b2 + hstep, voffB);
            PG8_WAIT_V(6); PG8_BAR; PG8_MMA(1, 1, At, B1); PG8_BAR;
            PG8_LDB(B0, 1, 0); PG8_SCHED; PG8_LDA(At, 1, 0); PG8_STAGE(PG8_SA(0, 1), a2 + hstep, voffA);
            PG8_WAIT_L(8); PG8_BAR; PG8_WAIT_L(0); PG8_MMA(0, 0, At, B0); PG8_BAR; PG8_SCHED;
            PG8_LDB(B1, 1, 1); PG8_STAGE(PG8_SB(1, 0), b3, voffB);
            PG8_BAR; PG8_WAIT_L(0); PG8_MMA(0, 1, At, B1); PG8_BAR;
            PG8_LDA(At, 1, 1); PG8_STAGE(PG8_SA(1, 0), a3, voffA);
            PG8_BAR; PG8_WAIT_L(0); PG8_MMA(1, 0, At, B0); PG8_BAR; PG8_SCHED;
            PG8_STAGE(PG8_SB(1, 1), b3 + hstep, voffB);
            PG8_WAIT_V(6); PG8_BAR; PG8_MMA(1, 1, At, B1); PG8_BAR;
            }
        }
        if constexpr (ALIGN_EPI) { if (wr == 0) PG8_BAR; }
        if constexpr (!Epi::AFTER_DRAIN) { E(acc, cur, wr, wc, fr, fq); S.done(cur); }
        if (!has_next) break;
#pragma unroll
        for (int a = 0; a < 2; ++a)
#pragma unroll
            for (int b = 0; b < 2; ++b)
#pragma unroll
                for (int m = 0; m < 4; ++m)
#pragma unroll
                    for (int n = 0; n < 2; ++n) acc[a][b][m][n] = (f32x4){0.f, 0.f, 0.f, 0.f};
        cur = nxt; cA = nA; cB = nB; ++ui;
        if constexpr (ALIGN_EPI) { if (wr == 1) PG8_BAR; }
    }
    PG8_WAIT_V(0);
    if constexpr (!ALIGN_EPI) { if (wr == 0) PG8_BAR; }
    PG8_BAR;
    if constexpr (Epi::AFTER_DRAIN) { E.fused(acc, cur, wr, wc, fr, fq, lds, wid, lane); S.done(cur); }
#undef PG8_SA
#undef PG8_SB
#undef PG8_STAGE
#undef PG8_LDA
#undef PG8_LDB
#undef PG8_MMA
#undef PG8_WAIT_V
#undef PG8_WAIT_L
#undef PG8_BAR
#undef PG8_SCHED
}
}

#define LAS __attribute__((address_space(3)))
typedef unsigned short bf16;
typedef float f32x4 __attribute__((ext_vector_type(4)));
typedef unsigned u32x4 __attribute__((ext_vector_type(4)));
typedef unsigned u32x2 __attribute__((ext_vector_type(2)));
typedef short bf16x8 __attribute__((ext_vector_type(8)));
typedef short s16x4 __attribute__((ext_vector_type(4)));
typedef float f32x2 __attribute__((ext_vector_type(2)));
constexpr int NB = 4, SEQ = 4096, DM = 2048, MT = NB * SEQ, DFF = 5632, NGU = 2 * DFF, NIN = 5120, AW = 1024, NH = 8, NMOD = 9 * DM, CK = 31;
constexpr float EPS = 1e-6f;
constexpr int NTHR = 512, NWAVES = 8;
#ifndef WG_GU
#define WG_GU 2
#endif
#ifndef WG_DN
#define WG_DN 4
#endif
#ifndef WG_IN
#define WG_IN 2
#endif
constexpr int KSPLIT = 28, NCG = NMOD / 4;
constexpr size_t MiB = 1u << 20;
constexpr size_t WS_MODP = 0, WS_MOD = 8 * MiB, WS_CTL = 8 * MiB + 512 * 1024, CTL_BYTES = 16384, WS_ROPE = 9 * MiB;
constexpr size_t WS_WGU1 = 12 * MiB, WS_WD1 = 56 * MiB, WS_WIN = 78 * MiB, WS_WOUT = 98 * MiB, WS_WGU2 = 106 * MiB, WS_WD2 = 150 * MiB;
constexpr size_t WS_H = 172 * MiB, WS_F = 236 * MiB, WS_ACT = 300 * MiB;
constexpr size_t WS_Q = 300 * MiB, WS_K = 332 * MiB, WS_V = 364 * MiB, WS_U = 396 * MiB;
constexpr size_t WS_O = 476 * MiB, WS_LSE = 572 * MiB, WS_END = 574 * MiB;
static_assert((size_t)KSPLIT * 4 * NMOD * 4 <= 8 * MiB && WS_ACT + (size_t)MT * DFF * 2 <= WS_O && WS_U + 32 * MiB <= WS_O, "ws map");
constexpr int LDS_BYTES = 147456;

struct Args { const float* in[24]; float* out; unsigned char* ws; };
enum { I_X = 0, I_C, I_WADA, I_BADA, I_F1PRE, I_F1G, I_F1U, I_F1D, I_F1POST, I_MIXPRE, I_WIN, I_CONVW, I_CONVB, I_LNG, I_LNB, I_AOG, I_COG, I_WOUT, I_MIXPOST, I_F2PRE, I_F2G, I_F2U, I_F2D, I_F2POST };

__device__ __forceinline__ unsigned pk2(float lo, float hi) { return pg8::pk_bf16(lo, hi); }
__device__ __forceinline__ float bf_lo(unsigned w) { return __builtin_bit_cast(float, w << 16); }
__device__ __forceinline__ float bf_hi(unsigned w) { return __builtin_bit_cast(float, w & 0xffff0000u); }
__device__ __forceinline__ float wave_sum(float v) {
#pragma unroll
    for (int o = 1; o < 64; o <<= 1) v += __shfl_xor(v, o);
    return v;
}

__device__ __forceinline__ int inv_perm32(int hc) { return 16 * ((hc >> 2) & 1) + 4 * (hc >> 3) + (hc & 3); }
__device__ __forceinline__ int dest_row(int kind, int n) {
    if (kind == 0 || kind == 1) return 256 * (n >> 7) + 128 * kind + 32 * ((n & 127) >> 5) + inv_perm32(n & 31);
    if (kind == 2) return (n & ~31) + inv_perm32(n & 31);
    if (n < 2048) { const int sec = n >> 10, hh = (n >> 7) & 7, cc = n & 127, nn = cc >> 6, d = cc & 63; return sec * 1024 + hh * 128 + 32 * (d >> 4) + 16 * nn + (d & 15); }
    if (n < 3072) return (n & ~31) + inv_perm32(n & 31);
    { const int chn = (n - 3072) & 1023, isg = (n >= 4096) ? 1 : 0; return 3072 + 256 * (chn >> 7) + 128 * isg + 32 * ((chn & 127) >> 5) + inv_perm32(chn & 31); }
}
struct TrItem { const float* W; bf16* WT; int K, N, kind, kb, nb; };
__device__ __forceinline__ TrItem tr_decode(const Args& a, int it) {
    constexpr int IT_G = (DM / 64) * (DFF / 64), IT_IN = (DM / 64) * (NIN / 64), IT_OUT = (DM / 64) * (DM / 64);
    unsigned char* ws = a.ws; TrItem t; int r = it;
    auto ffn = [&](int r2, const float* g, const float* u, const float* d, size_t wgu, size_t wd) {
        const int w = r2 / IT_G; const int q = r2 - w * IT_G;
        if (w == 0) { t.W = g; t.WT = (bf16*)(ws + wgu); t.K = DM; t.N = DFF; t.kind = 0; t.kb = q / (DFF / 64); t.nb = q % (DFF / 64); }
        else if (w == 1) { t.W = u; t.WT = (bf16*)(ws + wgu); t.K = DM; t.N = DFF; t.kind = 1; t.kb = q / (DFF / 64); t.nb = q % (DFF / 64); }
        else { t.W = d; t.WT = (bf16*)(ws + wd); t.K = DFF; t.N = DM; t.kind = 2; t.kb = q / (DM / 64); t.nb = q % (DM / 64); } };
    if (r < 3 * IT_G) { ffn(r, a.in[I_F1G], a.in[I_F1U], a.in[I_F1D], WS_WGU1, WS_WD1); return t; }
    r -= 3 * IT_G;
    if (r < IT_IN) { t.W = a.in[I_WIN]; t.WT = (bf16*)(ws + WS_WIN); t.K = DM; t.N = NIN; t.kind = 3; t.kb = r / (NIN / 64); t.nb = r % (NIN / 64); return t; }
    r -= IT_IN;
    if (r < IT_OUT) { t.W = a.in[I_WOUT]; t.WT = (bf16*)(ws + WS_WOUT); t.K = DM; t.N = DM; t.kind = 2; t.kb = r / (DM / 64); t.nb = r % (DM / 64); return t; }
    r -= IT_OUT;
    ffn(r, a.in[I_F2G], a.in[I_F2U], a.in[I_F2D], WS_WGU2, WS_WD2); return t;
}
__device__ __forceinline__ void tr_load(const TrItem& t, f32x4 (&v)[16], int lane) {
    const int lr = lane >> 4, lc = lane & 15;
    const f32x4* src = (const f32x4*)(t.W + (size_t)(64 * t.kb + lr) * t.N + 64 * t.nb) + lc;
#pragma unroll
    for (int i = 0; i < 16; ++i) v[i] = __builtin_nontemporal_load(src + (size_t)i * t.N);
}
__device__ __forceinline__ void tr_store(const TrItem& t, const f32x4 (&v)[16], LAS float* scr, int lane) {
    const int k0 = 64 * t.kb, n0 = 64 * t.nb, lr = lane >> 4, lc = lane & 15;
#pragma unroll
    for (int i = 0; i < 16; ++i) { LAS float* d = scr + (4 * i + lr) * 65 + 4 * lc; d[0] = v[i][0]; d[1] = v[i][1]; d[2] = v[i][2]; d[3] = v[i][3]; }
    const int c = lane & 7;
#pragma unroll
    for (int j = 0; j < 8; ++j) { const int nn = (lane >> 3) + 8 * j; const LAS float* s = scr + (8 * c) * 65 + nn;
        u32x4 o; o.x = pk2(s[0], s[65]); o.y = pk2(s[2 * 65], s[3 * 65]); o.z = pk2(s[4 * 65], s[5 * 65]); o.w = pk2(s[6 * 65], s[7 * 65]);
        const int dr = dest_row(t.kind, n0 + nn);
        *(u32x4*)(t.WT + (size_t)dr * t.K + k0 + 8 * c) = o; }
}
__device__ __forceinline__ void p0_prologue(const Args& a, LAS unsigned char* lds, int tid, int lane, int wave) {
    unsigned char* ws = a.ws;
    const int gtid = blockIdx.x * NTHR + tid, gw = blockIdx.x * NWAVES + wave, NGT = gridDim.x * NTHR, NGW = gridDim.x * NWAVES;
    {
        LAS float* cact = (LAS float*)lds;
        for (int i = tid; i < NB * DM; i += NTHR) { const int b = i >> 11, k = i & 2047; const float v = a.in[I_C][i]; cact[k * 4 + b] = v / (1.0f + __expf(-v)); }
        __syncthreads();
        float* part = (float*)(ws + WS_MODP);
        for (int t = gtid; t < NCG * KSPLIT; t += NGT) {
            const int ks = t / NCG, cgp = t % NCG, k0 = ks * DM / KSPLIT, k1 = (ks + 1) * DM / KSPLIT;
            const f32x4* W = (const f32x4*)a.in[I_WADA] + cgp;
            f32x4 acc0 = {0, 0, 0, 0}, acc1 = acc0, acc2 = acc0, acc3 = acc0;
#pragma unroll 8
            for (int k = k0; k < k1; ++k) { const f32x4 w = __builtin_nontemporal_load(W + (size_t)k * NCG); const f32x4 cv = *(const LAS f32x4*)(cact + 4 * k);
                acc0 += w * cv[0]; acc1 += w * cv[1]; acc2 += w * cv[2]; acc3 += w * cv[3]; }
            f32x4* pp = (f32x4*)(part + (size_t)ks * 4 * NMOD) + cgp;
            pp[0] = acc0; pp[NCG] = acc1; pp[2 * NCG] = acc2; pp[3 * NCG] = acc3;
        }
        __syncthreads();
    }
    {
        float* tab = (float*)(ws + WS_ROPE);
        for (int i = gtid; i < SEQ * 64; i += NGT) { const int pos = i >> 6, f = i & 63; const float inv = powf(10000.0f, -(float)f * (1.0f / 64.0f)); const float ang = (float)pos * inv;
            float sn, cs; sincosf(ang, &sn, &cs); tab[2 * i] = cs; tab[2 * i + 1] = sn; }
    }
    {
        LAS float* scr = (LAS float*)(lds + wave * 16640);
        constexpr int NITEMS = 6 * (DM / 64) * (DFF / 64) + (DM / 64) * (NIN / 64) + (DM / 64) * (DM / 64);
        int it = gw;
        if (it < NITEMS) {
            f32x4 va[16], vb[16];
            TrItem cur = tr_decode(a, it); tr_load(cur, va, lane);
            for (;;) {
                const int nx = it + NGW; const bool more = nx < NITEMS; TrItem nxt = cur;
                if (more) { nxt = tr_decode(a, nx); tr_load(nxt, vb, lane); }
                tr_store(cur, va, scr, lane);
                if (!more) break;
#pragma unroll
                for (int i = 0; i < 16; ++i) va[i] = vb[i];
                cur = nxt; it = nx;
            }
        }
    }
}
__device__ __forceinline__ void p0b_modreduce(const Args& a, int tid) {
    const float* part = (const float*)(a.ws + WS_MODP); float* mod = (float*)(a.ws + WS_MOD);
    for (int i = blockIdx.x * NTHR + tid; i < NB * NMOD; i += gridDim.x * NTHR) { const int n = i % NMOD; float s = a.in[I_BADA][n];
#pragma unroll 4
        for (int ks = 0; ks < KSPLIT; ++ks) s += part[(size_t)ks * 4 * NMOD + i];
        mod[i] = s; }
}

template <bool XIN16> struct XRow { u32x4 w[XIN16 ? 4 : 8]; };
template <bool XIN16> __device__ __forceinline__ void xrow_load(XRow<XIN16>& r, const void* xin, size_t row, int lane) {
    if (XIN16) {
#pragma unroll
        for (int j = 0; j < 4; ++j) r.w[j] = __builtin_nontemporal_load((const u32x4*)((const bf16*)xin + row * DM + 8 * (lane + 64 * j)));
    } else {
#pragma unroll
        for (int j = 0; j < 4; ++j) { const u32x4* p = (const u32x4*)((const float*)xin + row * DM + 8 * (lane + 64 * j)); r.w[2 * j] = __builtin_nontemporal_load(p); r.w[2 * j + 1] = __builtin_nontemporal_load(p + 1); }
    }
}
template <bool XIN16> __device__ __forceinline__ void xrow_unpack(const XRow<XIN16>& r, f32x4 (&x)[8]) {
    if (XIN16) {
#pragma unroll
        for (int j = 0; j < 4; ++j) { const u32x4 w = r.w[j]; x[2 * j] = (f32x4){bf_lo(w.x), bf_hi(w.x), bf_lo(w.y), bf_hi(w.y)}; x[2 * j + 1] = (f32x4){bf_lo(w.z), bf_hi(w.z), bf_lo(w.w), bf_hi(w.w)}; }
    } else {
#pragma unroll
        for (int q = 0; q < 8; ++q) x[q] = __builtin_bit_cast(f32x4, r.w[q]);
    }
}
template <bool HAS_RES, bool HAS_H, bool XIN16, bool XOUT16>
__device__ __forceinline__ void rowpass(const void* xin, const bf16* f, void* xout, bf16* hout, const float* post_g, const float* gate, float coef,
                                        const float* pre_g, const float* sc, const float* sh, int lane, int wave) {
    const int NGW = gridDim.x * NWAVES;
    for (int grp = blockIdx.x * NWAVES + wave; grp < MT / 8; grp += NGW) {
        const int r0 = grp * 8, b = r0 >> 12;
        f32x4 A[8], Bm[8];
#pragma unroll
        for (int j = 0; j < 4; ++j)
#pragma unroll
            for (int hh = 0; hh < 2; ++hh) { const int col = 8 * (lane + 64 * j) + 4 * hh;
                if (HAS_RES) { const f32x4 g = *(const f32x4*)(gate + (size_t)b * NMOD + col), pg = *(const f32x4*)(post_g + col); A[2 * j + hh] = g * pg * coef; }
                if (HAS_H) { const f32x4 s = *(const f32x4*)(sc + (size_t)b * NMOD + col), pg = *(const f32x4*)(pre_g + col); Bm[2 * j + hh] = pg * (s + 1.0f); }
            }
        constexpr bool DEEP = XIN16 || !HAS_RES;
        XRow<XIN16> xc, xn, xm; u32x4 fc[4], fn[4], fm[4];
        xrow_load<XIN16>(xc, xin, (size_t)r0, lane);
        if (HAS_RES) {
#pragma unroll
            for (int j = 0; j < 4; ++j) fc[j] = __builtin_nontemporal_load((const u32x4*)(f + (size_t)r0 * DM + 8 * (lane + 64 * j)));
        }
        if (DEEP) { xrow_load<XIN16>(xm, xin, (size_t)r0 + 1, lane);
            if (HAS_RES) {
#pragma unroll
                for (int j = 0; j < 4; ++j) fm[j] = __builtin_nontemporal_load((const u32x4*)(f + ((size_t)r0 + 1) * DM + 8 * (lane + 64 * j)));
            } }
#pragma unroll 1
        for (int rr = 0; rr < 8; ++rr) {
            const size_t row = (size_t)(r0 + rr);
            { const int ahead = DEEP ? 2 : 1; const size_t rn = (rr + ahead < 8) ? row + ahead : (size_t)(r0 + 7);
              xrow_load<XIN16>(xn, xin, rn, lane);
              if (HAS_RES) {
#pragma unroll
                  for (int j = 0; j < 4; ++j) fn[j] = __builtin_nontemporal_load((const u32x4*)(f + rn * DM + 8 * (lane + 64 * j)));
              } }
            f32x4 x[8]; xrow_unpack<XIN16>(xc, x);
            if (HAS_RES) {
                float ss = 0.f;
#pragma unroll
                for (int j = 0; j < 4; ++j)
#pragma unroll
                    for (int e = 0; e < 4; ++e) { const float lo = bf_lo(fc[j][e]), hi = bf_hi(fc[j][e]); ss += lo * lo + hi * hi; }
                const float r1 = __builtin_amdgcn_rsqf(wave_sum(ss) * (1.0f / DM) + EPS);
#pragma unroll
                for (int j = 0; j < 4; ++j) { const u32x4 w = fc[j];
                    x[2 * j] += A[2 * j] * (f32x4){bf_lo(w.x), bf_hi(w.x), bf_lo(w.y), bf_hi(w.y)} * r1; x[2 * j + 1] += A[2 * j + 1] * (f32x4){bf_lo(w.z), bf_hi(w.z), bf_lo(w.w), bf_hi(w.w)} * r1; }
                if (XOUT16) {
#pragma unroll
                    for (int j = 0; j < 4; ++j) { u32x4 w; w.x = pk2(x[2 * j][0], x[2 * j][1]); w.y = pk2(x[2 * j][2], x[2 * j][3]); w.z = pk2(x[2 * j + 1][0], x[2 * j + 1][1]); w.w = pk2(x[2 * j + 1][2], x[2 * j + 1][3]);
                        *(u32x4*)((bf16*)xout + row * DM + 8 * (lane + 64 * j)) = w;
                        x[2 * j] = (f32x4){bf_lo(w.x), bf_hi(w.x), bf_lo(w.y), bf_hi(w.y)}; x[2 * j + 1] = (f32x4){bf_lo(w.z), bf_hi(w.z), bf_lo(w.w), bf_hi(w.w)}; }
                } else {
#pragma unroll
                    for (int j = 0; j < 4; ++j) { f32x4* p = (f32x4*)((float*)xout + row * DM + 8 * (lane + 64 * j)); p[0] = x[2 * j]; p[1] = x[2 * j + 1]; }
                }
            }
            if (HAS_H) {
                float ss = 0.f;
#pragma unroll
                for (int q = 0; q < 8; ++q) ss += (x[q][0] * x[q][0] + x[q][1] * x[q][1]) + (x[q][2] * x[q][2] + x[q][3] * x[q][3]);
                const float r2 = __builtin_amdgcn_rsqf(wave_sum(ss) * (1.0f / DM) + EPS);
#pragma unroll
                for (int j = 0; j < 4; ++j) { const f32x4* shp = (const f32x4*)(sh + (size_t)b * NMOD + 8 * (lane + 64 * j));
                    const f32x4 h0 = x[2 * j] * r2 * Bm[2 * j] + shp[0], h1 = x[2 * j + 1] * r2 * Bm[2 * j + 1] + shp[1];
                    u32x4 w; w.x = pk2(h0[0], h0[1]); w.y = pk2(h0[2], h0[3]); w.z = pk2(h1[0], h1[1]); w.w = pk2(h1[2], h1[3]);
                    *(u32x4*)(hout + row * DM + 8 * (lane + 64 * j)) = w; }
            }
            if (DEEP) { xc = xm; xm = xn; } else xc = xn;
            if (HAS_RES) {
#pragma unroll
                for (int j = 0; j < 4; ++j) { if (DEEP) { fc[j] = fm[j]; fm[j] = fn[j]; } else fc[j] = fn[j]; }
            }
        }
    }
}

__device__ __forceinline__ unsigned swz(unsigned row, unsigned ch) { return 256u * row + 16u * (ch ^ (((row & 7u) << 1) | ((row >> 3) & 1u))); }
__device__ __forceinline__ s16x4 vtr(const LAS unsigned char* p) { return __builtin_bit_cast(s16x4, __builtin_amdgcn_ds_read_tr16_b64_v4i16((LAS s16x4*)p)); }
struct AttnItem { int dsh, b, h, r, m0; size_t obase; };
__device__ __forceinline__ AttnItem attn_decode(int idx) {
    AttnItem it; const int p = idx >> 10, rem = idx & 1023, t = rem & 31; it.b = rem >> 8; it.h = (rem >> 5) & 7; it.dsh = 2 * p;
    const int ngrp = (SEQ >> it.dsh) >> 7; it.r = t / ngrp; it.m0 = (t % ngrp) * 128; it.obase = (size_t)p; return it;
}
__device__ __forceinline__ void attn_issue(const AttnItem& it, const bf16* __restrict__ Kb, const bf16* __restrict__ Vb, int tid, u32x4 (&kreg)[8], u32x4 (&vreg)[8]) {
    const int ch = tid & 15, rr = tid >> 4, L = SEQ >> it.dsh;
    const size_t bh = (size_t)it.b * SEQ * AW + (size_t)it.h * 128 + 8 * ch;
#pragma unroll
    for (int i = 0; i < 8; ++i) { int km = it.m0 - 64 + 32 * i + rr; km = km < 0 ? 0 : (km > L - 1 ? L - 1 : km); const size_t off = bh + (size_t)((km << it.dsh) + it.r) * AW;
        kreg[i] = *(const u32x4*)(Kb + off); vreg[i] = *(const u32x4*)(Vb + off); }
}
__device__ __forceinline__ void attn_phase(const Args& a, LAS unsigned char* lds, int tid, int lane, int wave) {
    unsigned char* ws = a.ws;
    const bf16 *Q = (const bf16*)(ws + WS_Q), *Kb = (const bf16*)(ws + WS_K), *Vb = (const bf16*)(ws + WS_V);
    LAS unsigned char* kimg = lds; LAS unsigned char* vimg = lds + 65536;
    const int fr = lane & 15, fq = lane >> 4, G = gridDim.x;
    const unsigned q4 = (unsigned)(lane & 15) >> 2, p4 = (unsigned)lane & 3u;
    constexpr int NITEM = 3 * NB * NH * 32;
    const bool xcd_order = (G == 256);
    const int istep = xcd_order ? 32 : G;
    int idx = xcd_order ? ((int)(blockIdx.x & 7) * (NITEM / 8) + (int)(blockIdx.x >> 3)) : (int)blockIdx.x;
    const int iend = xcd_order ? ((int)(blockIdx.x & 7) + 1) * (NITEM / 8) : NITEM;
    if (idx >= iend) return;
    u32x4 kreg[8], vreg[8];
    AttnItem it = attn_decode(idx);
    attn_issue(it, Kb, Vb, tid, kreg, vreg);
    for (;;) {
        const int L = SEQ >> it.dsh, m0 = it.m0 + 16 * wave;
        const size_t bh = (size_t)it.b * SEQ * AW + (size_t)it.h * 128;
        const int qpos = ((m0 + fr) << it.dsh) + it.r;
        bf16x8 qf[4];
        { const bf16x8* qp = (const bf16x8*)(Q + bh + (size_t)qpos * AW) + fq;
#pragma unroll
          for (int kk = 0; kk < 4; ++kk) qf[kk] = qp[4 * kk]; }
        __syncthreads();
        { const unsigned ch = tid & 15, rr = tid >> 4;
#pragma unroll
          for (int i = 0; i < 8; ++i) { const unsigned o = swz(32u * i + rr, ch); *(LAS u32x4*)(kimg + o) = kreg[i]; *(LAS u32x4*)(vimg + o) = vreg[i]; } }
        __syncthreads();
        const int nidx = idx + istep; const bool has_next = nidx < iend;
        AttnItem nit = it;
        if (has_next) { nit = attn_decode(nidx); attn_issue(nit, Kb, Vb, tid, kreg, vreg); }
        f32x4 s[10];
        const unsigned wrow = 16u * wave;
#pragma unroll
        for (int blk = 0; blk < 9; ++blk) {
            f32x4 acc = {0.f, 0.f, 0.f, 0.f};
#pragma unroll
            for (int kk = 0; kk < 4; ++kk) { const bf16x8 kf = *(const LAS bf16x8*)(kimg + swz(wrow + 16u * blk + fr, 4u * kk + fq)); acc = __builtin_amdgcn_mfma_f32_16x16x32_bf16(kf, qf[kk], acc, 0, 0, 0); }
            s[blk] = acc;
        }
        float mx = -1e30f;
#pragma unroll
        for (int j = 0; j < 4; ++j) { s[0][j] = (4 * fq + j - fr >= 0) ? s[0][j] : -1e30f; s[8][j] = (4 * fq + j - fr <= 0) ? s[8][j] : -1e30f; }
        if (m0 < 64 || m0 + 80 > L) {
#pragma unroll
            for (int blk = 0; blk < 9; ++blk)
#pragma unroll
                for (int j = 0; j < 4; ++j) { const int km = m0 - 64 + 16 * blk + 4 * fq + j; s[blk][j] = (km >= 0 && km < L) ? s[blk][j] : -1e30f; }
        }
#pragma unroll
        for (int blk = 0; blk < 9; ++blk)
#pragma unroll
            for (int j = 0; j < 4; ++j) mx = fmaxf(mx, s[blk][j]);
        mx = fmaxf(mx, __shfl_xor(mx, 16)); mx = fmaxf(mx, __shfl_xor(mx, 32));
        float l = 0.f;
#pragma unroll
        for (int blk = 0; blk < 9; ++blk)
#pragma unroll
            for (int j = 0; j < 4; ++j) { const float p = __builtin_amdgcn_exp2f(s[blk][j] - mx); s[blk][j] = p; l += p; }
        s[9] = (f32x4){0.f, 0.f, 0.f, 0.f};
        l += __shfl_xor(l, 16); l += __shfl_xor(l, 32);
        f32x4 o[8];
#pragma unroll
        for (int c = 0; c < 8; ++c) o[c] = (f32x4){0.f, 0.f, 0.f, 0.f};
#pragma unroll
        for (int ks = 0; ks < 5; ++ks) {
            u32x4 pw; pw.x = pk2(s[2 * ks][0], s[2 * ks][1]); pw.y = pk2(s[2 * ks][2], s[2 * ks][3]); pw.z = pk2(s[2 * ks + 1][0], s[2 * ks + 1][1]); pw.w = pk2(s[2 * ks + 1][2], s[2 * ks + 1][3]);
            const bf16x8 pb = __builtin_bit_cast(bf16x8, pw);
            const unsigned r0 = wrow + 32u * ks + 4u * fq + q4, r1 = (ks == 4) ? r0 : r0 + 16u;
#pragma unroll
            for (int c = 0; c < 8; ++c) {
                const s16x4 a0 = vtr(vimg + swz(r0, 2u * c + (p4 >> 1)) + 8u * (p4 & 1u));
                const s16x4 a1 = vtr(vimg + swz(r1, 2u * c + (p4 >> 1)) + 8u * (p4 & 1u));
                const bf16x8 av = {a0[0], a0[1], a0[2], a0[3], a1[0], a1[1], a1[2], a1[3]};
                o[c] = __builtin_amdgcn_mfma_f32_16x16x32_bf16(av, pb, o[c], 0, 0, 0);
            }
        }
        const float inv = 1.0f / l;
        bf16* op = (bf16*)(ws + WS_O + it.obase * 32 * MiB) + bh + (size_t)qpos * AW + 4 * fq;
#pragma unroll
        for (int c = 0; c < 8; ++c) { u32x2 w; w.x = pk2(o[c][0] * inv, o[c][1] * inv); w.y = pk2(o[c][2] * inv, o[c][3] * inv); *(u32x2*)(op + 16 * c) = w; }
        if (fq == 0) ((float*)(ws + WS_LSE) + it.obase * MT * NH)[((size_t)it.b * SEQ + qpos) * NH + it.h] = mx + __log2f(l);
        if (!has_next) break;
        it = nit; idx = nidx;
    }
}

__device__ __forceinline__ void unpack16(const u32x4 a, const u32x4 b, float* v) {
    v[0] = bf_lo(a.x); v[1] = bf_hi(a.x); v[2] = bf_lo(a.y); v[3] = bf_hi(a.y); v[4] = bf_lo(a.z); v[5] = bf_hi(a.z); v[6] = bf_lo(a.w); v[7] = bf_hi(a.w);
    v[8] = bf_lo(b.x); v[9] = bf_hi(b.x); v[10] = bf_lo(b.y); v[11] = bf_hi(b.y); v[12] = bf_lo(b.z); v[13] = bf_hi(b.z); v[14] = bf_lo(b.w); v[15] = bf_hi(b.w);
}
__device__ __forceinline__ void store16(bf16* p, const float* v) {
    u32x4 a, b; a.x = pk2(v[0], v[1]); a.y = pk2(v[2], v[3]); a.z = pk2(v[4], v[5]); a.w = pk2(v[6], v[7]); b.x = pk2(v[8], v[9]); b.y = pk2(v[10], v[11]); b.z = pk2(v[12], v[13]); b.w = pk2(v[14], v[15]);
    ((u32x4*)p)[0] = a; ((u32x4*)p)[1] = b;
}
#ifndef RING
#define RING 4
#endif
__device__ __forceinline__ void mixpost_phase(const Args& a, LAS unsigned char* lds, int tid, int lane, int wave) {
    unsigned char* ws = a.ws;
    for (int i = tid; i < CK * 1024 / 4; i += NTHR) ((LAS f32x4*)lds)[i] = ((const f32x4*)a.in[I_CONVW])[i];
    __syncthreads();
    const bf16* U = (const bf16*)(ws + WS_U); bf16* MG = (bf16*)(ws + WS_H);
    const float* lse = (const float*)(ws + WS_LSE);
    const int NGW = gridDim.x * NWAVES, c0 = 16 * lane, head = lane >> 3;
    for (int grp = blockIdx.x * NWAVES + wave; grp < MT / 4; grp += NGW) {
        const int row0 = grp * 4, b = row0 >> 12, s0 = row0 & 4095;
        u32x4 ring[RING][2], w3[3][2];
#define CONV_ISSUE(dst, sp_) do { const int sp = (sp_); const bool ok = (sp >= 0) && (sp < SEQ); const u32x4* p = (const u32x4*)(U + ((size_t)b * SEQ + (ok ? sp : 0)) * AW + c0); \
            dst[0] = p[0]; dst[1] = p[1]; if (!ok) { dst[0] = (u32x4){0u, 0u, 0u, 0u}; dst[1] = dst[0]; } } while (0)
#define CONV_UNPACK(slot, src) do { const u32x4 q0 = src[0], q1 = src[1]; \
            win[slot][0] = (f32x2){bf_lo(q0.x), bf_hi(q0.x)}; win[slot][1] = (f32x2){bf_lo(q0.y), bf_hi(q0.y)}; win[slot][2] = (f32x2){bf_lo(q0.z), bf_hi(q0.z)}; win[slot][3] = (f32x2){bf_lo(q0.w), bf_hi(q0.w)}; \
            win[slot][4] = (f32x2){bf_lo(q1.x), bf_hi(q1.x)}; win[slot][5] = (f32x2){bf_lo(q1.y), bf_hi(q1.y)}; win[slot][6] = (f32x2){bf_lo(q1.z), bf_hi(q1.z)}; win[slot][7] = (f32x2){bf_lo(q1.w), bf_hi(q1.w)}; } while (0)
        CONV_ISSUE(w3[0], s0 - 15); CONV_ISSUE(w3[1], s0 - 14); CONV_ISSUE(w3[2], s0 - 13);
#pragma unroll
        for (int j = 0; j < RING; ++j) CONV_ISSUE(ring[j], s0 - 12 + j);
#pragma unroll 1
        for (int t = 0; t < 4; ++t) {
            const size_t row = (size_t)(row0 + t);
            float l0 = lse[row * NH + head], l1 = lse[(size_t)MT * NH + row * NH + head], l2 = lse[(size_t)2 * MT * NH + row * NH + head];
            const u32x4* p0 = (const u32x4*)((const bf16*)(ws + WS_O) + row * AW + c0); const u32x4 a00 = p0[0], a01 = p0[1];
            const u32x4* p1 = (const u32x4*)((const bf16*)(ws + WS_O + 32 * MiB) + row * AW + c0); const u32x4 a10 = p1[0], a11 = p1[1];
            const u32x4* p2 = (const u32x4*)((const bf16*)(ws + WS_O + 64 * MiB) + row * AW + c0); const u32x4 a20 = p2[0], a21 = p2[1];
            const float mx = fmaxf(l0, fmaxf(l1, l2)); float w0 = __builtin_amdgcn_exp2f(l0 - mx), w1 = __builtin_amdgcn_exp2f(l1 - mx), w2 = __builtin_amdgcn_exp2f(l2 - mx);
            const float iw = 1.0f / (w0 + w1 + w2); w0 *= iw; w1 *= iw; w2 *= iw;
            float v[16], acc[16];
            unpack16(a00, a01, v);
#pragma unroll
            for (int i = 0; i < 16; ++i) acc[i] = w0 * v[i];
            unpack16(a10, a11, v);
#pragma unroll
            for (int i = 0; i < 16; ++i) acc[i] += w1 * v[i];
            unpack16(a20, a21, v);
#pragma unroll
            for (int i = 0; i < 16; ++i) acc[i] += w2 * v[i];
            float ss = 0.f;
#pragma unroll
            for (int i = 0; i < 16; ++i) ss += acc[i] * acc[i];
            const float rs = __builtin_amdgcn_rsqf(wave_sum(ss) * (1.0f / AW) + EPS);
#pragma unroll
            for (int i = 0; i < 16; i += 4) { const f32x4 g = *(const f32x4*)(a.in[I_AOG] + c0 + i); acc[i] *= rs * g[0]; acc[i + 1] *= rs * g[1]; acc[i + 2] *= rs * g[2]; acc[i + 3] *= rs * g[3]; }
            store16(MG + row * DM + c0, acc);
        }
        f32x2 cacc2[4][8], win[4][8];
#pragma unroll
        for (int t = 0; t < 4; ++t)
#pragma unroll
            for (int i = 0; i < 8; ++i) cacc2[t][i] = (f32x2){0.f, 0.f};
        CONV_UNPACK(0, w3[0]); CONV_UNPACK(1, w3[1]); CONV_UNPACK(2, w3[2]);
#pragma unroll 1
        for (int kb = 0; kb < 32; kb += RING) {
#pragma unroll
            for (int j = 0; j < RING; ++j) { const int k = kb + j;
                if (k < CK) {
                    CONV_UNPACK((j + 3) & 3, ring[j]);
                    if (k + RING < CK) CONV_ISSUE(ring[j], s0 - 12 + k + RING);
                    f32x2 w[8];
#pragma unroll
                    for (int i = 0; i < 4; ++i) { const f32x4 wv = *(const LAS f32x4*)(lds + ((size_t)k * 1024 + c0 + 4 * i) * 4); w[2 * i] = (f32x2){wv[0], wv[1]}; w[2 * i + 1] = (f32x2){wv[2], wv[3]}; }
#pragma unroll
                    for (int t = 0; t < 4; ++t)
#pragma unroll
                        for (int i = 0; i < 8; ++i) cacc2[t][i] = __builtin_elementwise_fma(w[i], win[(t + j) & 3][i], cacc2[t][i]);
                } }
        }
#undef CONV_ISSUE
#undef CONV_UNPACK
        float cacc[4][16];
#pragma unroll
        for (int t = 0; t < 4; ++t)
#pragma unroll
            for (int i = 0; i < 8; ++i) { cacc[t][2 * i] = cacc2[t][i][0]; cacc[t][2 * i + 1] = cacc2[t][i][1]; }
        float cb[16], lg[16], lb[16], og[16];
#pragma unroll
        for (int i = 0; i < 16; i += 4) { const f32x4 x0 = *(const f32x4*)(a.in[I_CONVB] + c0 + i), x1 = *(const f32x4*)(a.in[I_LNG] + c0 + i), x2 = *(const f32x4*)(a.in[I_LNB] + c0 + i), x3 = *(const f32x4*)(a.in[I_COG] + c0 + i);
#pragma unroll
            for (int e = 0; e < 4; ++e) { cb[i + e] = x0[e]; lg[i + e] = x1[e]; lb[i + e] = x2[e]; og[i + e] = x3[e]; } }
#pragma unroll
        for (int t = 0; t < 4; ++t) {
            float sm = 0.f;
#pragma unroll
            for (int i = 0; i < 16; ++i) { cacc[t][i] += cb[i]; sm += cacc[t][i]; }
            const float mu = wave_sum(sm) * (1.0f / 1024.0f); float sv = 0.f;
#pragma unroll
            for (int i = 0; i < 16; ++i) { cacc[t][i] -= mu; sv += cacc[t][i] * cacc[t][i]; }
            const float rs = __builtin_amdgcn_rsqf(wave_sum(sv) * (1.0f / 1024.0f) + EPS); float s2 = 0.f;
#pragma unroll
            for (int i = 0; i < 16; ++i) { const float y = cacc[t][i] * rs * lg[i] + lb[i]; const float z = y * pg8::sigmoid_f(y); cacc[t][i] = z; s2 += z * z; }
            const float r2 = __builtin_amdgcn_rsqf(wave_sum(s2) * (1.0f / 1024.0f) + EPS);
#pragma unroll
            for (int i = 0; i < 16; ++i) cacc[t][i] *= r2 * og[i];
            store16(MG + (size_t)(row0 + t) * DM + 1024 + c0, cacc[t]);
        }
    }
}

#define XB_TMO      128
#define XB_XCNT(j)  (256  + 64 * (j))
#define XB_XSUB(j)  (1280 + 64 * (j))
#define XB_XGEN(j)  (2304 + 64 * (j))
#define XB_TOP      3328
#define XB_TOPGEN   3392
#define XCD_BAR_WORDS 3456
#define XB_SPIN_CAP (1u << 18)

__device__ __forceinline__ unsigned xb_ld(unsigned* p)              { return __hip_atomic_load(p, __ATOMIC_RELAXED, __HIP_MEMORY_SCOPE_AGENT); }
__device__ __forceinline__ unsigned xb_add(unsigned* p, unsigned v) { return __hip_atomic_fetch_add(p, v, __ATOMIC_RELAXED, __HIP_MEMORY_SCOPE_AGENT); }
__device__ __forceinline__ unsigned xb_xcc_id() { return (unsigned)__builtin_amdgcn_s_getreg((3 << 11) | 20) & 0xFu; }
#define XB_SPIN(cond, bar) do { unsigned _sp = 0; while (cond) { __builtin_amdgcn_s_sleep(1); \
    if ((++_sp & 255u) == 0u) { if (xb_ld(&(bar)[XB_TMO])) break; if (_sp > XB_SPIN_CAP) { atomicAdd(&(bar)[XB_TMO], 1u); break; } } } } while (0)

struct XcdBarrier {
    unsigned* bar; unsigned x;
    volatile LAS unsigned* st;
};

__device__ __forceinline__ XcdBarrier xcd_barrier_post(unsigned* bar, volatile LAS unsigned* st) {
    XcdBarrier b; b.bar = bar; b.x = xb_xcc_id(); b.st = st;
    if (threadIdx.x == 0) (void)xb_add(&bar[XB_XCNT(b.x)], 1u);
    return b;
}
__device__ __forceinline__ void xcd_barrier_complete(unsigned* bar, unsigned x, unsigned& nloc, unsigned& nx) {
    const unsigned G = gridDim.x * gridDim.y * gridDim.z;
    unsigned sum, cnt, mine, sp = 0u;
    for (;;) {
        sum = 0u; cnt = 0u; mine = 0u;
#pragma unroll
        for (unsigned j = 0; j < 16; ++j) { const unsigned c = xb_ld(&bar[XB_XCNT(j)]); sum += c; cnt += (c > 0u) ? 1u : 0u; mine = (j == x) ? c : mine; }
        if (sum == G) break;
        __builtin_amdgcn_s_sleep(1);
        if ((++sp & 255u) == 0u) { if (xb_ld(&bar[XB_TMO])) break; if (sp > XB_SPIN_CAP) { atomicAdd(&bar[XB_TMO], 1u); break; } }
    }
    nloc = mine > 0u ? mine : 1u; nx = cnt > 0u ? cnt : 1u;
}

__device__ __forceinline__ void xcd_barrier(const XcdBarrier& b) {
    asm volatile("s_waitcnt vmcnt(0)" ::: "memory");
    __syncthreads();
    if (threadIdx.x == 0) {
        unsigned* bar = b.bar;
        __builtin_amdgcn_s_waitcnt(0);
        unsigned nloc = b.st[0], nx = b.st[1];
        if (nloc == 0u) { xcd_barrier_complete(bar, b.x, nloc, nx); b.st[0] = nloc; b.st[1] = nx; }
        const unsigned old = xb_add(&bar[XB_XSUB(b.x)], 1u);
        const unsigned gen = old / nloc;
        if (old + 1u == (gen + 1u) * nloc) {
            __builtin_amdgcn_fence(__ATOMIC_RELEASE, "agent");
            asm volatile("s_waitcnt vmcnt(0)" ::: "memory");
            const unsigned og = xb_add(&bar[XB_TOP], 1u);
            const unsigned tg = og / nx;
            if (og + 1u == (tg + 1u) * nx) xb_add(&bar[XB_TOPGEN], 1u);
            else XB_SPIN(xb_ld(&bar[XB_TOPGEN]) == tg, bar);
            __builtin_amdgcn_fence(__ATOMIC_ACQUIRE, "agent");
            xb_add(&bar[XB_XGEN(b.x)], 1u);
            asm volatile("s_waitcnt vmcnt(0)" ::: "memory");
        } else {
            XB_SPIN(xb_ld(&bar[XB_XGEN(b.x)]) == gen, bar);
            __builtin_amdgcn_fence(__ATOMIC_ACQUIRE, "agent");
            asm volatile("s_waitcnt vmcnt(0)" ::: "memory");
        }
    }
    __syncthreads();
}


__global__ void __launch_bounds__(NTHR, 2) fwd_megakernel(Args a) {
    extern __shared__ __attribute__((aligned(16))) unsigned char lds_raw[];
    LAS unsigned char* lds = (LAS unsigned char*)lds_raw;
    cg::grid_group grid = cg::this_grid();
    volatile LAS unsigned* bst = (volatile LAS unsigned*)(lds + 147456 - 64);
    if (threadIdx.x < 2) bst[threadIdx.x] = 0u;
    __syncthreads();
    const XcdBarrier bar = xcd_barrier_post((unsigned*)(a.ws + WS_CTL), bst);
    const int tid0 = threadIdx.x, wave = __builtin_amdgcn_readfirstlane(tid0 >> 6), G = gridDim.x;
#define FRESH() int tid = tid0; asm volatile("" : "+v"(tid)); const int lane = tid & 63; (void)lane;
    unsigned char* ws = a.ws;
    const float* mod = (const float*)(ws + WS_MOD);
    bf16 *HB = (bf16*)(ws + WS_H), *FB = (bf16*)(ws + WS_F), *ACT = (bf16*)(ws + WS_ACT);

#ifndef PH_MASK
#define PH_MASK 0xFFFF
#endif
#define PH(n) if (PH_MASK & (1 << (n)))
#ifndef DUP_MASK
#define DUP_MASK 0
#endif
#define DUP(n) ((DUP_MASK >> (n)) & 1)
    for (int rep = 0; rep <= DUP(0); ++rep) {
    { FRESH();
    PH(0) p0_prologue(a, lds, tid, lane, wave);
    }
    if (a.ws == nullptr) grid.sync();
    xcd_barrier(bar);
    { FRESH();
    PH(0) p0b_modreduce(a, tid);
    }
    xcd_barrier(bar);
    }
#if DUP(15)
    for (int rep = 0; rep < 10; ++rep) xcd_barrier(bar);
#endif
    for (int rep = 0; rep <= DUP(1); ++rep)
    { FRESH();
    PH(1) rowpass<false, true, false, false>(a.in[I_X], nullptr, nullptr, HB, nullptr, nullptr, 0.f, a.in[I_F1PRE], mod + 1 * DM, mod + 0 * DM, lane, wave);
    }
    xcd_barrier(bar);
    { FRESH();
    PH(2) { pg8::Gemm g{HB, (const bf16*)(ws + WS_WGU1), MT, NGU, DM}; pg8::StaticOrder S; S.init(MT, NGU, G, (int)blockIdx.x); S.wg = WG_GU; pg8::EpiSwiGLU E{ACT, DFF};
      pg8::gemm_phase<pg8::EpiSwiGLU, pg8::StaticOrder, true, true>(lds, g, S, E); }
    }
#if DUP(2)
    xcd_barrier(bar);
    { FRESH();
    PH(2) { pg8::Gemm g{HB, (const bf16*)(ws + WS_WGU1), MT, NGU, DM}; pg8::StaticOrder S; S.init(MT, NGU, G, (int)blockIdx.x); S.wg = WG_GU; pg8::EpiSwiGLU E{ACT, DFF};
      pg8::gemm_phase<pg8::EpiSwiGLU, pg8::StaticOrder, true, true>(lds, g, S, E); }
    }
#endif
    xcd_barrier(bar);
    { FRESH();
    PH(3) { pg8::Gemm g{ACT, (const bf16*)(ws + WS_WD1), MT, DM, DFF}; pg8::StaticOrder S; S.init(MT, DM, G, (int)blockIdx.x); S.wg = WG_DN; pg8::EpiPlain E{FB, DM};
      pg8::gemm_phase<pg8::EpiPlain, pg8::StaticOrder, true, true>(lds, g, S, E); }
    }
#if DUP(3)
    xcd_barrier(bar);
    { FRESH();
    PH(3) { pg8::Gemm g{ACT, (const bf16*)(ws + WS_WD1), MT, DM, DFF}; pg8::StaticOrder S; S.init(MT, DM, G, (int)blockIdx.x); S.wg = WG_DN; pg8::EpiPlain E{FB, DM};
      pg8::gemm_phase<pg8::EpiPlain, pg8::StaticOrder, true, true>(lds, g, S, E); }
    }
#endif
    xcd_barrier(bar);
    for (int rep = 0; rep <= DUP(4); ++rep)
    { FRESH();
    PH(4) rowpass<true, true, false, true>(a.in[I_X], FB, a.out, HB, a.in[I_F1POST], mod + 2 * DM, 0.5f, a.in[I_MIXPRE], mod + 4 * DM, mod + 3 * DM, lane, wave);
    }
    xcd_barrier(bar);
    { FRESH();
    PH(5) { pg8::Gemm g{HB, (const bf16*)(ws + WS_WIN), MT, NIN, DM}; pg8::StaticOrder S; S.init(MT, NIN, G, (int)blockIdx.x); S.wg = WG_IN;
      pg8::EpiIn E{(bf16*)(ws + WS_Q), (bf16*)(ws + WS_K), (bf16*)(ws + WS_V), (bf16*)(ws + WS_U), (const float*)(ws + WS_ROPE), 0.08838834764831845f * 1.4426950408889634f};
      pg8::gemm_phase<pg8::EpiIn, pg8::StaticOrder, true, true>(lds, g, S, E); }
    }
    xcd_barrier(bar);
    for (int rep = 0; rep <= DUP(6); ++rep)
    { FRESH();
    PH(6) attn_phase(a, lds, tid, lane, wave);
    }
    xcd_barrier(bar);
    for (int rep = 0; rep <= DUP(7); ++rep)
    { FRESH();
    PH(7) mixpost_phase(a, lds, tid, lane, wave);
    }
    xcd_barrier(bar);
    { FRESH();
    PH(8) { pg8::Gemm g{HB, (const bf16*)(ws + WS_WOUT), MT, DM, DM}; pg8::StaticOrder S; S.init(MT, DM, G, (int)blockIdx.x); S.wg = WG_DN; pg8::EpiPlain E{FB, DM};
      pg8::gemm_phase<pg8::EpiPlain, pg8::StaticOrder, true, true>(lds, g, S, E); }
    }
    xcd_barrier(bar);
    for (int rep = 0; rep <= DUP(9); ++rep)
    { FRESH();
    PH(9) rowpass<true, true, true, true>(a.out, FB, ws + WS_O, HB, a.in[I_MIXPOST], mod + 5 * DM, 1.0f, a.in[I_F2PRE], mod + 7 * DM, mod + 6 * DM, lane, wave);
    }
    xcd_barrier(bar);
    { FRESH();
    PH(10) { pg8::Gemm g{HB, (const bf16*)(ws + WS_WGU2), MT, NGU, DM}; pg8::StaticOrder S; S.init(MT, NGU, G, (int)blockIdx.x); S.wg = WG_GU; pg8::EpiSwiGLU E{ACT, DFF};
      pg8::gemm_phase<pg8::EpiSwiGLU, pg8::StaticOrder, true, true>(lds, g, S, E); }
    }
    xcd_barrier(bar);
    { FRESH();
    PH(11) { pg8::Gemm g{ACT, (const bf16*)(ws + WS_WD2), MT, DM, DFF}; pg8::StaticOrder S; S.init(MT, DM, G, (int)blockIdx.x); S.wg = WG_DN; pg8::EpiPlain E{FB, DM};
      pg8::gemm_phase<pg8::EpiPlain, pg8::StaticOrder, true, true>(lds, g, S, E); }
    }
    xcd_barrier(bar);
    for (int rep = 0; rep <= DUP(12); ++rep)
    { FRESH();
    PH(12) rowpass<true, false, true, false>(ws + WS_O, FB, a.out, nullptr, a.in[I_F2POST], mod + 8 * DM, 0.5f, nullptr, nullptr, nullptr, lane, wave);
    }
}

extern "C" void kernel_launch(void* const* d_in, const int* in_sizes, int n_in, void* d_out, int out_size, void* d_ws, size_t ws_size, hipStream_t stream) {
    static int grid = 0;
    if (grid == 0) {
        if (n_in != 24 || out_size != MT * DM || ws_size < WS_END) { fprintf(stderr, "kernel_launch: unexpected shapes (n_in %d, out %d, ws %zu); nothing launched\n", n_in, out_size, ws_size); grid = -1; return; }
        int dev = 0, cus = 0, per_cu = 0;
        (void)hipGetDevice(&dev); (void)hipDeviceGetAttribute(&cus, hipDeviceAttributeMultiprocessorCount, dev);
        if (hipFuncSetAttribute((const void*)fwd_megakernel, hipFuncAttributeMaxDynamicSharedMemorySize, LDS_BYTES) != hipSuccess) { fprintf(stderr, "kernel_launch: hipFuncSetAttribute failed\n"); grid = -1; return; }
        if (hipOccupancyMaxActiveBlocksPerMultiprocessor(&per_cu, (const void*)fwd_megakernel, NTHR, LDS_BYTES) != hipSuccess || per_cu < 1) { fprintf(stderr, "kernel_launch: occupancy query says %d\n", per_cu); per_cu = 1; }
        (void)hipGetLastError();
        grid = cus * 1;
        if (grid <= 0) grid = 256;
    }
    if (grid < 0) return;
    if (hipMemsetAsync((char*)d_ws + WS_CTL, 0, CTL_BYTES, stream) != hipSuccess) { fprintf(stderr, "kernel_launch: memset of the barrier words failed\n"); return; }
    Args a{};
    for (int i = 0; i < 24; ++i) a.in[i] = (const float*)d_in[i];
    a.out = (float*)d_out; a.ws = (unsigned char*)d_ws;
    void* args[] = {&a};
    hipError_t e = hipLaunchCooperativeKernel((const void*)fwd_megakernel, dim3(grid), dim3(NTHR), args, LDS_BYTES, stream);
    if (e != hipSuccess) fprintf(stderr, "cooperative launch failed: %s (grid %d)\n", hipGetErrorString(e), grid);
}
```

```cpp
#include <hip/hip_runtime.h>
#include <hip/hip_cooperative_groups.h>
#include <cstdio>
#include <cstdint>
namespace cg = cooperative_groups;
namespace pg8 {
#define PG8_LAS __attribute__((address_space(3)))
typedef unsigned short bf16_t;
typedef short bf16x8 __attribute__((ext_vector_type(8)));
typedef float f32x4 __attribute__((ext_vector_type(4)));
typedef unsigned u32x4 __attribute__((ext_vector_type(4)));
constexpr int BM = 256, BK = 64, HALF = 128, HTB = HALF * BK * 2  , STAGE_BYTES = 8 * HTB, NXCD = 8, WGM = 8;

__host__ __device__ __forceinline__ int lds_byte(int r, int c) { const int st = (r >> 4) * 2 + (c >> 5), rr = r & 15, cc = c & 31, ob = rr * 64 + cc * 2; return st * 1024 + (ob ^ (((ob >> 9) & 1) << 5)); }
__host__ __device__ __forceinline__ void stage_rc(int b, int& R, int& C) { const int st = b / 1024, sb = b % 1024, swz = sb ^ (((sb >> 9) & 1) << 5); R = (st >> 1) * 16 + swz / 64; C = (st & 1) * 32 + (swz % 64) / 2; }
__host__ __device__ __forceinline__ int perm32(int rho) { const int n = rho >> 4, i = rho & 15; return 8 * (i >> 2) + 4 * n + (i & 3); }

struct Unit { int pm, pn; };
struct Gemm { const bf16_t* A; const bf16_t* Bt; int M, N, K; };

struct StaticOrder {
    int nM, nN, nwg, G, c, wg = WGM;
    __host__ __device__ void init(int M, int N, int G_, int c_) { nM = M / BM; nN = N / BM; nwg = nM * nN; G = G_; c = c_; }
    __host__ __device__ bool next(int i, Unit& u) const {
        const long L = (long)i * G + c; if (L >= nwg) return false;
        int wgid = (int)L; { const int q = nwg / NXCD, r = nwg % NXCD, xcd = wgid % NXCD, off = wgid / NXCD; wgid = (xcd < r ? xcd * (q + 1) : r * (q + 1) + (xcd - r) * q) + off; }
        const int nig = wg * nN, gid = wgid / nig, fm = gid * wg, gsz = (nM - fm) < wg ? (nM - fm) : wg;
        u.pm = fm + ((wgid % nig) % gsz); u.pn = (wgid % nig) / gsz; return true;
    }
    __device__ __forceinline__ void a_ready(const Unit&) const {}
    __device__ __forceinline__ void done(const Unit&) const {}
};

typedef float f32x2_t __attribute__((ext_vector_type(2)));
typedef __bf16 bf16x2_t __attribute__((ext_vector_type(2)));
__device__ __forceinline__ unsigned pk_bf16(float lo, float hi) { f32x2_t v = {lo, hi}; bf16x2_t b = __builtin_convertvector(v, bf16x2_t); return __builtin_bit_cast(unsigned, b); }
__device__ __forceinline__ float sigmoid_f(float x) { return __builtin_amdgcn_rcpf(1.0f + __builtin_amdgcn_exp2f(-1.44269504089f * x)); }
typedef unsigned u32x2 __attribute__((ext_vector_type(2)));

template <int MODE> __device__ __forceinline__ void epi_glu_store(const f32x4 (&acc)[2][2][4][2], bf16_t* O, int ldc, int row0, int col0) {
#pragma unroll
    for (int ai = 0; ai < 2; ++ai)
#pragma unroll
        for (int m = 0; m < 4; ++m) {
            bf16_t* rowp = O + (size_t)(row0 + ai * HALF + m * 16) * ldc + col0;
            float r[8];
#pragma unroll
            for (int n = 0; n < 2; ++n)
#pragma unroll
                for (int e = 0; e < 4; ++e) { const float a = acc[ai][0][m][n][e], b = acc[ai][1][m][n][e];
                    r[4 * n + e] = (MODE == 0) ? (a * sigmoid_f(a)) * b : a * sigmoid_f(b); }
            u32x4 w; w.x = pk_bf16(r[0], r[1]); w.y = pk_bf16(r[2], r[3]); w.z = pk_bf16(r[4], r[5]); w.w = pk_bf16(r[6], r[7]);
            *(u32x4*)rowp = w; }
}
__device__ __forceinline__ void epi_plain_store(const f32x4 (&acc)[2][2][4][2], bf16_t* O, int ldc, int row0, int col0) {
#pragma unroll
    for (int ai = 0; ai < 2; ++ai)
#pragma unroll
        for (int m = 0; m < 4; ++m) {
            bf16_t* rowp = O + (size_t)(row0 + ai * HALF + m * 16) * ldc + col0;
#pragma unroll
            for (int bj = 0; bj < 2; ++bj) { const f32x4 v0 = acc[ai][bj][m][0], v1 = acc[ai][bj][m][1];
                u32x4 w; w.x = pk_bf16(v0[0], v0[1]); w.y = pk_bf16(v0[2], v0[3]); w.z = pk_bf16(v1[0], v1[1]); w.w = pk_bf16(v1[2], v1[3]);
                *(u32x4*)(rowp + bj * HALF) = w; } }
}
struct EpiSwiGLU {
    static constexpr bool PERM = false, AFTER_DRAIN = false;
    bf16_t* O; int ldc;
    __device__ __forceinline__ void operator()(const f32x4 (&acc)[2][2][4][2], const Unit& u, int wr, int wc, int fr, int fq) const {
        epi_glu_store<0>(acc, O, ldc, u.pm * BM + wr * 64 + fr, u.pn * HALF + wc * 32 + 8 * fq);
    }
};
struct EpiPlain {
    static constexpr bool PERM = false, AFTER_DRAIN = false;
    bf16_t* O; int ldc;
    __device__ __forceinline__ void operator()(const f32x4 (&acc)[2][2][4][2], const Unit& u, int wr, int wc, int fr, int fq) const {
        epi_plain_store(acc, O, ldc, u.pm * BM + wr * 64 + fr, u.pn * BM + wc * 32 + 8 * fq);
    }
};
struct EpiIn {
    static constexpr bool PERM = false, AFTER_DRAIN = false;
    bf16_t *Q, *K, *V, *U; const float* rope;
    float qscale;
    __device__ __forceinline__ void operator()(const f32x4 (&acc)[2][2][4][2], const Unit& u, int wr, int wc, int fr, int fq) const {
        const int row0 = u.pm * BM + wr * 64 + fr;
        if (u.pn >= 12) { epi_glu_store<1>(acc, U, 1024, row0, (u.pn - 12) * HALF + wc * 32 + 8 * fq); return; }
        if (u.pn >= 8) { epi_plain_store(acc, V, 1024, row0, (u.pn - 8) * BM + wc * 32 + 8 * fq); return; }
        const bool isq = u.pn < 4; bf16_t* base = isq ? Q : K; const float sc = isq ? qscale : 1.0f;
        const int d0 = 16 * wc + 4 * fq;
#pragma unroll
        for (int ai = 0; ai < 2; ++ai)
#pragma unroll
            for (int m = 0; m < 4; ++m) { const int row = row0 + ai * HALF + m * 16, pos = row & 4095;
                const f32x4 cs0 = *(const f32x4*)(rope + ((size_t)pos * 64 + d0) * 2), cs1 = *(const f32x4*)(rope + ((size_t)pos * 64 + d0) * 2 + 4);
                const float c[4] = {cs0[0], cs0[2], cs1[0], cs1[2]}, s[4] = {cs0[1], cs0[3], cs1[1], cs1[3]};
#pragma unroll
                for (int bj = 0; bj < 2; ++bj) { const int head = 2 * (u.pn & 3) + bj; bf16_t* p = base + (size_t)row * 1024 + head * 128 + d0;
                    float o1[4], o2[4];
#pragma unroll
                    for (int e = 0; e < 4; ++e) { const float t1 = acc[ai][bj][m][0][e], t2 = acc[ai][bj][m][1][e]; o1[e] = (t1 * c[e] - t2 * s[e]) * sc; o2[e] = (t2 * c[e] + t1 * s[e]) * sc; }
                    u32x2 w1, w2; w1.x = pk_bf16(o1[0], o1[1]); w1.y = pk_bf16(o1[2], o1[3]); w2.x = pk_bf16(o2[0], o2[1]); w2.y = pk_bf16(o2[2], o2[3]);
                    *(u32x2*)p = w1; *(u32x2*)(p + 64) = w2; } }
    }
};

template <class Epi, class Sched, bool ALIGN_EPI = false, bool SP2 = false>
__device__ __forceinline__ void gemm_phase(PG8_LAS unsigned char* lds, const Gemm g, const Sched& S, const Epi& E) {
    const int tid = threadIdx.x, wid = __builtin_amdgcn_readfirstlane(tid >> 6), lane = tid & 63, wr = wid >> 2, wc = wid & 3, fr = lane & 15, fq = lane >> 4;
    const int K = g.K, nt = K / BK;
    unsigned voffA[2], voffB[2];
#pragma unroll
    for (int i = 0; i < 2; ++i) { int R, C; stage_rc(tid * 16 + i * 8192, R, C); const int Rb = Epi::PERM ? ((R & ~31) + perm32(R & 31)) : R;
        voffA[i] = (unsigned)(R * K + C) * 2u; voffB[i] = (unsigned)(Rb * K + C) * 2u; }
    const size_t kstep = (size_t)(BK * 2);
    const size_t hstep = (size_t)HALF * K * 2;
    const size_t tstep = 2 * hstep;
    const unsigned ldsw = (unsigned)wid * 1024u;
    const int aoff = lds_byte(wr * 64 + fr, fq * 8), boff = lds_byte(wc * 32 + fr, fq * 8);
#define PG8_SA(b, h) (((b) * 2 + (h)) * HTB)
#define PG8_SB(b, h) ((4 + (b) * 2 + (h)) * HTB)
#define PG8_STAGE(bufoff, gbase, voff) do { _Pragma("unroll") for (int _i = 0; _i < 2; ++_i) \
        __builtin_amdgcn_global_load_lds((const unsigned*)((const char*)(gbase) + (voff)[_i]), (PG8_LAS unsigned*)(lds + (bufoff) + ldsw + _i * 8192), 16, 0, 0); } while (0)
#define PG8_LDA(dst, b, h) do { _Pragma("unroll") for (int m = 0; m < 4; ++m) _Pragma("unroll") for (int k = 0; k < 2; ++k) dst[m][k] = *(const PG8_LAS bf16x8*)(lds + PG8_SA(b, h) + aoff + m * 2048 + k * 1024); } while (0)
#define PG8_LDB(dst, b, h) do { _Pragma("unroll") for (int n = 0; n < 2; ++n) _Pragma("unroll") for (int k = 0; k < 2; ++k) dst[n][k] = *(const PG8_LAS bf16x8*)(lds + PG8_SB(b, h) + boff + n * 2048 + k * 1024); } while (0)
#define PG8_MMA(ai, bj, At, Bt) do { __builtin_amdgcn_s_setprio(1); _Pragma("unroll") for (int m = 0; m < 4; ++m) _Pragma("unroll") for (int n = 0; n < 2; ++n) _Pragma("unroll") for (int k = 0; k < 2; ++k) \
        acc[ai][bj][m][n] = __builtin_amdgcn_mfma_f32_16x16x32_bf16(Bt[n][k], At[m][k], acc[ai][bj][m][n], 0, 0, 0); __builtin_amdgcn_s_setprio(0); } while (0)
#define PG8_WAIT_V(n) asm volatile("s_waitcnt vmcnt(" #n ")" ::: "memory")
#define PG8_WAIT_L(n) asm volatile("s_waitcnt lgkmcnt(" #n ")" ::: "memory")
#define PG8_BAR __builtin_amdgcn_s_barrier()
#define PG8_SCHED __builtin_amdgcn_sched_barrier(0)
    Unit cur, nxt; int ui = 0;
    if (!S.next(0, cur)) return;
    f32x4 acc[2][2][4][2];
#pragma unroll
    for (int a = 0; a < 2; ++a)
#pragma unroll
        for (int b = 0; b < 2; ++b)
#pragma unroll
            for (int m = 0; m < 4; ++m)
#pragma unroll
                for (int n = 0; n < 2; ++n) acc[a][b][m][n] = (f32x4){0.f, 0.f, 0.f, 0.f};
    bf16x8 At[4][2], B0[2][2], B1[2][2];
    const char* cA = (const char*)g.A + (size_t)cur.pm * tstep; const char* cB = (const char*)g.Bt + (size_t)cur.pn * tstep;
    S.a_ready(cur);
    if constexpr (SP2) {
        PG8_STAGE(PG8_SB(0, 0), cB, voffB); PG8_STAGE(PG8_SB(0, 1), cB + hstep, voffB); PG8_STAGE(PG8_SA(0, 0), cA, voffA); PG8_STAGE(PG8_SA(0, 1), cA + hstep, voffA);
        if (wr == 1) PG8_BAR;
        PG8_WAIT_V(2); PG8_BAR;
        PG8_STAGE(PG8_SB(1, 0), cB + kstep, voffB); PG8_STAGE(PG8_SA(1, 0), cA + kstep, voffA); PG8_STAGE(PG8_SB(1, 1), cB + hstep + kstep, voffB);
        PG8_WAIT_V(6); PG8_BAR;
    } else {
        PG8_STAGE(PG8_SB(0, 0), cB, voffB); PG8_STAGE(PG8_SA(0, 0), cA, voffA); PG8_STAGE(PG8_SB(0, 1), cB + hstep, voffB); PG8_STAGE(PG8_SA(0, 1), cA + hstep, voffA);
        if (wr == 1) PG8_BAR;
        PG8_WAIT_V(4); PG8_BAR;
        PG8_STAGE(PG8_SB(1, 0), cB + kstep, voffB); PG8_STAGE(PG8_SA(1, 0), cA + kstep, voffA); PG8_STAGE(PG8_SB(1, 1), cB + hstep + kstep, voffB);
        PG8_WAIT_V(6); PG8_BAR;
    }
    for (;;) {
        const bool has_next = S.next(ui + 1, nxt);
        const char* nA = has_next ? (const char*)g.A + (size_t)nxt.pm * tstep : cA; const char* nB = has_next ? (const char*)g.Bt + (size_t)nxt.pn * tstep : cB;
        for (int t = 0; t < nt; t += 2) {
            const bool last = (t == nt - 2);
            const char* a1 = cA + (size_t)(t + 1) * kstep;
            const char* a2 = last ? nA : cA + (size_t)(t + 2) * kstep; const char* b2 = last ? nB : cB + (size_t)(t + 2) * kstep;
            const char* a3 = a2 + kstep; const char* b3 = b2 + kstep;
            if (last && has_next) S.a_ready(nxt);
            if constexpr (SP2) {
            PG8_LDB(B0, 0, 0); PG8_LDB(B1, 0, 1); PG8_SCHED; PG8_LDA(At, 0, 0); PG8_STAGE(PG8_SA(1, 1), a1 + hstep, voffA);
            PG8_WAIT_V(8); PG8_WAIT_L(0); PG8_BAR; PG8_MMA(0, 0, At, B0); PG8_MMA(0, 1, At, B1); PG8_BAR; PG8_SCHED;
            PG8_LDA(At, 0, 1); PG8_STAGE(PG8_SB(0, 0), b2, voffB); PG8_STAGE(PG8_SB(0, 1), b2 + hstep, voffB); PG8_STAGE(PG8_SA(0, 0), a2, voffA);
            PG8_WAIT_V(8); PG8_WAIT_L(0); PG8_BAR; PG8_MMA(1, 0, At, B0); PG8_MMA(1, 1, At, B1); PG8_BAR; PG8_SCHED;
            PG8_LDB(B0, 1, 0); PG8_LDB(B1, 1, 1); PG8_SCHED; PG8_LDA(At, 1, 0); PG8_STAGE(PG8_SA(0, 1), a2 + hstep, voffA);
            PG8_WAIT_V(8); PG8_WAIT_L(0); PG8_BAR; PG8_MMA(0, 0, At, B0); PG8_MMA(0, 1, At, B1); PG8_BAR; PG8_SCHED;
            PG8_LDA(At, 1, 1); PG8_STAGE(PG8_SB(1, 0), b3, voffB); PG8_STAGE(PG8_SB(1, 1), b3 + hstep, voffB); PG8_STAGE(PG8_SA(1, 0), a3, voffA);
            PG8_WAIT_V(8); PG8_WAIT_L(0); PG8_BAR; PG8_MMA(1, 0, At, B0); PG8_MMA(1, 1, At, B1); PG8_BAR; PG8_SCHED;
            } else {
            PG8_LDB(B0, 0, 0); PG8_SCHED; PG8_LDA(At, 0, 0); PG8_STAGE(PG8_SA(1, 1), a1 + hstep, voffA);
            PG8_WAIT_L(8); PG8_BAR; PG8_WAIT_L(0); PG8_MMA(0, 0, At, B0); PG8_BAR; PG8_SCHED;
            PG8_LDB(B1, 0, 1); PG8_STAGE(PG8_SB(0, 0), b2, voffB);
            PG8_BAR; PG8_WAIT_L(0); PG8_MMA(0, 1, At, B1); PG8_BAR;
            PG8_LDA(At, 0, 1); PG8_STAGE(PG8_SA(0, 0), a2, voffA);
            PG8_BAR; PG8_WAIT_L(0); PG8_MMA(1, 0, At, B0); PG8_BAR; PG8_SCHED;
            PG8_STAGE(PG8_SB(0, 1), b2 + hstep, voffB);
            PG8_WAIT_V(6); PG8_BAR; PG8_MMA(1, 1, At, B1); PG8_BAR;
            PG8_LDB(B0, 1, 0); PG8_SCHED; PG8_LDA(At, 1, 0); PG8_STAGE(PG8_SA(0, 1), a2 + hstep, voffA);
            PG8_WAIT_L(8); PG8_BAR; PG8_WAIT_L(0); PG8_MMA(0, 0, At, B0); PG8_BAR; PG8_SCHED;
            PG8_LDB(B1, 1, 1); PG8_STAGE(PG8_SB(1, 0), b3, voffB);
            PG8_BAR; PG8_WAIT_L(0); PG8_MMA(0, 1, At, B1); PG8_BAR;
            PG8_LDA(At, 1, 1); PG8_STAGE(PG8_SA(1, 0), a3, voffA);
            PG8_BAR; PG8_WAIT_L(0); PG8_MMA(1, 0, At, B0); PG8_BAR; PG8_SCHED;
            PG8_STAGE(PG8_SB(1, 1), b3 + hstep, voffB);
            PG8_WAIT_V(6); PG8_BAR; PG8_MMA(1, 1, At, B1); PG8_BAR;
            }
        }
        if constexpr (ALIGN_EPI) { if (wr == 0) PG8_BAR; }
        if constexpr (!Epi::AFTER_DRAIN) { E(acc, cur, wr, wc, fr, fq); S.done(cur); }
        if (!has_next) break;
#pragma unroll
        for (int a = 0; a < 2; ++a)
#pragma unroll
            for (int b = 0; b < 2; ++b)
#pragma unroll
                for (int m = 0; m < 4; ++m)
#pragma unroll
                    for (int n = 0; n < 2; ++n) acc[a][b][m][n] = (f32x4){0.f, 0.f, 0.f, 0.f};
        cur = nxt; cA = nA; cB = nB; ++ui;
        if constexpr (ALIGN_EPI) { if (wr == 1) PG8_BAR; }
    }
    PG8_WAIT_V(0);
    if constexpr (!ALIGN_EPI) { if (wr == 0) PG8_BAR; }
    PG8_BAR;
    if constexpr (Epi::AFTER_DRAIN) { E.fused(acc, cur, wr, wc, fr, fq, lds, wid, lane); S.done(cur); }
#undef PG8_SA
#undef PG8_SB
#undef PG8_STAGE
#undef PG8_LDA
#undef PG8_LDB
#undef PG8_MMA
#undef PG8_WAIT_V
#undef PG8_WAIT_L
#undef PG8_BAR
#undef PG8_SCHED
}
}

#define LAS __attribute__((address_space(3)))
typedef unsigned short bf16;
typedef float f32x4 __attribute__((ext_vector_type(4)));
typedef unsigned u32x4 __attribute__((ext_vector_type(4)));
typedef unsigned u32x2 __attribute__((ext_vector_type(2)));
typedef short bf16x8 __attribute__((ext_vector_type(8)));
typedef short s16x4 __attribute__((ext_vector_type(4)));
typedef float f32x2 __attribute__((ext_vector_type(2)));
constexpr int NB = 4, SEQ = 4096, DM = 2048, MT = NB * SEQ, DFF = 5632, NGU = 2 * DFF, NIN = 5120, AW = 1024, NH = 8, NMOD = 9 * DM, CK = 31;
constexpr float EPS = 1e-6f;
constexpr int NTHR = 512, NWAVES = 8;
#ifndef WG_GU
#define WG_GU 2
#endif
#ifndef WG_DN
#define WG_DN 4
#endif
#ifndef WG_IN
#define WG_IN 2
#endif
constexpr int KSPLIT = 28, NCG = NMOD / 4;
constexpr size_t MiB = 1u << 20;
constexpr size_t WS_MODP = 0, WS_MOD = 8 * MiB, WS_CTL = 8 * MiB + 512 * 1024, CTL_BYTES = 16384, WS_ROPE = 9 * MiB;
constexpr size_t WS_WGU1 = 12 * MiB, WS_WD1 = 56 * MiB, WS_WIN = 78 * MiB, WS_WOUT = 98 * MiB, WS_WGU2 = 106 * MiB, WS_WD2 = 150 * MiB;
constexpr size_t WS_H = 172 * MiB, WS_F = 236 * MiB, WS_ACT = 300 * MiB;
constexpr size_t WS_Q = 300 * MiB, WS_K = 332 * MiB, WS_V = 364 * MiB, WS_U = 396 * MiB;
constexpr size_t WS_O = 476 * MiB, WS_LSE = 572 * MiB, WS_END = 574 * MiB;
static_assert((size_t)KSPLIT * 4 * NMOD * 4 <= 8 * MiB && WS_ACT + (size_t)MT * DFF * 2 <= WS_O && WS_U + 32 * MiB <= WS_O, "ws map");
constexpr int LDS_BYTES = 147456;

struct Args { const float* in[24]; float* out; unsigned char* ws; };
enum { I_X = 0, I_C, I_WADA, I_BADA, I_F1PRE, I_F1G, I_F1U, I_F1D, I_F1POST, I_MIXPRE, I_WIN, I_CONVW, I_CONVB, I_LNG, I_LNB, I_AOG, I_COG, I_WOUT, I_MIXPOST, I_F2PRE, I_F2G, I_F2U, I_F2D, I_F2POST };

__device__ __forceinline__ unsigned pk2(float lo, float hi) { return pg8::pk_bf16(lo, hi); }
__device__ __forceinline__ float bf_lo(unsigned w) { return __builtin_bit_cast(float, w << 16); }
__device__ __forceinline__ float bf_hi(unsigned w) { return __builtin_bit_cast(float, w & 0xffff0000u); }
__device__ __forceinline__ float wave_sum(float v) {
#pragma unroll
    for (int o = 1; o < 64; o <<= 1) v += __shfl_xor(v, o);
    return v;
}

__device__ __forceinline__ int inv_perm32(int hc) { return 16 * ((hc >> 2) & 1) + 4 * (hc >> 3) + (hc & 3); }
__device__ __forceinline__ int dest_row(int kind, int n) {
    if (kind == 0 || kind == 1) return 256 * (n >> 7) + 128 * kind + 32 * ((n & 127) >> 5) + inv_perm32(n & 31);
    if (kind == 2) return (n & ~31) + inv_perm32(n & 31);
    if (n < 2048) { const int sec = n >> 10, hh = (n >> 7) & 7, cc = n & 127, nn = cc >> 6, d = cc & 63; return sec * 1024 + hh * 128 + 32 * (d >> 4) + 16 * nn + (d & 15); }
    if (n < 3072) return (n & ~31) + inv_perm32(n & 31);
    { const int chn = (n - 3072) & 1023, isg = (n >= 4096) ? 1 : 0; return 3072 + 256 * (chn >> 7) + 128 * isg + 32 * ((chn & 127) >> 5) + inv_perm32(chn & 31); }
}
struct TrItem { const float* W; bf16* WT; int K, N, kind, kb, nb; };
__device__ __forceinline__ TrItem tr_decode(const Args& a, int it) {
    constexpr int IT_G = (DM / 64) * (DFF / 64), IT_IN = (DM / 64) * (NIN / 64), IT_OUT = (DM / 64) * (DM / 64);
    unsigned char* ws = a.ws; TrItem t; int r = it;
    auto ffn = [&](int r2, const float* g, const float* u, const float* d, size_t wgu, size_t wd) {
        const int w = r2 / IT_G; const int q = r2 - w * IT_G;
        if (w == 0) { t.W = g; t.WT = (bf16*)(ws + wgu); t.K = DM; t.N = DFF; t.kind = 0; t.kb = q / (DFF / 64); t.nb = q % (DFF / 64); }
        else if (w == 1) { t.W = u; t.WT = (bf16*)(ws + wgu); t.K = DM; t.N = DFF; t.kind = 1; t.kb = q / (DFF / 64); t.nb = q % (DFF / 64); }
        else { t.W = d; t.WT = (bf16*)(ws + wd); t.K = DFF; t.N = DM; t.kind = 2; t.kb = q / (DM / 64); t.nb = q % (DM / 64); } };
    if (r < 3 * IT_G) { ffn(r, a.in[I_F1G], a.in[I_F1U], a.in[I_F1D], WS_WGU1, WS_WD1); return t; }
    r -= 3 * IT_G;
    if (r < IT_IN) { t.W = a.in[I_WIN]; t.WT = (bf16*)(ws + WS_WIN); t.K = DM; t.N = NIN; t.kind = 3; t.kb = r / (NIN / 64); t.nb = r % (NIN / 64); return t; }
    r -= IT_IN;
    if (r < IT_OUT) { t.W = a.in[I_WOUT]; t.WT = (bf16*)(ws + WS_WOUT); t.K = DM; t.N = DM; t.kind = 2; t.kb = r / (DM / 64); t.nb = r % (DM / 64); return t; }
    r -= IT_OUT;
    ffn(r, a.in[I_F2G], a.in[I_F2U], a.in[I_F2D], WS_WGU2, WS_WD2); return t;
}
__device__ __forceinline__ void tr_load(const TrItem& t, f32x4 (&v)[16], int lane) {
    const int lr = lane >> 4, lc = lane & 15;
    const f32x4* src = (const f32x4*)(t.W + (size_t)(64 * t.kb + lr) * t.N + 64 * t.nb) + lc;
#pragma unroll
    for (int i = 0; i < 16; ++i) v[i] = __builtin_nontemporal_load(src + (size_t)i * t.N);
}
__device__ __forceinline__ void tr_store(const TrItem& t, const f32x4 (&v)[16], LAS float* scr, int lane) {
    const int k0 = 64 * t.kb, n0 = 64 * t.nb, lr = lane >> 4, lc = lane & 15;
#pragma unroll
    for (int i = 0; i < 16; ++i) { LAS float* d = scr + (4 * i + lr) * 65 + 4 * lc; d[0] = v[i][0]; d[1] = v[i][1]; d[2] = v[i][2]; d[3] = v[i][3]; }
    const int c = lane & 7;
#pragma unroll
    for (int j = 0; j < 8; ++j) { const int nn = (lane >> 3) + 8 * j; const LAS float* s = scr + (8 * c) * 65 + nn;
        u32x4 o; o.x = pk2(s[0], s[65]); o.y = pk2(s[2 * 65], s[3 * 65]); o.z = pk2(s[4 * 65], s[5 * 65]); o.w = pk2(s[6 * 65], s[7 * 65]);
        const int dr = dest_row(t.kind, n0 + nn);
        *(u32x4*)(t.WT + (size_t)dr * t.K + k0 + 8 * c) = o; }
}
__device__ __forceinline__ void p0_prologue(const Args& a, LAS unsigned char* lds, int tid, int lane, int wave) {
    unsigned char* ws = a.ws;
    const int gtid = blockIdx.x * NTHR + tid, gw = blockIdx.x * NWAVES + wave, NGT = gridDim.x * NTHR, NGW = gridDim.x * NWAVES;
    {
        LAS float* cact = (LAS float*)lds;
        for (int i = tid; i < NB * DM; i += NTHR) { const int b = i >> 11, k = i & 2047; const float v = a.in[I_C][i]; cact[k * 4 + b] = v / (1.0f + __expf(-v)); }
        __syncthreads();
        float* part = (float*)(ws + WS_MODP);
        for (int t = gtid; t < NCG * KSPLIT; t += NGT) {
            const int ks = t / NCG, cgp = t % NCG, k0 = ks * DM / KSPLIT, k1 = (ks + 1) * DM / KSPLIT;
            const f32x4* W = (const f32x4*)a.in[I_WADA] + cgp;
            f32x4 acc0 = {0, 0, 0, 0}, acc1 = acc0, acc2 = acc0, acc3 = acc0;
#pragma unroll 8
            for (int k = k0; k < k1; ++k) { const f32x4 w = __builtin_nontemporal_load(W + (size_t)k * NCG); const f32x4 cv = *(const LAS f32x4*)(cact + 4 * k);
                acc0 += w * cv[0]; acc1 += w * cv[1]; acc2 += w * cv[2]; acc3 += w * cv[3]; }
            f32x4* pp = (f32x4*)(part + (size_t)ks * 4 * NMOD) + cgp;
            pp[0] = acc0; pp[NCG] = acc1; pp[2 * NCG] = acc2; pp[3 * NCG] = acc3;
        }
        __syncthreads();
    }
    {
        float* tab = (float*)(ws + WS_ROPE);
        for (int i = gtid; i < SEQ * 64; i += NGT) { const int pos = i >> 6, f = i & 63; const float inv = powf(10000.0f, -(float)f * (1.0f / 64.0f)); const float ang = (float)pos * inv;
            float sn, cs; sincosf(ang, &sn, &cs); tab[2 * i] = cs; tab[2 * i + 1] = sn; }
    }
    {
        LAS float* scr = (LAS float*)(lds + wave * 16640);
        constexpr int NITEMS = 6 * (DM / 64) * (DFF / 64) + (DM / 64) * (NIN / 64) + (DM / 64) * (DM / 64);
        int it = gw;
        if (it < NITEMS) {
            f32x4 va[16], vb[16];
            TrItem cur = tr_decode(a, it); tr_load(cur, va, lane);
            for (;;) {
                const int nx = it + NGW; const bool more = nx < NITEMS; TrItem nxt = cur;
                if (more) { nxt = tr_decode(a, nx); tr_load(nxt, vb, lane); }
                tr_store(cur, va, scr, lane);
                if (!more) break;
#pragma unroll
                for (int i = 0; i < 16; ++i) va[i] = vb[i];
                cur = nxt; it = nx;
            }
        }
    }
}
__device__ __forceinline__ void p0b_modreduce(const Args& a, int tid) {
    const float* part = (const float*)(a.ws + WS_MODP); float* mod = (float*)(a.ws + WS_MOD);
    for (int i = blockIdx.x * NTHR + tid; i < NB * NMOD; i += gridDim.x * NTHR) { const int n = i % NMOD; float s = a.in[I_BADA][n];
#pragma unroll 4
        for (int ks = 0; ks < KSPLIT; ++ks) s += part[(size_t)ks * 4 * NMOD + i];
        mod[i] = s; }
}

template <bool XIN16> struct XRow { u32x4 w[XIN16 ? 4 : 8]; };
template <bool XIN16> __device__ __forceinline__ void xrow_load(XRow<XIN16>& r, const void* xin, size_t row, int lane) {
    if (XIN16) {
#pragma unroll
        for (int j = 0; j < 4; ++j) r.w[j] = __builtin_nontemporal_load((const u32x4*)((const bf16*)xin + row * DM + 8 * (lane + 64 * j)));
    } else {
#pragma unroll
        for (int j = 0; j < 4; ++j) { const u32x4* p = (const u32x4*)((const float*)xin + row * DM + 8 * (lane + 64 * j)); r.w[2 * j] = __builtin_nontemporal_load(p); r.w[2 * j + 1] = __builtin_nontemporal_load(p + 1); }
    }
}
template <bool XIN16> __device__ __forceinline__ void xrow_unpack(const XRow<XIN16>& r, f32x4 (&x)[8]) {
    if (XIN16) {
#pragma unroll
        for (int j = 0; j < 4; ++j) { const u32x4 w = r.w[j]; x[2 * j] = (f32x4){bf_lo(w.x), bf_hi(w.x), bf_lo(w.y), bf_hi(w.y)}; x[2 * j + 1] = (f32x4){bf_lo(w.z), bf_hi(w.z), bf_lo(w.w), bf_hi(w.w)}; }
    } else {
#pragma unroll
        for (int q = 0; q < 8; ++q) x[q] = __builtin_bit_cast(f32x4, r.w[q]);
    }
}
template <bool HAS_RES, bool HAS_H, bool XIN16, bool XOUT16>
__device__ __forceinline__ void rowpass(const void* xin, const bf16* f, void* xout, bf16* hout, const float* post_g, const float* gate, float coef,
                                        const float* pre_g, const float* sc, const float* sh, int lane, int wave) {
    const int NGW = gridDim.x * NWAVES;
    for (int grp = blockIdx.x * NWAVES + wave; grp < MT / 8; grp += NGW) {
        const int r0 = grp * 8, b = r0 >> 12;
        f32x4 A[8], Bm[8];
#pragma unroll
        for (int j = 0; j < 4; ++j)
#pragma unroll
            for (int hh = 0; hh < 2; ++hh) { const int col = 8 * (lane + 64 * j) + 4 * hh;
                if (HAS_RES) { const f32x4 g = *(const f32x4*)(gate + (size_t)b * NMOD + col), pg = *(const f32x4*)(post_g + col); A[2 * j + hh] = g * pg * coef; }
                if (HAS_H) { const f32x4 s = *(const f32x4*)(sc + (size_t)b * NMOD + col), pg = *(const f32x4*)(pre_g + col); Bm[2 * j + hh] = pg * (s + 1.0f); }
            }
        XRow<XIN16> xc, xn; u32x4 fc[4], fn[4];
        xrow_load<XIN16>(xc, xin, (size_t)r0, lane);
        if (HAS_RES) {
#pragma unroll
            for (int j = 0; j < 4; ++j) fc[j] = __builtin_nontemporal_load((const u32x4*)(f + (size_t)r0 * DM + 8 * (lane + 64 * j)));
        }
#pragma unroll 1
        for (int rr = 0; rr < 8; ++rr) {
            const size_t row = (size_t)(r0 + rr);
            { const size_t rn = rr < 7 ? row + 1 : row;
              xrow_load<XIN16>(xn, xin, rn, lane);
              if (HAS_RES) {
#pragma unroll
                  for (int j = 0; j < 4; ++j) fn[j] = __builtin_nontemporal_load((const u32x4*)(f + rn * DM + 8 * (lane + 64 * j)));
              } }
            f32x4 x[8]; xrow_unpack<XIN16>(xc, x);
            if (HAS_RES) {
                float ss = 0.f;
#pragma unroll
                for (int j = 0; j < 4; ++j)
#pragma unroll
                    for (int e = 0; e < 4; ++e) { const float lo = bf_lo(fc[j][e]), hi = bf_hi(fc[j][e]); ss += lo * lo + hi * hi; }
                const float r1 = __builtin_amdgcn_rsqf(wave_sum(ss) * (1.0f / DM) + EPS);
#pragma unroll
                for (int j = 0; j < 4; ++j) { const u32x4 w = fc[j];
                    x[2 * j] += A[2 * j] * (f32x4){bf_lo(w.x), bf_hi(w.x), bf_lo(w.y), bf_hi(w.y)} * r1; x[2 * j + 1] += A[2 * j + 1] * (f32x4){bf_lo(w.z), bf_hi(w.z), bf_lo(w.w), bf_hi(w.w)} * r1; }
                if (XOUT16) {
#pragma unroll
                    for (int j = 0; j < 4; ++j) { u32x4 w; w.x = pk2(x[2 * j][0], x[2 * j][1]); w.y = pk2(x[2 * j][2], x[2 * j][3]); w.z = pk2(x[2 * j + 1][0], x[2 * j + 1][1]); w.w = pk2(x[2 * j + 1][2], x[2 * j + 1][3]);
                        *(u32x4*)((bf16*)xout + row * DM + 8 * (lane + 64 * j)) = w;
                        x[2 * j] = (f32x4){bf_lo(w.x), bf_hi(w.x), bf_lo(w.y), bf_hi(w.y)}; x[2 * j + 1] = (f32x4){bf_lo(w.z), bf_hi(w.z), bf_lo(w.w), bf_hi(w.w)}; }
                } else {
#pragma unroll
                    for (int j = 0; j < 4; ++j) { f32x4* p = (f32x4*)((float*)xout + row * DM + 8 * (lane + 64 * j)); p[0] = x[2 * j]; p[1] = x[2 * j + 1]; }
                }
            }
            if (HAS_H) {
                float ss = 0.f;
#pragma unroll
                for (int q = 0; q < 8; ++q) ss += (x[q][0] * x[q][0] + x[q][1] * x[q][1]) + (x[q][2] * x[q][2] + x[q][3] * x[q][3]);
                const float r2 = __builtin_amdgcn_rsqf(wave_sum(ss) * (1.0f / DM) + EPS);
#pragma unroll
                for (int j = 0; j < 4; ++j) { const f32x4* shp = (const f32x4*)(sh + (size_t)b * NMOD + 8 * (lane + 64 * j));
                    const f32x4 h0 = x[2 * j] * r2 * Bm[2 * j] + shp[0], h1 = x[2 * j + 1] * r2 * Bm[2 * j + 1] + shp[1];
                    u32x4 w; w.x = pk2(h0[0], h0[1]); w.y = pk2(h0[2], h0[3]); w.z = pk2(h1[0], h1[1]); w.w = pk2(h1[2], h1[3]);
                    *(u32x4*)(hout + row * DM + 8 * (lane + 64 * j)) = w; }
            }
            xc = xn;
            if (HAS_RES) {
#pragma unroll
                for (int j = 0; j < 4; ++j) fc[j] = fn[j];
            }
        }
    }
}

__device__ __forceinline__ unsigned swz(unsigned row, unsigned ch) { return 256u * row + 16u * (ch ^ (((row & 7u) << 1) | ((row >> 3) & 1u))); }
__device__ __forceinline__ s16x4 vtr(const LAS unsigned char* p) { return __builtin_bit_cast(s16x4, __builtin_amdgcn_ds_read_tr16_b64_v4i16((LAS s16x4*)p)); }
struct AttnItem { int dsh, b, h, r, m0; size_t obase; };
__device__ __forceinline__ AttnItem attn_decode(int idx) {
    AttnItem it; const int p = idx >> 10, rem = idx & 1023, t = rem & 31; it.b = rem >> 8; it.h = (rem >> 5) & 7; it.dsh = 2 * p;
    const int ngrp = (SEQ >> it.dsh) >> 7; it.r = t / ngrp; it.m0 = (t % ngrp) * 128; it.obase = (size_t)p; return it;
}
__device__ __forceinline__ void attn_issue(const AttnItem& it, const bf16* __restrict__ Kb, const bf16* __restrict__ Vb, int tid, u32x4 (&kreg)[8], u32x4 (&vreg)[8]) {
    const int ch = tid & 15, rr = tid >> 4, L = SEQ >> it.dsh;
    const size_t bh = (size_t)it.b * SEQ * AW + (size_t)it.h * 128 + 8 * ch;
#pragma unroll
    for (int i = 0; i < 8; ++i) { int km = it.m0 - 64 + 32 * i + rr; km = km < 0 ? 0 : (km > L - 1 ? L - 1 : km); const size_t off = bh + (size_t)((km << it.dsh) + it.r) * AW;
        kreg[i] = *(const u32x4*)(Kb + off); vreg[i] = *(const u32x4*)(Vb + off); }
}
__device__ __forceinline__ void attn_phase(const Args& a, LAS unsigned char* lds, int tid, int lane, int wave) {
    unsigned char* ws = a.ws;
    const bf16 *Q = (const bf16*)(ws + WS_Q), *Kb = (const bf16*)(ws + WS_K), *Vb = (const bf16*)(ws + WS_V);
    LAS unsigned char* kimg = lds; LAS unsigned char* vimg = lds + 65536;
    const int fr = lane & 15, fq = lane >> 4, G = gridDim.x;
    const unsigned q4 = (unsigned)(lane & 15) >> 2, p4 = (unsigned)lane & 3u;
    constexpr int NITEM = 3 * NB * NH * 32;
    const bool xcd_order = (G == 256);
    const int istep = xcd_order ? 32 : G;
    int idx = xcd_order ? ((int)(blockIdx.x & 7) * (NITEM / 8) + (int)(blockIdx.x >> 3)) : (int)blockIdx.x;
    const int iend = xcd_order ? ((int)(blockIdx.x & 7) + 1) * (NITEM / 8) : NITEM;
    if (idx >= iend) return;
    u32x4 kreg[8], vreg[8];
    AttnItem it = attn_decode(idx);
    attn_issue(it, Kb, Vb, tid, kreg, vreg);
    for (;;) {
        const int L = SEQ >> it.dsh, m0 = it.m0 + 16 * wave;
        const size_t bh = (size_t)it.b * SEQ * AW + (size_t)it.h * 128;
        const int qpos = ((m0 + fr) << it.dsh) + it.r;
        bf16x8 qf[4];
        { const bf16x8* qp = (const bf16x8*)(Q + bh + (size_t)qpos * AW) + fq;
#pragma unroll
          for (int kk = 0; kk < 4; ++kk) qf[kk] = qp[4 * kk]; }
        __syncthreads();
        { const unsigned ch = tid & 15, rr = tid >> 4;
#pragma unroll
          for (int i = 0; i < 8; ++i) { const unsigned o = swz(32u * i + rr, ch); *(LAS u32x4*)(kimg + o) = kreg[i]; *(LAS u32x4*)(vimg + o) = vreg[i]; } }
        __syncthreads();
        const int nidx = idx + istep; const bool has_next = nidx < iend;
        AttnItem nit = it;
        if (has_next) { nit = attn_decode(nidx); attn_issue(nit, Kb, Vb, tid, kreg, vreg); }
        f32x4 s[10];
        const unsigned wrow = 16u * wave;
#pragma unroll
        for (int blk = 0; blk < 9; ++blk) {
            f32x4 acc = {0.f, 0.f, 0.f, 0.f};
#pragma unroll
            for (int kk = 0; kk < 4; ++kk) { const bf16x8 kf = *(const LAS bf16x8*)(kimg + swz(wrow + 16u * blk + fr, 4u * kk + fq)); acc = __builtin_amdgcn_mfma_f32_16x16x32_bf16(kf, qf[kk], acc, 0, 0, 0); }
            s[blk] = acc;
        }
        float mx = -1e30f;
#pragma unroll
        for (int j = 0; j < 4; ++j) { s[0][j] = (4 * fq + j - fr >= 0) ? s[0][j] : -1e30f; s[8][j] = (4 * fq + j - fr <= 0) ? s[8][j] : -1e30f; }
        if (m0 < 64 || m0 + 80 > L) {
#pragma unroll
            for (int blk = 0; blk < 9; ++blk)
#pragma unroll
                for (int j = 0; j < 4; ++j) { const int km = m0 - 64 + 16 * blk + 4 * fq + j; s[blk][j] = (km >= 0 && km < L) ? s[blk][j] : -1e30f; }
        }
#pragma unroll
        for (int blk = 0; blk < 9; ++blk)
#pragma unroll
            for (int j = 0; j < 4; ++j) mx = fmaxf(mx, s[blk][j]);
        mx = fmaxf(mx, __shfl_xor(mx, 16)); mx = fmaxf(mx, __shfl_xor(mx, 32));
        float l = 0.f;
#pragma unroll
        for (int blk = 0; blk < 9; ++blk)
#pragma unroll
            for (int j = 0; j < 4; ++j) { const float p = __builtin_amdgcn_exp2f(s[blk][j] - mx); s[blk][j] = p; l += p; }
        s[9] = (f32x4){0.f, 0.f, 0.f, 0.f};
        l += __shfl_xor(l, 16); l += __shfl_xor(l, 32);
        f32x4 o[8];
#pragma unroll
        for (int c = 0; c < 8; ++c) o[c] = (f32x4){0.f, 0.f, 0.f, 0.f};
#pragma unroll
        for (int ks = 0; ks < 5; ++ks) {
            u32x4 pw; pw.x = pk2(s[2 * ks][0], s[2 * ks][1]); pw.y = pk2(s[2 * ks][2], s[2 * ks][3]); pw.z = pk2(s[2 * ks + 1][0], s[2 * ks + 1][1]); pw.w = pk2(s[2 * ks + 1][2], s[2 * ks + 1][3]);
            const bf16x8 pb = __builtin_bit_cast(bf16x8, pw);
            const unsigned r0 = wrow + 32u * ks + 4u * fq + q4, r1 = (ks == 4) ? r0 : r0 + 16u;
#pragma unroll
            for (int c = 0; c < 8; ++c) {
                const s16x4 a0 = vtr(vimg + swz(r0, 2u * c + (p4 >> 1)) + 8u * (p4 & 1u));
                const s16x4 a1 = vtr(vimg + swz(r1, 2u * c + (p4 >> 1)) + 8u * (p4 & 1u));
                const bf16x8 av = {a0[0], a0[1], a0[2], a0[3], a1[0], a1[1], a1[2], a1[3]};
                o[c] = __builtin_amdgcn_mfma_f32_16x16x32_bf16(av, pb, o[c], 0, 0, 0);
            }
        }
        const float inv = 1.0f / l;
        bf16* op = (bf16*)(ws + WS_O + it.obase * 32 * MiB) + bh + (size_t)qpos * AW + 4 * fq;
#pragma unroll
        for (int c = 0; c < 8; ++c) { u32x2 w; w.x = pk2(o[c][0] * inv, o[c][1] * inv); w.y = pk2(o[c][2] * inv, o[c][3] * inv); *(u32x2*)(op + 16 * c) = w; }
        if (fq == 0) ((float*)(ws + WS_LSE) + it.obase * MT * NH)[((size_t)it.b * SEQ + qpos) * NH + it.h] = mx + __log2f(l);
        if (!has_next) break;
        it = nit; idx = nidx;
    }
}

__device__ __forceinline__ void unpack16(const u32x4 a, const u32x4 b, float* v) {
    v[0] = bf_lo(a.x); v[1] = bf_hi(a.x); v[2] = bf_lo(a.y); v[3] = bf_hi(a.y); v[4] = bf_lo(a.z); v[5] = bf_hi(a.z); v[6] = bf_lo(a.w); v[7] = bf_hi(a.w);
    v[8] = bf_lo(b.x); v[9] = bf_hi(b.x); v[10] = bf_lo(b.y); v[11] = bf_hi(b.y); v[12] = bf_lo(b.z); v[13] = bf_hi(b.z); v[14] = bf_lo(b.w); v[15] = bf_hi(b.w);
}
__device__ __forceinline__ void store16(bf16* p, const float* v) {
    u32x4 a, b; a.x = pk2(v[0], v[1]); a.y = pk2(v[2], v[3]); a.z = pk2(v[4], v[5]); a.w = pk2(v[6], v[7]); b.x = pk2(v[8], v[9]); b.y = pk2(v[10], v[11]); b.z = pk2(v[12], v[13]); b.w = pk2(v[14], v[15]);
    ((u32x4*)p)[0] = a; ((u32x4*)p)[1] = b;
}
#ifndef RING
#define RING 4
#endif
__device__ __forceinline__ void mixpost_phase(const Args& a, LAS unsigned char* lds, int tid, int lane, int wave) {
    unsigned char* ws = a.ws;
    for (int i = tid; i < CK * 1024 / 4; i += NTHR) ((LAS f32x4*)lds)[i] = ((const f32x4*)a.in[I_CONVW])[i];
    __syncthreads();
    const bf16* U = (const bf16*)(ws + WS_U); bf16* MG = (bf16*)(ws + WS_H);
    const float* lse = (const float*)(ws + WS_LSE);
    const int NGW = gridDim.x * NWAVES, c0 = 16 * lane, head = lane >> 3;
    for (int grp = blockIdx.x * NWAVES + wave; grp < MT / 4; grp += NGW) {
        const int row0 = grp * 4, b = row0 >> 12, s0 = row0 & 4095;
        u32x4 ring[RING][2], w3[3][2];
#define CONV_ISSUE(dst, sp_) do { const int sp = (sp_); const bool ok = (sp >= 0) && (sp < SEQ); const u32x4* p = (const u32x4*)(U + ((size_t)b * SEQ + (ok ? sp : 0)) * AW + c0); \
            dst[0] = p[0]; dst[1] = p[1]; if (!ok) { dst[0] = (u32x4){0u, 0u, 0u, 0u}; dst[1] = dst[0]; } } while (0)
#define CONV_UNPACK(slot, src) do { const u32x4 q0 = src[0], q1 = src[1]; \
            win[slot][0] = (f32x2){bf_lo(q0.x), bf_hi(q0.x)}; win[slot][1] = (f32x2){bf_lo(q0.y), bf_hi(q0.y)}; win[slot][2] = (f32x2){bf_lo(q0.z), bf_hi(q0.z)}; win[slot][3] = (f32x2){bf_lo(q0.w), bf_hi(q0.w)}; \
            win[slot][4] = (f32x2){bf_lo(q1.x), bf_hi(q1.x)}; win[slot][5] = (f32x2){bf_lo(q1.y), bf_hi(q1.y)}; win[slot][6] = (f32x2){bf_lo(q1.z), bf_hi(q1.z)}; win[slot][7] = (f32x2){bf_lo(q1.w), bf_hi(q1.w)}; } while (0)
        CONV_ISSUE(w3[0], s0 - 15); CONV_ISSUE(w3[1], s0 - 14); CONV_ISSUE(w3[2], s0 - 13);
#pragma unroll
        for (int j = 0; j < RING; ++j) CONV_ISSUE(ring[j], s0 - 12 + j);
#pragma unroll 1
        for (int t = 0; t < 4; ++t) {
            const size_t row = (size_t)(row0 + t);
            float l0 = lse[row * NH + head], l1 = lse[(size_t)MT * NH + row * NH + head], l2 = lse[(size_t)2 * MT * NH + row * NH + head];
            const u32x4* p0 = (const u32x4*)((const bf16*)(ws + WS_O) + row * AW + c0); const u32x4 a00 = p0[0], a01 = p0[1];
            const u32x4* p1 = (const u32x4*)((const bf16*)(ws + WS_O + 32 * MiB) + row * AW + c0); const u32x4 a10 = p1[0], a11 = p1[1];
            const u32x4* p2 = (const u32x4*)((const bf16*)(ws + WS_O + 64 * MiB) + row * AW + c0); const u32x4 a20 = p2[0], a21 = p2[1];
            const float mx = fmaxf(l0, fmaxf(l1, l2)); float w0 = __builtin_amdgcn_exp2f(l0 - mx), w1 = __builtin_amdgcn_exp2f(l1 - mx), w2 = __builtin_amdgcn_exp2f(l2 - mx);
            const float iw = 1.0f / (w0 + w1 + w2); w0 *= iw; w1 *= iw; w2 *= iw;
            float v[16], acc[16];
            unpack16(a00, a01, v);
#pragma unroll
            for (int i = 0; i < 16; ++i) acc[i] = w0 * v[i];
            unpack16(a10, a11, v);
#pragma unroll
            for (int i = 0; i < 16; ++i) acc[i] += w1 * v[i];
            unpack16(a20, a21, v);
#pragma unroll
            for (int i = 0; i < 16; ++i) acc[i] += w2 * v[i];
            float ss = 0.f;
#pragma unroll
            for (int i = 0; i < 16; ++i) ss += acc[i] * acc[i];
            const float rs = __builtin_amdgcn_rsqf(wave_sum(ss) * (1.0f / AW) + EPS);
#pragma unroll
            for (int i = 0; i < 16; i += 4) { const f32x4 g = *(const f32x4*)(a.in[I_AOG] + c0 + i); acc[i] *= rs * g[0]; acc[i + 1] *= rs * g[1]; acc[i + 2] *= rs * g[2]; acc[i + 3] *= rs * g[3]; }
            store16(MG + row * DM + c0, acc);
        }
        f32x2 cacc2[4][8], win[4][8];
#pragma unroll
        for (int t = 0; t < 4; ++t)
#pragma unroll
            for (int i = 0; i < 8; ++i) cacc2[t][i] = (f32x2){0.f, 0.f};
        CONV_UNPACK(0, w3[0]); CONV_UNPACK(1, w3[1]); CONV_UNPACK(2, w3[2]);
#pragma unroll 1
        for (int kb = 0; kb < 32; kb += RING) {
#pragma unroll
            for (int j = 0; j < RING; ++j) { const int k = kb + j;
                if (k < CK) {
                    CONV_UNPACK((j + 3) & 3, ring[j]);
                    if (k + RING < CK) CONV_ISSUE(ring[j], s0 - 12 + k + RING);
                    f32x2 w[8];
#pragma unroll
                    for (int i = 0; i < 4; ++i) { const f32x4 wv = *(const LAS f32x4*)(lds + ((size_t)k * 1024 + c0 + 4 * i) * 4); w[2 * i] = (f32x2){wv[0], wv[1]}; w[2 * i + 1] = (f32x2){wv[2], wv[3]}; }
#pragma unroll
                    for (int t = 0; t < 4; ++t)
#pragma unroll
                        for (int i = 0; i < 8; ++i) cacc2[t][i] = __builtin_elementwise_fma(w[i], win[(t + j) & 3][i], cacc2[t][i]);
                } }
        }
#undef CONV_ISSUE
#undef CONV_UNPACK
        float cacc[4][16];
#pragma unroll
        for (int t = 0; t < 4; ++t)
#pragma unroll
            for (int i = 0; i < 8; ++i) { cacc[t][2 * i] = cacc2[t][i][0]; cacc[t][2 * i + 1] = cacc2[t][i][1]; }
        float cb[16], lg[16], lb[16], og[16];
#pragma unroll
        for (int i = 0; i < 16; i += 4) { const f32x4 x0 = *(const f32x4*)(a.in[I_CONVB] + c0 + i), x1 = *(const f32x4*)(a.in[I_LNG] + c0 + i), x2 = *(const f32x4*)(a.in[I_LNB] + c0 + i), x3 = *(const f32x4*)(a.in[I_COG] + c0 + i);
#pragma unroll
            for (int e = 0; e < 4; ++e) { cb[i + e] = x0[e]; lg[i + e] = x1[e]; lb[i + e] = x2[e]; og[i + e] = x3[e]; } }
#pragma unroll
        for (int t = 0; t < 4; ++t) {
            float sm = 0.f;
#pragma unroll
            for (int i = 0; i < 16; ++i) { cacc[t][i] += cb[i]; sm += cacc[t][i]; }
            const float mu = wave_sum(sm) * (1.0f / 1024.0f); float sv = 0.f;
#pragma unroll
            for (int i = 0; i < 16; ++i) { cacc[t][i] -= mu; sv += cacc[t][i] * cacc[t][i]; }
            const float rs = __builtin_amdgcn_rsqf(wave_sum(sv) * (1.0f / 1024.0f) + EPS); float s2 = 0.f;
#pragma unroll
            for (int i = 0; i < 16; ++i) { const float y = cacc[t][i] * rs * lg[i] + lb[i]; const float z = y * pg8::sigmoid_f(y); cacc[t][i] = z; s2 += z * z; }
            const float r2 = __builtin_amdgcn_rsqf(wave_sum(s2) * (1.0f / 1024.0f) + EPS);
#pragma unroll
            for (int i = 0; i < 16; ++i) cacc[t][i] *= r2 * og[i];
            store16(MG + (size_t)(row0 + t) * DM + 1024 + c0, cacc[t]);
        }
    }
}

#define XB_TMO      128
#define XB_XCNT(j)  (256  + 64 * (j))
#define XB_XSUB(j)  (1280 + 64 * (j))
#define XB_XGEN(j)  (2304 + 64 * (j))
#define XB_TOP      3328
#define XB_TOPGEN   3392
#define XCD_BAR_WORDS 3456
#define XB_SPIN_CAP (1u << 18)

__device__ __forceinline__ unsigned xb_ld(unsigned* p)              { return __hip_atomic_load(p, __ATOMIC_RELAXED, __HIP_MEMORY_SCOPE_AGENT); }
__device__ __forceinline__ unsigned xb_add(unsigned* p, unsigned v) { return __hip_atomic_fetch_add(p, v, __ATOMIC_RELAXED, __HIP_MEMORY_SCOPE_AGENT); }
__device__ __forceinline__ unsigned xb_xcc_id() { return (unsigned)__builtin_amdgcn_s_getreg((3 << 11) | 20) & 0xFu; }
#define XB_SPIN(cond, bar) do { unsigned _sp = 0; while (cond) { __builtin_amdgcn_s_sleep(1); \
    if ((++_sp & 255u) == 0u) { if (xb_ld(&(bar)[XB_TMO])) break; if (_sp > XB_SPIN_CAP) { atomicAdd(&(bar)[XB_TMO], 1u); break; } } } } while (0)

struct XcdBarrier {
    unsigned* bar; unsigned x;
    volatile LAS unsigned* st;
};

__device__ __forceinline__ XcdBarrier xcd_barrier_post(unsigned* bar, volatile LAS unsigned* st) {
    XcdBarrier b; b.bar = bar; b.x = xb_xcc_id(); b.st = st;
    if (threadIdx.x == 0) (void)xb_add(&bar[XB_XCNT(b.x)], 1u);
    return b;
}
__device__ __forceinline__ void xcd_barrier_complete(unsigned* bar, unsigned x, unsigned& nloc, unsigned& nx) {
    const unsigned G = gridDim.x * gridDim.y * gridDim.z;
    unsigned sum, cnt, mine, sp = 0u;
    for (;;) {
        sum = 0u; cnt = 0u; mine = 0u;
#pragma unroll
        for (unsigned j = 0; j < 16; ++j) { const unsigned c = xb_ld(&bar[XB_XCNT(j)]); sum += c; cnt += (c > 0u) ? 1u : 0u; mine = (j == x) ? c : mine; }
        if (sum == G) break;
        __builtin_amdgcn_s_sleep(1);
        if ((++sp & 255u) == 0u) { if (xb_ld(&bar[XB_TMO])) break; if (sp > XB_SPIN_CAP) { atomicAdd(&bar[XB_TMO], 1u); break; } }
    }
    nloc = mine > 0u ? mine : 1u; nx = cnt > 0u ? cnt : 1u;
}

__device__ __forceinline__ void xcd_barrier(const XcdBarrier& b) {
    asm volatile("s_waitcnt vmcnt(0)" ::: "memory");
    __syncthreads();
    if (threadIdx.x == 0) {
        unsigned* bar = b.bar;
        __builtin_amdgcn_s_waitcnt(0);
        unsigned nloc = b.st[0], nx = b.st[1];
        if (nloc == 0u) { xcd_barrier_complete(bar, b.x, nloc, nx); b.st[0] = nloc; b.st[1] = nx; }
        const unsigned old = xb_add(&bar[XB_XSUB(b.x)], 1u);
        const unsigned gen = old / nloc;
        if (old + 1u == (gen + 1u) * nloc) {
            __builtin_amdgcn_fence(__ATOMIC_RELEASE, "agent");
            asm volatile("s_waitcnt vmcnt(0)" ::: "memory");
            const unsigned og = xb_add(&bar[XB_TOP], 1u);
            const unsigned tg = og / nx;
            if (og + 1u == (tg + 1u) * nx) xb_add(&bar[XB_TOPGEN], 1u);
            else XB_SPIN(xb_ld(&bar[XB_TOPGEN]) == tg, bar);
            __builtin_amdgcn_fence(__ATOMIC_ACQUIRE, "agent");
            xb_add(&bar[XB_XGEN(b.x)], 1u);
            asm volatile("s_waitcnt vmcnt(0)" ::: "memory");
        } else {
            XB_SPIN(xb_ld(&bar[XB_XGEN(b.x)]) == gen, bar);
            __builtin_amdgcn_fence(__ATOMIC_ACQUIRE, "agent");
            asm volatile("s_waitcnt vmcnt(0)" ::: "memory");
        }
    }
    __syncthreads();
}


__global__ void __launch_bounds__(NTHR, 2) fwd_megakernel(Args a) {
    extern __shared__ __attribute__((aligned(16))) unsigned char lds_raw[];
    LAS unsigned char* lds = (LAS unsigned char*)lds_raw;
    cg::grid_group grid = cg::this_grid();
    volatile LAS unsigned* bst = (volatile LAS unsigned*)(lds + 147456 - 64);
    if (threadIdx.x < 2) bst[threadIdx.x] = 0u;
    __syncthreads();
    const XcdBarrier bar = xcd_barrier_post((unsigned*)(a.ws + WS_CTL), bst);
    const int tid0 = threadIdx.x, wave = __builtin_amdgcn_readfirstlane(tid0 >> 6), G = gridDim.x;
#define FRESH() int tid = tid0; asm volatile("" : "+v"(tid)); const int lane = tid & 63; (void)lane;
    unsigned char* ws = a.ws;
    const float* mod = (const float*)(ws + WS_MOD);
    bf16 *HB = (bf16*)(ws + WS_H), *FB = (bf16*)(ws + WS_F), *ACT = (bf16*)(ws + WS_ACT);

    { FRESH();
    p0_prologue(a, lds, tid, lane, wave);
    }
    if (a.ws == nullptr) grid.sync();
    xcd_barrier(bar);
    { FRESH();
    p0b_modreduce(a, tid);
    }
    xcd_barrier(bar);
    { FRESH();
    rowpass<false, true, false, false>(a.in[I_X], nullptr, nullptr, HB, nullptr, nullptr, 0.f, a.in[I_F1PRE], mod + 1 * DM, mod + 0 * DM, lane, wave);
    }
    xcd_barrier(bar);
    { FRESH();
    { pg8::Gemm g{HB, (const bf16*)(ws + WS_WGU1), MT, NGU, DM}; pg8::StaticOrder S; S.init(MT, NGU, G, (int)blockIdx.x); S.wg = WG_GU; pg8::EpiSwiGLU E{ACT, DFF};
      pg8::gemm_phase<pg8::EpiSwiGLU, pg8::StaticOrder, true, true>(lds, g, S, E); }
    }
    xcd_barrier(bar);
    { FRESH();
    { pg8::Gemm g{ACT, (const bf16*)(ws + WS_WD1), MT, DM, DFF}; pg8::StaticOrder S; S.init(MT, DM, G, (int)blockIdx.x); S.wg = WG_DN; pg8::EpiPlain E{FB, DM};
      pg8::gemm_phase<pg8::EpiPlain, pg8::StaticOrder, true, true>(lds, g, S, E); }
    }
    xcd_barrier(bar);
    { FRESH();
    rowpass<true, true, false, true>(a.in[I_X], FB, a.out, HB, a.in[I_F1POST], mod + 2 * DM, 0.5f, a.in[I_MIXPRE], mod + 4 * DM, mod + 3 * DM, lane, wave);
    }
    xcd_barrier(bar);
    { FRESH();
    { pg8::Gemm g{HB, (const bf16*)(ws + WS_WIN), MT, NIN, DM}; pg8::StaticOrder S; S.init(MT, NIN, G, (int)blockIdx.x); S.wg = WG_IN;
      pg8::EpiIn E{(bf16*)(ws + WS_Q), (bf16*)(ws + WS_K), (bf16*)(ws + WS_V), (bf16*)(ws + WS_U), (const float*)(ws + WS_ROPE), 0.08838834764831845f * 1.4426950408889634f};
      pg8::gemm_phase<pg8::EpiIn, pg8::StaticOrder, true, true>(lds, g, S, E); }
    }
    xcd_barrier(bar);
    { FRESH();
    attn_phase(a, lds, tid, lane, wave);
    }
    xcd_barrier(bar);
    { FRESH();
    mixpost_phase(a, lds, tid, lane, wave);
    }
    xcd_barrier(bar);
    { FRESH();
    { pg8::Gemm g{HB, (const bf16*)(ws + WS_WOUT), MT, DM, DM}; pg8::StaticOrder S; S.init(MT, DM, G, (int)blockIdx.x); S.wg = WG_DN; pg8::EpiPlain E{FB, DM};
      pg8::gemm_phase<pg8::EpiPlain, pg8::StaticOrder, true, true>(lds, g, S, E); }
    }
    xcd_barrier(bar);
    { FRESH();
    rowpass<true, true, true, true>(a.out, FB, ws + WS_O, HB, a.in[I_MIXPOST], mod + 5 * DM, 1.0f, a.in[I_F2PRE], mod + 7 * DM, mod + 6 * DM, lane, wave);
    }
    xcd_barrier(bar);
    { FRESH();
    { pg8::Gemm g{HB, (const bf16*)(ws + WS_WGU2), MT, NGU, DM}; pg8::StaticOrder S; S.init(MT, NGU, G, (int)blockIdx.x); S.wg = WG_GU; pg8::EpiSwiGLU E{ACT, DFF};
      pg8::gemm_phase<pg8::EpiSwiGLU, pg8::StaticOrder, true, true>(lds, g, S, E); }
    }
    xcd_barrier(bar);
    { FRESH();
    { pg8::Gemm g{ACT, (const bf16*)(ws + WS_WD2), MT, DM, DFF}; pg8::StaticOrder S; S.init(MT, DM, G, (int)blockIdx.x); S.wg = WG_DN; pg8::EpiPlain E{FB, DM};
      pg8::gemm_phase<pg8::EpiPlain, pg8::StaticOrder, true, true>(lds, g, S, E); }
    }
    xcd_barrier(bar);
    { FRESH();
    rowpass<true, false, true, false>(ws + WS_O, FB, a.out, nullptr, a.in[I_F2POST], mod + 8 * DM, 0.5f, nullptr, nullptr, nullptr, lane, wave);
    }
}

extern "C" void kernel_launch(void* const* d_in, const int* in_sizes, int n_in, void* d_out, int out_size, void* d_ws, size_t ws_size, hipStream_t stream) {
    static int grid = 0;
    if (grid == 0) {
        if (n_in != 24 || out_size != MT * DM || ws_size < WS_END) { fprintf(stderr, "kernel_launch: unexpected shapes (n_in %d, out %d, ws %zu); nothing launched\n", n_in, out_size, ws_size); grid = -1; return; }
        int dev = 0, cus = 0, per_cu = 0;
        (void)hipGetDevice(&dev); (void)hipDeviceGetAttribute(&cus, hipDeviceAttributeMultiprocessorCount, dev);
        if (hipFuncSetAttribute((const void*)fwd_megakernel, hipFuncAttributeMaxDynamicSharedMemorySize, LDS_BYTES) != hipSuccess) { fprintf(stderr, "kernel_launch: hipFuncSetAttribute failed\n"); grid = -1; return; }
        if (hipOccupancyMaxActiveBlocksPerMultiprocessor(&per_cu, (const void*)fwd_megakernel, NTHR, LDS_BYTES) != hipSuccess || per_cu < 1) { fprintf(stderr, "kernel_launch: occupancy query says %d\n", per_cu); per_cu = 1; }
        (void)hipGetLastError();
        grid = cus * 1;
        if (grid <= 0) grid = 256;
    }
    if (grid < 0) return;
    if (hipMemsetAsync((char*)d_ws + WS_CTL, 0, CTL_BYTES, stream) != hipSuccess) { fprintf(stderr, "kernel_launch: memset of the barrier words failed\n"); return; }
    Args a{};
    for (int i = 0; i < 24; ++i) a.in[i] = (const float*)d_in[i];
    a.out = (float*)d_out; a.ws = (unsigned char*)d_ws;
    void* args[] = {&a};
    hipError_t e = hipLaunchCooperativeKernel((const void*)fwd_megakernel, dim3(grid), dim3(NTHR), args, LDS_BYTES, stream);
    if (e != hipSuccess) fprintf(stderr, "cooperative launch failed: %s (grid %d)\n", hipGetErrorString(e), grid);
}
```

```cpp
#include <hip/hip_runtime.h>
#include <hip/hip_cooperative_groups.h>
#include <cstdio>
#include <cstdint>
namespace cg = cooperative_groups;
namespace pg8 {
#define PG8_LAS __attribute__((address_space(3)))
typedef unsigned short bf16_t;
typedef short bf16x8 __attribute__((ext_vector_type(8)));
typedef float f32x4 __attribute__((ext_vector_type(4)));
typedef unsigned u32x4 __attribute__((ext_vector_type(4)));
constexpr int BM = 256, BK = 64, HALF = 128, HTB = HALF * BK * 2  , STAGE_BYTES = 8 * HTB, NXCD = 8, WGM = 8;

__host__ __device__ __forceinline__ int lds_byte(int r, int c) { const int st = (r >> 4) * 2 + (c >> 5), rr = r & 15, cc = c & 31, ob = rr * 64 + cc * 2; return st * 1024 + (ob ^ (((ob >> 9) & 1) << 5)); }
__host__ __device__ __forceinline__ void stage_rc(int b, int& R, int& C) { const int st = b / 1024, sb = b % 1024, swz = sb ^ (((sb >> 9) & 1) << 5); R = (st >> 1) * 16 + swz / 64; C = (st & 1) * 32 + (swz % 64) / 2; }
__host__ __device__ __forceinline__ int perm32(int rho) { const int n = rho >> 4, i = rho & 15; return 8 * (i >> 2) + 4 * n + (i & 3); }

struct Unit { int pm, pn; };
struct Gemm { const bf16_t* A; const bf16_t* Bt; int M, N, K; };

struct StaticOrder {
    int nM, nN, nwg, G, c, wg = WGM;
    __host__ __device__ void init(int M, int N, int G_, int c_) { nM = M / BM; nN = N / BM; nwg = nM * nN; G = G_; c = c_; }
    __host__ __device__ bool next(int i, Unit& u) const {
        const long L = (long)i * G + c; if (L >= nwg) return false;
        int wgid = (int)L; { const int q = nwg / NXCD, r = nwg % NXCD, xcd = wgid % NXCD, off = wgid / NXCD; wgid = (xcd < r ? xcd * (q + 1) : r * (q + 1) + (xcd - r) * q) + off; }
        const int nig = wg * nN, gid = wgid / nig, fm = gid * wg, gsz = (nM - fm) < wg ? (nM - fm) : wg;
        u.pm = fm + ((wgid % nig) % gsz); u.pn = (wgid % nig) / gsz; return true;
    }
    __device__ __forceinline__ void a_ready(const Unit&) const {}
    __device__ __forceinline__ void done(const Unit&) const {}
};

typedef float f32x2_t __attribute__((ext_vector_type(2)));
typedef __bf16 bf16x2_t __attribute__((ext_vector_type(2)));
__device__ __forceinline__ unsigned pk_bf16(float lo, float hi) { f32x2_t v = {lo, hi}; bf16x2_t b = __builtin_convertvector(v, bf16x2_t); return __builtin_bit_cast(unsigned, b); }
__device__ __forceinline__ float sigmoid_f(float x) { return __builtin_amdgcn_rcpf(1.0f + __builtin_amdgcn_exp2f(-1.44269504089f * x)); }
typedef unsigned u32x2 __attribute__((ext_vector_type(2)));

template <int MODE> __device__ __forceinline__ void epi_glu_store(const f32x4 (&acc)[2][2][4][2], bf16_t* O, int ldc, int row0, int col0) {
#pragma unroll
    for (int ai = 0; ai < 2; ++ai)
#pragma unroll
        for (int m = 0; m < 4; ++m) {
            bf16_t* rowp = O + (size_t)(row0 + ai * HALF + m * 16) * ldc + col0;
            float r[8];
#pragma unroll
            for (int n = 0; n < 2; ++n)
#pragma unroll
                for (int e = 0; e < 4; ++e) { const float a = acc[ai][0][m][n][e], b = acc[ai][1][m][n][e];
                    r[4 * n + e] = (MODE == 0) ? (a * sigmoid_f(a)) * b : a * sigmoid_f(b); }
            u32x4 w; w.x = pk_bf16(r[0], r[1]); w.y = pk_bf16(r[2], r[3]); w.z = pk_bf16(r[4], r[5]); w.w = pk_bf16(r[6], r[7]);
            *(u32x4*)rowp = w; }
}
__device__ __forceinline__ void epi_plain_store(const f32x4 (&acc)[2][2][4][2], bf16_t* O, int ldc, int row0, int col0) {
#pragma unroll
    for (int ai = 0; ai < 2; ++ai)
#pragma unroll
        for (int m = 0; m < 4; ++m) {
            bf16_t* rowp = O + (size_t)(row0 + ai * HALF + m * 16) * ldc + col0;
#pragma unroll
            for (int bj = 0; bj < 2; ++bj) { const f32x4 v0 = acc[ai][bj][m][0], v1 = acc[ai][bj][m][1];
                u32x4 w; w.x = pk_bf16(v0[0], v0[1]); w.y = pk_bf16(v0[2], v0[3]); w.z = pk_bf16(v1[0], v1[1]); w.w = pk_bf16(v1[2], v1[3]);
                *(u32x4*)(rowp + bj * HALF) = w; } }
}
__device__ __forceinline__ float clamp448(float v) { return __builtin_fminf(__builtin_fmaxf(v, -448.0f), 448.0f); }
__device__ __forceinline__ unsigned pk4_fp8(float a, float b, float c, float d) {
    int w = 0; w = __builtin_amdgcn_cvt_pk_fp8_f32(clamp448(a), clamp448(b), w, false); w = __builtin_amdgcn_cvt_pk_fp8_f32(clamp448(c), clamp448(d), w, true); return (unsigned)w; }
struct EpiSwiGLU8 {
    static constexpr bool PERM = false, AFTER_DRAIN = false;
    unsigned char* O; int ldc; float scale;
    __device__ __forceinline__ void operator()(const f32x4 (&acc)[2][2][4][2], const Unit& u, int wr, int wc, int fr, int fq) const {
        const int row0 = u.pm * BM + wr * 64 + fr, col0 = u.pn * HALF + wc * 32 + 8 * fq;
#pragma unroll
        for (int ai = 0; ai < 2; ++ai)
#pragma unroll
            for (int m = 0; m < 4; ++m) {
                unsigned char* rowp = O + (size_t)(row0 + ai * HALF + m * 16) * ldc + col0;
                float r[8];
#pragma unroll
                for (int n = 0; n < 2; ++n)
#pragma unroll
                    for (int e = 0; e < 4; ++e) { const float a = acc[ai][0][m][n][e], b = acc[ai][1][m][n][e]; r[4 * n + e] = (a * sigmoid_f(a)) * b * scale; }
                u32x2 w; w.x = pk4_fp8(r[0], r[1], r[2], r[3]); w.y = pk4_fp8(r[4], r[5], r[6], r[7]);
                *(u32x2*)rowp = w; }
    }
};
struct EpiPlainScaled {
    static constexpr bool PERM = false, AFTER_DRAIN = false;
    bf16_t* O; int ldc; float oscale;
    __device__ __forceinline__ void operator()(const f32x4 (&acc)[2][2][4][2], const Unit& u, int wr, int wc, int fr, int fq) const {
        const int row0 = u.pm * BM + wr * 64 + fr, col0 = u.pn * BM + wc * 32 + 8 * fq;
#pragma unroll
        for (int ai = 0; ai < 2; ++ai)
#pragma unroll
            for (int m = 0; m < 4; ++m) {
                bf16_t* rowp = O + (size_t)(row0 + ai * HALF + m * 16) * ldc + col0;
#pragma unroll
                for (int bj = 0; bj < 2; ++bj) { const f32x4 v0 = acc[ai][bj][m][0] * oscale, v1 = acc[ai][bj][m][1] * oscale;
                    u32x4 w; w.x = pk_bf16(v0[0], v0[1]); w.y = pk_bf16(v0[2], v0[3]); w.z = pk_bf16(v1[0], v1[1]); w.w = pk_bf16(v1[2], v1[3]);
                    *(u32x4*)(rowp + bj * HALF) = w; } }
    }
};
struct EpiSwiGLU {
    static constexpr bool PERM = false, AFTER_DRAIN = false;
    bf16_t* O; int ldc;
    __device__ __forceinline__ void operator()(const f32x4 (&acc)[2][2][4][2], const Unit& u, int wr, int wc, int fr, int fq) const {
        epi_glu_store<0>(acc, O, ldc, u.pm * BM + wr * 64 + fr, u.pn * HALF + wc * 32 + 8 * fq);
    }
};
struct EpiPlain {
    static constexpr bool PERM = false, AFTER_DRAIN = false;
    bf16_t* O; int ldc;
    __device__ __forceinline__ void operator()(const f32x4 (&acc)[2][2][4][2], const Unit& u, int wr, int wc, int fr, int fq) const {
        epi_plain_store(acc, O, ldc, u.pm * BM + wr * 64 + fr, u.pn * BM + wc * 32 + 8 * fq);
    }
};
struct EpiIn {
    static constexpr bool PERM = false, AFTER_DRAIN = false;
    bf16_t *Q, *K, *V, *U; const float* rope;
    float qscale;
    __device__ __forceinline__ void operator()(const f32x4 (&acc)[2][2][4][2], const Unit& u, int wr, int wc, int fr, int fq) const {
        const int row0 = u.pm * BM + wr * 64 + fr;
        if (u.pn >= 12) { epi_glu_store<1>(acc, U, 1024, row0, (u.pn - 12) * HALF + wc * 32 + 8 * fq); return; }
        if (u.pn >= 8) { epi_plain_store(acc, V, 1024, row0, (u.pn - 8) * BM + wc * 32 + 8 * fq); return; }
        const bool isq = u.pn < 4; bf16_t* base = isq ? Q : K; const float sc = isq ? qscale : 1.0f;
        const int d0 = 16 * wc + 4 * fq;
#pragma unroll
        for (int ai = 0; ai < 2; ++ai)
#pragma unroll
            for (int m = 0; m < 4; ++m) { const int row = row0 + ai * HALF + m * 16, pos = row & 4095;
                const f32x4 cs0 = *(const f32x4*)(rope + ((size_t)pos * 64 + d0) * 2), cs1 = *(const f32x4*)(rope + ((size_t)pos * 64 + d0) * 2 + 4);
                const float c[4] = {cs0[0], cs0[2], cs1[0], cs1[2]}, s[4] = {cs0[1], cs0[3], cs1[1], cs1[3]};
#pragma unroll
                for (int bj = 0; bj < 2; ++bj) { const int head = 2 * (u.pn & 3) + bj; bf16_t* p = base + (size_t)row * 1024 + head * 128 + d0;
                    float o1[4], o2[4];
#pragma unroll
                    for (int e = 0; e < 4; ++e) { const float t1 = acc[ai][bj][m][0][e], t2 = acc[ai][bj][m][1][e]; o1[e] = (t1 * c[e] - t2 * s[e]) * sc; o2[e] = (t2 * c[e] + t1 * s[e]) * sc; }
                    u32x2 w1, w2; w1.x = pk_bf16(o1[0], o1[1]); w1.y = pk_bf16(o1[2], o1[3]); w2.x = pk_bf16(o2[0], o2[1]); w2.y = pk_bf16(o2[2], o2[3]);
                    *(u32x2*)p = w1; *(u32x2*)(p + 64) = w2; } }
    }
};

typedef int i32x4 __attribute__((ext_vector_type(4)));
typedef int i32x8 __attribute__((ext_vector_type(8)));
__device__ __forceinline__ i32x8 cat8(bf16x8 lo, bf16x8 hi) { return __builtin_shufflevector(__builtin_bit_cast(i32x4, lo), __builtin_bit_cast(i32x4, hi), 0, 1, 2, 3, 4, 5, 6, 7); }
__device__ __forceinline__ void mfma_f8(f32x4& acc, const i32x8& b, const i32x8& a, int unit_scale) {
    asm volatile("v_mfma_scale_f32_16x16x128_f8f6f4 %0, %1, %2, %0, %3, %3 op_sel_hi:[0,0,0]" : "+v"(acc) : "v"(b), "v"(a), "v"(unit_scale));
}
template <class Epi, class Sched, bool ALIGN_EPI = false, bool SP2 = false, bool F8 = false>
__device__ __forceinline__ void gemm_phase(PG8_LAS unsigned char* lds, const Gemm g, const Sched& S, const Epi& E) {
    const int tid = threadIdx.x, wid = __builtin_amdgcn_readfirstlane(tid >> 6), lane = tid & 63, wr = wid >> 2, wc = wid & 3, fr = lane & 15, fq = lane >> 4;
    const int K = g.K, nt = K / BK;
    unsigned voffA[2], voffB[2];
#pragma unroll
    for (int i = 0; i < 2; ++i) { int R, C; stage_rc(tid * 16 + i * 8192, R, C); const int Rb = Epi::PERM ? ((R & ~31) + perm32(R & 31)) : R;
        voffA[i] = (unsigned)(R * K + C) * 2u; voffB[i] = (unsigned)(Rb * K + C) * 2u; }
    const size_t kstep = (size_t)(BK * 2);
    const size_t hstep = (size_t)HALF * K * 2;
    const size_t tstep = 2 * hstep;
    const unsigned ldsw = (unsigned)wid * 1024u;
    const int aoff = lds_byte(wr * 64 + fr, fq * 8), boff = lds_byte(wc * 32 + fr, fq * 8);
#define PG8_SA(b, h) (((b) * 2 + (h)) * HTB)
#define PG8_SB(b, h) ((4 + (b) * 2 + (h)) * HTB)
#define PG8_STAGE(bufoff, gbase, voff) do { _Pragma("unroll") for (int _i = 0; _i < 2; ++_i) \
        __builtin_amdgcn_global_load_lds((const unsigned*)((const char*)(gbase) + (voff)[_i]), (PG8_LAS unsigned*)(lds + (bufoff) + ldsw + _i * 8192), 16, 0, 0); } while (0)
#define PG8_LDA(dst, b, h) do { if constexpr (F8) { _Pragma("unroll") for (int m = 0; m < 4; ++m) dst##8[m] = cat8(*(const PG8_LAS bf16x8*)(lds + PG8_SA(b, h) + aoff + m * 2048), *(const PG8_LAS bf16x8*)(lds + PG8_SA(b, h) + aoff + m * 2048 + 1024)); } \
        else { _Pragma("unroll") for (int m = 0; m < 4; ++m) _Pragma("unroll") for (int k = 0; k < 2; ++k) dst[m][k] = *(const PG8_LAS bf16x8*)(lds + PG8_SA(b, h) + aoff + m * 2048 + k * 1024); } } while (0)
#define PG8_LDB(dst, b, h) do { if constexpr (F8) { _Pragma("unroll") for (int n = 0; n < 2; ++n) dst##8[n] = cat8(*(const PG8_LAS bf16x8*)(lds + PG8_SB(b, h) + boff + n * 2048), *(const PG8_LAS bf16x8*)(lds + PG8_SB(b, h) + boff + n * 2048 + 1024)); } \
        else { _Pragma("unroll") for (int n = 0; n < 2; ++n) _Pragma("unroll") for (int k = 0; k < 2; ++k) dst[n][k] = *(const PG8_LAS bf16x8*)(lds + PG8_SB(b, h) + boff + n * 2048 + k * 1024); } } while (0)
#define PG8_MMA(ai, bj, At, Bt) do { __builtin_amdgcn_s_setprio(1); \
        if constexpr (F8) { _Pragma("unroll") for (int m = 0; m < 4; ++m) _Pragma("unroll") for (int n = 0; n < 2; ++n) \
            mfma_f8(acc[ai][bj][m][n], Bt##8[n], At##8[m], 0x7F7F7F7F); } \
        else { _Pragma("unroll") for (int m = 0; m < 4; ++m) _Pragma("unroll") for (int n = 0; n < 2; ++n) _Pragma("unroll") for (int k = 0; k < 2; ++k) \
            acc[ai][bj][m][n] = __builtin_amdgcn_mfma_f32_16x16x32_bf16(Bt[n][k], At[m][k], acc[ai][bj][m][n], 0, 0, 0); } \
        __builtin_amdgcn_s_setprio(0); } while (0)
#define PG8_WAIT_V(n) asm volatile("s_waitcnt vmcnt(" #n ")" ::: "memory")
#define PG8_WAIT_L(n) asm volatile("s_waitcnt lgkmcnt(" #n ")" ::: "memory")
#define PG8_BAR __builtin_amdgcn_s_barrier()
#define PG8_SCHED __builtin_amdgcn_sched_barrier(0)
    Unit cur, nxt; int ui = 0;
    if (!S.next(0, cur)) return;
    f32x4 acc[2][2][4][2];
#pragma unroll
    for (int a = 0; a < 2; ++a)
#pragma unroll
        for (int b = 0; b < 2; ++b)
#pragma unroll
            for (int m = 0; m < 4; ++m)
#pragma unroll
                for (int n = 0; n < 2; ++n) acc[a][b][m][n] = (f32x4){0.f, 0.f, 0.f, 0.f};
    bf16x8 At[4][2], B0[2][2], B1[2][2]; i32x8 At8[4], B08[2], B18[2];
    const char* cA = (const char*)g.A + (size_t)cur.pm * tstep; const char* cB = (const char*)g.Bt + (size_t)cur.pn * tstep;
    S.a_ready(cur);
    if constexpr (SP2) {
        PG8_STAGE(PG8_SB(0, 0), cB, voffB); PG8_STAGE(PG8_SB(0, 1), cB + hstep, voffB); PG8_STAGE(PG8_SA(0, 0), cA, voffA); PG8_STAGE(PG8_SA(0, 1), cA + hstep, voffA);
        if (wr == 1) PG8_BAR;
        PG8_WAIT_V(2); PG8_BAR;
        PG8_STAGE(PG8_SB(1, 0), cB + kstep, voffB); PG8_STAGE(PG8_SA(1, 0), cA + kstep, voffA); PG8_STAGE(PG8_SB(1, 1), cB + hstep + kstep, voffB);
        PG8_WAIT_V(6); PG8_BAR;
    } else {
        PG8_STAGE(PG8_SB(0, 0), cB, voffB); PG8_STAGE(PG8_SA(0, 0), cA, voffA); PG8_STAGE(PG8_SB(0, 1), cB + hstep, voffB); PG8_STAGE(PG8_SA(0, 1), cA + hstep, voffA);
        if (wr == 1) PG8_BAR;
        PG8_WAIT_V(4); PG8_BAR;
        PG8_STAGE(PG8_SB(1, 0), cB + kstep, voffB); PG8_STAGE(PG8_SA(1, 0), cA + kstep, voffA); PG8_STAGE(PG8_SB(1, 1), cB + hstep + kstep, voffB);
        PG8_WAIT_V(6); PG8_BAR;
    }
    for (;;) {
        const bool has_next = S.next(ui + 1, nxt);
        const char* nA = has_next ? (const char*)g.A + (size_t)nxt.pm * tstep : cA; const char* nB = has_next ? (const char*)g.Bt + (size_t)nxt.pn * tstep : cB;
        for (int t = 0; t < nt; t += 2) {
            const bool last = (t == nt - 2);
            const char* a1 = cA + (size_t)(t + 1) * kstep;
            const char* a2 = last ? nA : cA + (size_t)(t + 2) * kstep; const char* b2 = last ? nB : cB + (size_t)(t + 2) * kstep;
            const char* a3 = a2 + kstep; const char* b3 = b2 + kstep;
            if (last && has_next) S.a_ready(nxt);
            if constexpr (SP2) {
            PG8_LDB(B0, 0, 0); PG8_LDB(B1, 0, 1); PG8_SCHED; PG8_LDA(At, 0, 0); PG8_STAGE(PG8_SA(1, 1), a1 + hstep, voffA);
            PG8_WAIT_V(8); PG8_WAIT_L(0); PG8_BAR; PG8_MMA(0, 0, At, B0); PG8_MMA(0, 1, At, B1); PG8_BAR; PG8_SCHED;
            PG8_LDA(At, 0, 1); PG8_STAGE(PG8_SB(0, 0), b2, voffB); PG8_STAGE(PG8_SB(0, 1), b2 + hstep, voffB); PG8_STAGE(PG8_SA(0, 0), a2, voffA);
            PG8_WAIT_V(8); PG8_WAIT_L(0); PG8_BAR; PG8_MMA(1, 0, At, B0); PG8_MMA(1, 1, At, B1); PG8_BAR; PG8_SCHED;
            PG8_LDB(B0, 1, 0); PG8_LDB(B1, 1, 1); PG8_SCHED; PG8_LDA(At, 1, 0); PG8_STAGE(PG8_SA(0, 1), a2 + hstep, voffA);
            PG8_WAIT_V(8); PG8_WAIT_L(0); PG8_BAR; PG8_MMA(0, 0, At, B0); PG8_MMA(0, 1, At, B1); PG8_BAR; PG8_SCHED;
            PG8_LDA(At, 1, 1); PG8_STAGE(PG8_SB(1, 0), b3, voffB); PG8_STAGE(PG8_SB(1, 1), b3 + hstep, voffB); PG8_STAGE(PG8_SA(1, 0), a3, voffA);
            PG8_WAIT_V(8); PG8_WAIT_L(0); PG8_BAR; PG8_MMA(1, 0, At, B0); PG8_MMA(1, 1, At, B1); PG8_BAR; PG8_SCHED;
            } else {
            PG8_LDB(B0, 0, 0); PG8_SCHED; PG8_LDA(At, 0, 0); PG8_STAGE(PG8_SA(1, 1), a1 + hstep, voffA);
            PG8_WAIT_L(8); PG8_BAR; PG8_WAIT_L(0); PG8_MMA(0, 0, At, B0); PG8_BAR; PG8_SCHED;
            PG8_LDB(B1, 0, 1); PG8_STAGE(PG8_SB(0, 0), b2, voffB);
            PG8_BAR; PG8_WAIT_L(0); PG8_MMA(0, 1, At, B1); PG8_BAR;
            PG8_LDA(At, 0, 1); PG8_STAGE(PG8_SA(0, 0), a2, voffA);
            PG8_BAR; PG8_WAIT_L(0); PG8_MMA(1, 0, At, B0); PG8_BAR; PG8_SCHED;
            PG8_STAGE(PG8_SB(0, 1), b2 + hstep, voffB);
            PG8_WAIT_V(6); PG8_BAR; PG8_MMA(1, 1, At, B1); PG8_BAR;
            PG8_LDB(B0, 1, 0); PG8_SCHED; PG8_LDA(At, 1, 0); PG8_STAGE(PG8_SA(0, 1), a2 + hstep, voffA);
            PG8_WAIT_L(8); PG8_BAR; PG8_WAIT_L(0); PG8_MMA(0, 0, At, B0); PG8_BAR; PG8_SCHED;
            PG8_LDB(B1, 1, 1); PG8_STAGE(PG8_SB(1, 0), b3, voffB);
            PG8_BAR; PG8_WAIT_L(0); PG8_MMA(0, 1, At, B1); PG8_BAR;
            PG8_LDA(At, 1, 1); PG8_STAGE(PG8_SA(1, 0), a3, voffA);
            PG8_BAR; PG8_WAIT_L(0); PG8_MMA(1, 0, At, B0); PG8_BAR; PG8_SCHED;
            PG8_STAGE(PG8_SB(1, 1), b3 + hstep, voffB);
            PG8_WAIT_V(6); PG8_BAR; PG8_MMA(1, 1, At, B1); PG8_BAR;
            }
        }
        if constexpr (ALIGN_EPI) { if (wr == 0) PG8_BAR; }
        if constexpr (F8) asm volatile("s_nop 15\n\ts_nop 15" ::: "memory");
        if constexpr (!Epi::AFTER_DRAIN) { E(acc, cur, wr, wc, fr, fq); S.done(cur); }
        if (!has_next) break;
#pragma unroll
        for (int a = 0; a < 2; ++a)
#pragma unroll
            for (int b = 0; b < 2; ++b)
#pragma unroll
                for (int m = 0; m < 4; ++m)
#pragma unroll
                    for (int n = 0; n < 2; ++n) acc[a][b][m][n] = (f32x4){0.f, 0.f, 0.f, 0.f};
        cur = nxt; cA = nA; cB = nB; ++ui;
        if constexpr (ALIGN_EPI) { if (wr == 1) PG8_BAR; }
    }
    PG8_WAIT_V(0);
    if constexpr (!ALIGN_EPI) { if (wr == 0) PG8_BAR; }
    PG8_BAR;
    if constexpr (Epi::AFTER_DRAIN) { E.fused(acc, cur, wr, wc, fr, fq, lds, wid, lane); S.done(cur); }
#undef PG8_SA
#undef PG8_SB
#undef PG8_STAGE
#undef PG8_LDA
#undef PG8_LDB
#undef PG8_MMA
#undef PG8_WAIT_V
#undef PG8_WAIT_L
#undef PG8_BAR
#undef PG8_SCHED
}
}

#define LAS __attribute__((address_space(3)))
typedef unsigned short bf16;
typedef float f32x4 __attribute__((ext_vector_type(4)));
typedef unsigned u32x4 __attribute__((ext_vector_type(4)));
typedef unsigned u32x2 __attribute__((ext_vector_type(2)));
typedef short bf16x8 __attribute__((ext_vector_type(8)));
typedef short s16x4 __attribute__((ext_vector_type(4)));
typedef float f32x2 __attribute__((ext_vector_type(2)));
constexpr int NB = 4, SEQ = 4096, DM = 2048, MT = NB * SEQ, DFF = 5632, NGU = 2 * DFF, NIN = 5120, AW = 1024, NH = 8, NMOD = 9 * DM, CK = 31;
constexpr float EPS = 1e-6f;
constexpr int NTHR = 512, NWAVES = 8;
#ifndef WG_GU
#define WG_GU 2
#endif
#ifndef WG_DN
#define WG_DN 4
#endif
#ifndef WG_IN
#define WG_IN 2
#endif
constexpr int KSPLIT = 28, NCG = NMOD / 4;
constexpr size_t MiB = 1u << 20;
constexpr size_t WS_MODP = 0, WS_MOD = 8 * MiB, WS_CTL = 8 * MiB + 512 * 1024, CTL_BYTES = 16384, WS_ROPE = 9 * MiB;
constexpr size_t WS_WGU1 = 12 * MiB, WS_WD1 = 56 * MiB, WS_WIN = 78 * MiB, WS_WOUT = 98 * MiB, WS_WGU2 = 106 * MiB, WS_WD2 = 150 * MiB;
constexpr size_t WS_H = 172 * MiB, WS_F = 236 * MiB, WS_ACT = 300 * MiB;
constexpr size_t WS_Q = 300 * MiB, WS_K = 332 * MiB, WS_V = 364 * MiB, WS_U = 396 * MiB;
constexpr size_t WS_O = 476 * MiB, WS_LSE = 572 * MiB, WS_END = 574 * MiB;
static_assert((size_t)KSPLIT * 4 * NMOD * 4 <= 8 * MiB && WS_ACT + (size_t)MT * DFF * 2 <= WS_O && WS_U + 32 * MiB <= WS_O, "ws map");
constexpr int LDS_BYTES = 147456;

struct Args { const float* in[24]; float* out; unsigned char* ws; };
enum { I_X = 0, I_C, I_WADA, I_BADA, I_F1PRE, I_F1G, I_F1U, I_F1D, I_F1POST, I_MIXPRE, I_WIN, I_CONVW, I_CONVB, I_LNG, I_LNB, I_AOG, I_COG, I_WOUT, I_MIXPOST, I_F2PRE, I_F2G, I_F2U, I_F2D, I_F2POST };

__device__ __forceinline__ unsigned pk2(float lo, float hi) { return pg8::pk_bf16(lo, hi); }
__device__ __forceinline__ float bf_lo(unsigned w) { return __builtin_bit_cast(float, w << 16); }
__device__ __forceinline__ float bf_hi(unsigned w) { return __builtin_bit_cast(float, w & 0xffff0000u); }
__device__ __forceinline__ float wave_sum(float v) {
#pragma unroll
    for (int o = 1; o < 64; o <<= 1) v += __shfl_xor(v, o);
    return v;
}

__device__ __forceinline__ int inv_perm32(int hc) { return 16 * ((hc >> 2) & 1) + 4 * (hc >> 3) + (hc & 3); }
__device__ __forceinline__ int dest_row(int kind, int n) {
    if (kind == 0 || kind == 1) return 256 * (n >> 7) + 128 * kind + 32 * ((n & 127) >> 5) + inv_perm32(n & 31);
    if (kind == 2 || kind == 4) return (n & ~31) + inv_perm32(n & 31);
    if (n < 2048) { const int sec = n >> 10, hh = (n >> 7) & 7, cc = n & 127, nn = cc >> 6, d = cc & 63; return sec * 1024 + hh * 128 + 32 * (d >> 4) + 16 * nn + (d & 15); }
    if (n < 3072) return (n & ~31) + inv_perm32(n & 31);
    { const int chn = (n - 3072) & 1023, isg = (n >= 4096) ? 1 : 0; return 3072 + 256 * (chn >> 7) + 128 * isg + 32 * ((chn & 127) >> 5) + inv_perm32(chn & 31); }
}
constexpr float A8_SCALE = 4.0f, W8_SCALE = 1024.0f, O8_SCALE = 1.0f / (4.0f * 1024.0f);
struct TrItem { const float* W; bf16* WT; int K, N, kind, kb, nb; };
__device__ __forceinline__ TrItem tr_decode(const Args& a, int it) {
    constexpr int IT_G = (DM / 64) * (DFF / 64), IT_IN = (DM / 64) * (NIN / 64), IT_OUT = (DM / 64) * (DM / 64);
    unsigned char* ws = a.ws; TrItem t; int r = it;
    auto ffn = [&](int r2, const float* g, const float* u, const float* d, size_t wgu, size_t wd, int dkind) {
        const int w = r2 / IT_G; const int q = r2 - w * IT_G;
        if (w == 0) { t.W = g; t.WT = (bf16*)(ws + wgu); t.K = DM; t.N = DFF; t.kind = 0; t.kb = q / (DFF / 64); t.nb = q % (DFF / 64); }
        else if (w == 1) { t.W = u; t.WT = (bf16*)(ws + wgu); t.K = DM; t.N = DFF; t.kind = 1; t.kb = q / (DFF / 64); t.nb = q % (DFF / 64); }
        else { t.W = d; t.WT = (bf16*)(ws + wd); t.K = DFF; t.N = DM; t.kind = dkind; t.kb = q / (DM / 64); t.nb = q % (DM / 64); } };
    if (r < 3 * IT_G) { ffn(r, a.in[I_F1G], a.in[I_F1U], a.in[I_F1D], WS_WGU1, WS_WD1, 2); return t; }
    r -= 3 * IT_G;
    if (r < IT_IN) { t.W = a.in[I_WIN]; t.WT = (bf16*)(ws + WS_WIN); t.K = DM; t.N = NIN; t.kind = 3; t.kb = r / (NIN / 64); t.nb = r % (NIN / 64); return t; }
    r -= IT_IN;
    if (r < IT_OUT) { t.W = a.in[I_WOUT]; t.WT = (bf16*)(ws + WS_WOUT); t.K = DM; t.N = DM; t.kind = 2; t.kb = r / (DM / 64); t.nb = r % (DM / 64); return t; }
    r -= IT_OUT;
    ffn(r, a.in[I_F2G], a.in[I_F2U], a.in[I_F2D], WS_WGU2, WS_WD2, 4); return t;
}
__device__ __forceinline__ void tr_load(const TrItem& t, f32x4 (&v)[16], int lane) {
    const int lr = lane >> 4, lc = lane & 15;
    const f32x4* src = (const f32x4*)(t.W + (size_t)(64 * t.kb + lr) * t.N + 64 * t.nb) + lc;
#pragma unroll
    for (int i = 0; i < 16; ++i) v[i] = __builtin_nontemporal_load(src + (size_t)i * t.N);
}
__device__ __forceinline__ void tr_store(const TrItem& t, const f32x4 (&v)[16], LAS float* scr, int lane) {
    const int k0 = 64 * t.kb, n0 = 64 * t.nb, lr = lane >> 4, lc = lane & 15;
#pragma unroll
    for (int i = 0; i < 16; ++i) { LAS float* d = scr + (4 * i + lr) * 65 + 4 * lc; d[0] = v[i][0]; d[1] = v[i][1]; d[2] = v[i][2]; d[3] = v[i][3]; }
    if (t.kind == 4) {
        const int c4 = lane & 3; unsigned char* W8 = (unsigned char*)t.WT;
#pragma unroll
        for (int j = 0; j < 4; ++j) { const int nn = (lane >> 2) + 16 * j; const LAS float* s = scr + (16 * c4) * 65 + nn;
            u32x4 o;
            o.x = pg8::pk4_fp8(s[0] * W8_SCALE, s[65] * W8_SCALE, s[2 * 65] * W8_SCALE, s[3 * 65] * W8_SCALE);
            o.y = pg8::pk4_fp8(s[4 * 65] * W8_SCALE, s[5 * 65] * W8_SCALE, s[6 * 65] * W8_SCALE, s[7 * 65] * W8_SCALE);
            o.z = pg8::pk4_fp8(s[8 * 65] * W8_SCALE, s[9 * 65] * W8_SCALE, s[10 * 65] * W8_SCALE, s[11 * 65] * W8_SCALE);
            o.w = pg8::pk4_fp8(s[12 * 65] * W8_SCALE, s[13 * 65] * W8_SCALE, s[14 * 65] * W8_SCALE, s[15 * 65] * W8_SCALE);
            const int dr = dest_row(4, n0 + nn);
            *(u32x4*)(W8 + (size_t)dr * t.K + k0 + 16 * c4) = o; }
        return;
    }
    const int c = lane & 7;
#pragma unroll
    for (int j = 0; j < 8; ++j) { const int nn = (lane >> 3) + 8 * j; const LAS float* s = scr + (8 * c) * 65 + nn;
        u32x4 o; o.x = pk2(s[0], s[65]); o.y = pk2(s[2 * 65], s[3 * 65]); o.z = pk2(s[4 * 65], s[5 * 65]); o.w = pk2(s[6 * 65], s[7 * 65]);
        const int dr = dest_row(t.kind, n0 + nn);
        *(u32x4*)(t.WT + (size_t)dr * t.K + k0 + 8 * c) = o; }
}
__device__ __forceinline__ void p0_prologue(const Args& a, LAS unsigned char* lds, int tid, int lane, int wave) {
    unsigned char* ws = a.ws;
    const int gtid = blockIdx.x * NTHR + tid, gw = blockIdx.x * NWAVES + wave, NGT = gridDim.x * NTHR, NGW = gridDim.x * NWAVES;
    {
        LAS float* cact = (LAS float*)lds;
        for (int i = tid; i < NB * DM; i += NTHR) { const int b = i >> 11, k = i & 2047; const float v = a.in[I_C][i]; cact[k * 4 + b] = v / (1.0f + __expf(-v)); }
        __syncthreads();
        float* part = (float*)(ws + WS_MODP);
        for (int t = gtid; t < NCG * KSPLIT; t += NGT) {
            const int ks = t / NCG, cgp = t % NCG, k0 = ks * DM / KSPLIT, k1 = (ks + 1) * DM / KSPLIT;
            const f32x4* W = (const f32x4*)a.in[I_WADA] + cgp;
            f32x4 acc0 = {0, 0, 0, 0}, acc1 = acc0, acc2 = acc0, acc3 = acc0;
#pragma unroll 8
            for (int k = k0; k < k1; ++k) { const f32x4 w = __builtin_nontemporal_load(W + (size_t)k * NCG); const f32x4 cv = *(const LAS f32x4*)(cact + 4 * k);
                acc0 += w * cv[0]; acc1 += w * cv[1]; acc2 += w * cv[2]; acc3 += w * cv[3]; }
            f32x4* pp = (f32x4*)(part + (size_t)ks * 4 * NMOD) + cgp;
            pp[0] = acc0; pp[NCG] = acc1; pp[2 * NCG] = acc2; pp[3 * NCG] = acc3;
        }
        __syncthreads();
    }
    {
        float* tab = (float*)(ws + WS_ROPE);
        for (int i = gtid; i < SEQ * 64; i += NGT) { const int pos = i >> 6, f = i & 63; const float inv = powf(10000.0f, -(float)f * (1.0f / 64.0f)); const float ang = (float)pos * inv;
            float sn, cs; sincosf(ang, &sn, &cs); tab[2 * i] = cs; tab[2 * i + 1] = sn; }
    }
    {
        LAS float* scr = (LAS float*)(lds + wave * 16640);
        constexpr int NITEMS = 6 * (DM / 64) * (DFF / 64) + (DM / 64) * (NIN / 64) + (DM / 64) * (DM / 64);
        int it = gw;
        if (it < NITEMS) {
            f32x4 va[16], vb[16];
            TrItem cur = tr_decode(a, it); tr_load(cur, va, lane);
            for (;;) {
                const int nx = it + NGW; const bool more = nx < NITEMS; TrItem nxt = cur;
                if (more) { nxt = tr_decode(a, nx); tr_load(nxt, vb, lane); }
                tr_store(cur, va, scr, lane);
                if (!more) break;
#pragma unroll
                for (int i = 0; i < 16; ++i) va[i] = vb[i];
                cur = nxt; it = nx;
            }
        }
    }
}
__device__ __forceinline__ void p0b_modreduce(const Args& a, int tid) {
    const float* part = (const float*)(a.ws + WS_MODP); float* mod = (float*)(a.ws + WS_MOD);
    for (int i = blockIdx.x * NTHR + tid; i < NB * NMOD; i += gridDim.x * NTHR) { const int n = i % NMOD; float s = a.in[I_BADA][n];
#pragma unroll 4
        for (int ks = 0; ks < KSPLIT; ++ks) s += part[(size_t)ks * 4 * NMOD + i];
        mod[i] = s; }
}

template <bool XIN16> struct XRow { u32x4 w[XIN16 ? 4 : 8]; };
template <bool XIN16> __device__ __forceinline__ void xrow_load(XRow<XIN16>& r, const void* xin, size_t row, int lane) {
    if (XIN16) {
#pragma unroll
        for (int j = 0; j < 4; ++j) r.w[j] = __builtin_nontemporal_load((const u32x4*)((const bf16*)xin + row * DM + 8 * (lane + 64 * j)));
    } else {
#pragma unroll
        for (int j = 0; j < 4; ++j) { const u32x4* p = (const u32x4*)((const float*)xin + row * DM + 8 * (lane + 64 * j)); r.w[2 * j] = __builtin_nontemporal_load(p); r.w[2 * j + 1] = __builtin_nontemporal_load(p + 1); }
    }
}
template <bool XIN16> __device__ __forceinline__ void xrow_unpack(const XRow<XIN16>& r, f32x4 (&x)[8]) {
    if (XIN16) {
#pragma unroll
        for (int j = 0; j < 4; ++j) { const u32x4 w = r.w[j]; x[2 * j] = (f32x4){bf_lo(w.x), bf_hi(w.x), bf_lo(w.y), bf_hi(w.y)}; x[2 * j + 1] = (f32x4){bf_lo(w.z), bf_hi(w.z), bf_lo(w.w), bf_hi(w.w)}; }
    } else {
#pragma unroll
        for (int q = 0; q < 8; ++q) x[q] = __builtin_bit_cast(f32x4, r.w[q]);
    }
}
template <bool HAS_RES, bool HAS_H, bool XIN16, bool XOUT16>
__device__ __forceinline__ void rowpass(const void* xin, const bf16* f, void* xout, bf16* hout, const float* post_g, const float* gate, float coef,
                                        const float* pre_g, const float* sc, const float* sh, int lane, int wave) {
    const int NGW = gridDim.x * NWAVES;
    for (int grp = blockIdx.x * NWAVES + wave; grp < MT / 8; grp += NGW) {
        const int r0 = grp * 8, b = r0 >> 12;
        f32x4 A[8], Bm[8];
#pragma unroll
        for (int j = 0; j < 4; ++j)
#pragma unroll
            for (int hh = 0; hh < 2; ++hh) { const int col = 8 * (lane + 64 * j) + 4 * hh;
                if (HAS_RES) { const f32x4 g = *(const f32x4*)(gate + (size_t)b * NMOD + col), pg = *(const f32x4*)(post_g + col); A[2 * j + hh] = g * pg * coef; }
                if (HAS_H) { const f32x4 s = *(const f32x4*)(sc + (size_t)b * NMOD + col), pg = *(const f32x4*)(pre_g + col); Bm[2 * j + hh] = pg * (s + 1.0f); }
            }
        XRow<XIN16> xc, xn; u32x4 fc[4], fn[4];
        xrow_load<XIN16>(xc, xin, (size_t)r0, lane);
        if (HAS_RES) {
#pragma unroll
            for (int j = 0; j < 4; ++j) fc[j] = __builtin_nontemporal_load((const u32x4*)(f + (size_t)r0 * DM + 8 * (lane + 64 * j)));
        }
#pragma unroll 1
        for (int rr = 0; rr < 8; ++rr) {
            const size_t row = (size_t)(r0 + rr);
            { const size_t rn = rr < 7 ? row + 1 : row;
              xrow_load<XIN16>(xn, xin, rn, lane);
              if (HAS_RES) {
#pragma unroll
                  for (int j = 0; j < 4; ++j) fn[j] = __builtin_nontemporal_load((const u32x4*)(f + rn * DM + 8 * (lane + 64 * j)));
              } }
            f32x4 x[8]; xrow_unpack<XIN16>(xc, x);
            if (HAS_RES) {
                float ss = 0.f;
#pragma unroll
                for (int j = 0; j < 4; ++j)
#pragma unroll
                    for (int e = 0; e < 4; ++e) { const float lo = bf_lo(fc[j][e]), hi = bf_hi(fc[j][e]); ss += lo * lo + hi * hi; }
                const float r1 = __builtin_amdgcn_rsqf(wave_sum(ss) * (1.0f / DM) + EPS);
#pragma unroll
                for (int j = 0; j < 4; ++j) { const u32x4 w = fc[j];
                    x[2 * j] += A[2 * j] * (f32x4){bf_lo(w.x), bf_hi(w.x), bf_lo(w.y), bf_hi(w.y)} * r1; x[2 * j + 1] += A[2 * j + 1] * (f32x4){bf_lo(w.z), bf_hi(w.z), bf_lo(w.w), bf_hi(w.w)} * r1; }
                if (XOUT16) {
#pragma unroll
                    for (int j = 0; j < 4; ++j) { u32x4 w; w.x = pk2(x[2 * j][0], x[2 * j][1]); w.y = pk2(x[2 * j][2], x[2 * j][3]); w.z = pk2(x[2 * j + 1][0], x[2 * j + 1][1]); w.w = pk2(x[2 * j + 1][2], x[2 * j + 1][3]);
                        *(u32x4*)((bf16*)xout + row * DM + 8 * (lane + 64 * j)) = w;
                        x[2 * j] = (f32x4){bf_lo(w.x), bf_hi(w.x), bf_lo(w.y), bf_hi(w.y)}; x[2 * j + 1] = (f32x4){bf_lo(w.z), bf_hi(w.z), bf_lo(w.w), bf_hi(w.w)}; }
                } else {
#pragma unroll
                    for (int j = 0; j < 4; ++j) { f32x4* p = (f32x4*)((float*)xout + row * DM + 8 * (lane + 64 * j)); p[0] = x[2 * j]; p[1] = x[2 * j + 1]; }
                }
            }
            if (HAS_H) {
                float ss = 0.f;
#pragma unroll
                for (int q = 0; q < 8; ++q) ss += (x[q][0] * x[q][0] + x[q][1] * x[q][1]) + (x[q][2] * x[q][2] + x[q][3] * x[q][3]);
                const float r2 = __builtin_amdgcn_rsqf(wave_sum(ss) * (1.0f / DM) + EPS);
#pragma unroll
                for (int j = 0; j < 4; ++j) { const f32x4* shp = (const f32x4*)(sh + (size_t)b * NMOD + 8 * (lane + 64 * j));
                    const f32x4 h0 = x[2 * j] * r2 * Bm[2 * j] + shp[0], h1 = x[2 * j + 1] * r2 * Bm[2 * j + 1] + shp[1];
                    u32x4 w; w.x = pk2(h0[0], h0[1]); w.y = pk2(h0[2], h0[3]); w.z = pk2(h1[0], h1[1]); w.w = pk2(h1[2], h1[3]);
                    *(u32x4*)(hout + row * DM + 8 * (lane + 64 * j)) = w; }
            }
            xc = xn;
            if (HAS_RES) {
#pragma unroll
                for (int j = 0; j < 4; ++j) fc[j] = fn[j];
            }
        }
    }
}

__device__ __forceinline__ unsigned swz(unsigned row, unsigned ch) { return 256u * row + 16u * (ch ^ (((row & 7u) << 1) | ((row >> 3) & 1u))); }
__device__ __forceinline__ s16x4 vtr(const LAS unsigned char* p) { return __builtin_bit_cast(s16x4, __builtin_amdgcn_ds_read_tr16_b64_v4i16((LAS s16x4*)p)); }
struct AttnItem { int dsh, b, h, r, m0; size_t obase; };
__device__ __forceinline__ AttnItem attn_decode(int idx) {
    AttnItem it; const int p = idx >> 10, rem = idx & 1023, t = rem & 31; it.b = rem >> 8; it.h = (rem >> 5) & 7; it.dsh = 2 * p;
    const int ngrp = (SEQ >> it.dsh) >> 7; it.r = t / ngrp; it.m0 = (t % ngrp) * 128; it.obase = (size_t)p; return it;
}
__device__ __forceinline__ void attn_issue(const AttnItem& it, const bf16* __restrict__ Kb, const bf16* __restrict__ Vb, int tid, u32x4 (&kreg)[8], u32x4 (&vreg)[8]) {
    const int ch = tid & 15, rr = tid >> 4, L = SEQ >> it.dsh;
    const size_t bh = (size_t)it.b * SEQ * AW + (size_t)it.h * 128 + 8 * ch;
#pragma unroll
    for (int i = 0; i < 8; ++i) { int km = it.m0 - 64 + 32 * i + rr; km = km < 0 ? 0 : (km > L - 1 ? L - 1 : km); const size_t off = bh + (size_t)((km << it.dsh) + it.r) * AW;
        kreg[i] = *(const u32x4*)(Kb + off); vreg[i] = *(const u32x4*)(Vb + off); }
}
__device__ __forceinline__ void attn_phase(const Args& a, LAS unsigned char* lds, int tid, int lane, int wave) {
    unsigned char* ws = a.ws;
    const bf16 *Q = (const bf16*)(ws + WS_Q), *Kb = (const bf16*)(ws + WS_K), *Vb = (const bf16*)(ws + WS_V);
    LAS unsigned char* kimg = lds; LAS unsigned char* vimg = lds + 65536;
    const int fr = lane & 15, fq = lane >> 4, G = gridDim.x;
    const unsigned q4 = (unsigned)(lane & 15) >> 2, p4 = (unsigned)lane & 3u;
    constexpr int NITEM = 3 * NB * NH * 32;
    const bool xcd_order = (G == 256);
    const int istep = xcd_order ? 32 : G;
    int idx = xcd_order ? ((int)(blockIdx.x & 7) * (NITEM / 8) + (int)(blockIdx.x >> 3)) : (int)blockIdx.x;
    const int iend = xcd_order ? ((int)(blockIdx.x & 7) + 1) * (NITEM / 8) : NITEM;
    if (idx >= iend) return;
    u32x4 kreg[8], vreg[8];
    AttnItem it = attn_decode(idx);
    attn_issue(it, Kb, Vb, tid, kreg, vreg);
    for (;;) {
        const int L = SEQ >> it.dsh, m0 = it.m0 + 16 * wave;
        const size_t bh = (size_t)it.b * SEQ * AW + (size_t)it.h * 128;
        const int qpos = ((m0 + fr) << it.dsh) + it.r;
        bf16x8 qf[4];
        { const bf16x8* qp = (const bf16x8*)(Q + bh + (size_t)qpos * AW) + fq;
#pragma unroll
          for (int kk = 0; kk < 4; ++kk) qf[kk] = qp[4 * kk]; }
        __syncthreads();
        { const unsigned ch = tid & 15, rr = tid >> 4;
#pragma unroll
          for (int i = 0; i < 8; ++i) { const unsigned o = swz(32u * i + rr, ch); *(LAS u32x4*)(kimg + o) = kreg[i]; *(LAS u32x4*)(vimg + o) = vreg[i]; } }
        __syncthreads();
        const int nidx = idx + istep; const bool has_next = nidx < iend;
        AttnItem nit = it;
        if (has_next) { nit = attn_decode(nidx); attn_issue(nit, Kb, Vb, tid, kreg, vreg); }
        f32x4 s[10];
        const unsigned wrow = 16u * wave;
#pragma unroll
        for (int blk = 0; blk < 9; ++blk) {
            f32x4 acc = {0.f, 0.f, 0.f, 0.f};
#pragma unroll
            for (int kk = 0; kk < 4; ++kk) { const bf16x8 kf = *(const LAS bf16x8*)(kimg + swz(wrow + 16u * blk + fr, 4u * kk + fq)); acc = __builtin_amdgcn_mfma_f32_16x16x32_bf16(kf, qf[kk], acc, 0, 0, 0); }
            s[blk] = acc;
        }
        float mx = -1e30f;
#pragma unroll
        for (int j = 0; j < 4; ++j) { s[0][j] = (4 * fq + j - fr >= 0) ? s[0][j] : -1e30f; s[8][j] = (4 * fq + j - fr <= 0) ? s[8][j] : -1e30f; }
        if (m0 < 64 || m0 + 80 > L) {
#pragma unroll
            for (int blk = 0; blk < 9; ++blk)
#pragma unroll
                for (int j = 0; j < 4; ++j) { const int km = m0 - 64 + 16 * blk + 4 * fq + j; s[blk][j] = (km >= 0 && km < L) ? s[blk][j] : -1e30f; }
        }
#pragma unroll
        for (int blk = 0; blk < 9; ++blk)
#pragma unroll
            for (int j = 0; j < 4; ++j) mx = fmaxf(mx, s[blk][j]);
        mx = fmaxf(mx, __shfl_xor(mx, 16)); mx = fmaxf(mx, __shfl_xor(mx, 32));
        float l = 0.f;
#pragma unroll
        for (int blk = 0; blk < 9; ++blk)
#pragma unroll
            for (int j = 0; j < 4; ++j) { const float p = __builtin_amdgcn_exp2f(s[blk][j] - mx); s[blk][j] = p; l += p; }
        s[9] = (f32x4){0.f, 0.f, 0.f, 0.f};
        l += __shfl_xor(l, 16); l += __shfl_xor(l, 32);
        f32x4 o[8];
#pragma unroll
        for (int c = 0; c < 8; ++c) o[c] = (f32x4){0.f, 0.f, 0.f, 0.f};
#pragma unroll
        for (int ks = 0; ks < 5; ++ks) {
            u32x4 pw; pw.x = pk2(s[2 * ks][0], s[2 * ks][1]); pw.y = pk2(s[2 * ks][2], s[2 * ks][3]); pw.z = pk2(s[2 * ks + 1][0], s[2 * ks + 1][1]); pw.w = pk2(s[2 * ks + 1][2], s[2 * ks + 1][3]);
            const bf16x8 pb = __builtin_bit_cast(bf16x8, pw);
            const unsigned r0 = wrow + 32u * ks + 4u * fq + q4, r1 = (ks == 4) ? r0 : r0 + 16u;
#pragma unroll
            for (int c = 0; c < 8; ++c) {
                const s16x4 a0 = vtr(vimg + swz(r0, 2u * c + (p4 >> 1)) + 8u * (p4 & 1u));
                const s16x4 a1 = vtr(vimg + swz(r1, 2u * c + (p4 >> 1)) + 8u * (p4 & 1u));
                const bf16x8 av = {a0[0], a0[1], a0[2], a0[3], a1[0], a1[1], a1[2], a1[3]};
                o[c] = __builtin_amdgcn_mfma_f32_16x16x32_bf16(av, pb, o[c], 0, 0, 0);
            }
        }
        const float inv = 1.0f / l;
        bf16* op = (bf16*)(ws + WS_O + it.obase * 32 * MiB) + bh + (size_t)qpos * AW + 4 * fq;
#pragma unroll
        for (int c = 0; c < 8; ++c) { u32x2 w; w.x = pk2(o[c][0] * inv, o[c][1] * inv); w.y = pk2(o[c][2] * inv, o[c][3] * inv); *(u32x2*)(op + 16 * c) = w; }
        if (fq == 0) ((float*)(ws + WS_LSE) + it.obase * MT * NH)[((size_t)it.b * SEQ + qpos) * NH + it.h] = mx + __log2f(l);
        if (!has_next) break;
        it = nit; idx = nidx;
    }
}

__device__ __forceinline__ void unpack16(const u32x4 a, const u32x4 b, float* v) {
    v[0] = bf_lo(a.x); v[1] = bf_hi(a.x); v[2] = bf_lo(a.y); v[3] = bf_hi(a.y); v[4] = bf_lo(a.z); v[5] = bf_hi(a.z); v[6] = bf_lo(a.w); v[7] = bf_hi(a.w);
    v[8] = bf_lo(b.x); v[9] = bf_hi(b.x); v[10] = bf_lo(b.y); v[11] = bf_hi(b.y); v[12] = bf_lo(b.z); v[13] = bf_hi(b.z); v[14] = bf_lo(b.w); v[15] = bf_hi(b.w);
}
__device__ __forceinline__ void store16(bf16* p, const float* v) {
    u32x4 a, b; a.x = pk2(v[0], v[1]); a.y = pk2(v[2], v[3]); a.z = pk2(v[4], v[5]); a.w = pk2(v[6], v[7]); b.x = pk2(v[8], v[9]); b.y = pk2(v[10], v[11]); b.z = pk2(v[12], v[13]); b.w = pk2(v[14], v[15]);
    ((u32x4*)p)[0] = a; ((u32x4*)p)[1] = b;
}
#ifndef RING
#define RING 4
#endif
__device__ __forceinline__ void mixpost_phase(const Args& a, LAS unsigned char* lds, int tid, int lane, int wave) {
    unsigned char* ws = a.ws;
    for (int i = tid; i < CK * 1024 / 4; i += NTHR) ((LAS f32x4*)lds)[i] = ((const f32x4*)a.in[I_CONVW])[i];
    __syncthreads();
    const bf16* U = (const bf16*)(ws + WS_U); bf16* MG = (bf16*)(ws + WS_H);
    const float* lse = (const float*)(ws + WS_LSE);
    const int NGW = gridDim.x * NWAVES, c0 = 16 * lane, head = lane >> 3;
    for (int grp = blockIdx.x * NWAVES + wave; grp < MT / 4; grp += NGW) {
        const int row0 = grp * 4, b = row0 >> 12, s0 = row0 & 4095;
        u32x4 ring[RING][2], w3[3][2];
#define CONV_ISSUE(dst, sp_) do { const int sp = (sp_); const bool ok = (sp >= 0) && (sp < SEQ); const u32x4* p = (const u32x4*)(U + ((size_t)b * SEQ + (ok ? sp : 0)) * AW + c0); \
            dst[0] = p[0]; dst[1] = p[1]; if (!ok) { dst[0] = (u32x4){0u, 0u, 0u, 0u}; dst[1] = dst[0]; } } while (0)
#define CONV_UNPACK(slot, src) do { const u32x4 q0 = src[0], q1 = src[1]; \
            win[slot][0] = (f32x2){bf_lo(q0.x), bf_hi(q0.x)}; win[slot][1] = (f32x2){bf_lo(q0.y), bf_hi(q0.y)}; win[slot][2] = (f32x2){bf_lo(q0.z), bf_hi(q0.z)}; win[slot][3] = (f32x2){bf_lo(q0.w), bf_hi(q0.w)}; \
            win[slot][4] = (f32x2){bf_lo(q1.x), bf_hi(q1.x)}; win[slot][5] = (f32x2){bf_lo(q1.y), bf_hi(q1.y)}; win[slot][6] = (f32x2){bf_lo(q1.z), bf_hi(q1.z)}; win[slot][7] = (f32x2){bf_lo(q1.w), bf_hi(q1.w)}; } while (0)
        CONV_ISSUE(w3[0], s0 - 15); CONV_ISSUE(w3[1], s0 - 14); CONV_ISSUE(w3[2], s0 - 13);
#pragma unroll
        for (int j = 0; j < RING; ++j) CONV_ISSUE(ring[j], s0 - 12 + j);
#pragma unroll 1
        for (int t = 0; t < 4; ++t) {
            const size_t row = (size_t)(row0 + t);
            float l0 = lse[row * NH + head], l1 = lse[(size_t)MT * NH + row * NH + head], l2 = lse[(size_t)2 * MT * NH + row * NH + head];
            const u32x4* p0 = (const u32x4*)((const bf16*)(ws + WS_O) + row * AW + c0); const u32x4 a00 = p0[0], a01 = p0[1];
            const u32x4* p1 = (const u32x4*)((const bf16*)(ws + WS_O + 32 * MiB) + row * AW + c0); const u32x4 a10 = p1[0], a11 = p1[1];
            const u32x4* p2 = (const u32x4*)((const bf16*)(ws + WS_O + 64 * MiB) + row * AW + c0); const u32x4 a20 = p2[0], a21 = p2[1];
            const float mx = fmaxf(l0, fmaxf(l1, l2)); float w0 = __builtin_amdgcn_exp2f(l0 - mx), w1 = __builtin_amdgcn_exp2f(l1 - mx), w2 = __builtin_amdgcn_exp2f(l2 - mx);
            const float iw = 1.0f / (w0 + w1 + w2); w0 *= iw; w1 *= iw; w2 *= iw;
            float v[16], acc[16];
            unpack16(a00, a01, v);
#pragma unroll
            for (int i = 0; i < 16; ++i) acc[i] = w0 * v[i];
            unpack16(a10, a11, v);
#pragma unroll
            for (int i = 0; i < 16; ++i) acc[i] += w1 * v[i];
            unpack16(a20, a21, v);
#pragma unroll
            for (int i = 0; i < 16; ++i) acc[i] += w2 * v[i];
            float ss = 0.f;
#pragma unroll
            for (int i = 0; i < 16; ++i) ss += acc[i] * acc[i];
            const float rs = __builtin_amdgcn_rsqf(wave_sum(ss) * (1.0f / AW) + EPS);
#pragma unroll
            for (int i = 0; i < 16; i += 4) { const f32x4 g = *(const f32x4*)(a.in[I_AOG] + c0 + i); acc[i] *= rs * g[0]; acc[i + 1] *= rs * g[1]; acc[i + 2] *= rs * g[2]; acc[i + 3] *= rs * g[3]; }
            store16(MG + row * DM + c0, acc);
        }
        f32x2 cacc2[4][8], win[4][8];
#pragma unroll
        for (int t = 0; t < 4; ++t)
#pragma unroll
            for (int i = 0; i < 8; ++i) cacc2[t][i] = (f32x2){0.f, 0.f};
        CONV_UNPACK(0, w3[0]); CONV_UNPACK(1, w3[1]); CONV_UNPACK(2, w3[2]);
#pragma unroll 1
        for (int kb = 0; kb < 32; kb += RING) {
#pragma unroll
            for (int j = 0; j < RING; ++j) { const int k = kb + j;
                if (k < CK) {
                    CONV_UNPACK((j + 3) & 3, ring[j]);
                    if (k + RING < CK) CONV_ISSUE(ring[j], s0 - 12 + k + RING);
                    f32x2 w[8];
#pragma unroll
                    for (int i = 0; i < 4; ++i) { const f32x4 wv = *(const LAS f32x4*)(lds + ((size_t)k * 1024 + c0 + 4 * i) * 4); w[2 * i] = (f32x2){wv[0], wv[1]}; w[2 * i + 1] = (f32x2){wv[2], wv[3]}; }
#pragma unroll
                    for (int t = 0; t < 4; ++t)
#pragma unroll
                        for (int i = 0; i < 8; ++i) cacc2[t][i] = __builtin_elementwise_fma(w[i], win[(t + j) & 3][i], cacc2[t][i]);
                } }
        }
#undef CONV_ISSUE
#undef CONV_UNPACK
        float cacc[4][16];
#pragma unroll
        for (int t = 0; t < 4; ++t)
#pragma unroll
            for (int i = 0; i < 8; ++i) { cacc[t][2 * i] = cacc2[t][i][0]; cacc[t][2 * i + 1] = cacc2[t][i][1]; }
        float cb[16], lg[16], lb[16], og[16];
#pragma unroll
        for (int i = 0; i < 16; i += 4) { const f32x4 x0 = *(const f32x4*)(a.in[I_CONVB] + c0 + i), x1 = *(const f32x4*)(a.in[I_LNG] + c0 + i), x2 = *(const f32x4*)(a.in[I_LNB] + c0 + i), x3 = *(const f32x4*)(a.in[I_COG] + c0 + i);
#pragma unroll
            for (int e = 0; e < 4; ++e) { cb[i + e] = x0[e]; lg[i + e] = x1[e]; lb[i + e] = x2[e]; og[i + e] = x3[e]; } }
#pragma unroll
        for (int t = 0; t < 4; ++t) {
            float sm = 0.f;
#pragma unroll
            for (int i = 0; i < 16; ++i) { cacc[t][i] += cb[i]; sm += cacc[t][i]; }
            const float mu = wave_sum(sm) * (1.0f / 1024.0f); float sv = 0.f;
#pragma unroll
            for (int i = 0; i < 16; ++i) { cacc[t][i] -= mu; sv += cacc[t][i] * cacc[t][i]; }
            const float rs = __builtin_amdgcn_rsqf(wave_sum(sv) * (1.0f / 1024.0f) + EPS); float s2 = 0.f;
#pragma unroll
            for (int i = 0; i < 16; ++i) { const float y = cacc[t][i] * rs * lg[i] + lb[i]; const float z = y * pg8::sigmoid_f(y); cacc[t][i] = z; s2 += z * z; }
            const float r2 = __builtin_amdgcn_rsqf(wave_sum(s2) * (1.0f / 1024.0f) + EPS);
#pragma unroll
            for (int i = 0; i < 16; ++i) cacc[t][i] *= r2 * og[i];
            store16(MG + (size_t)(row0 + t) * DM + 1024 + c0, cacc[t]);
        }
    }
}

#define XB_TMO      128
#define XB_XCNT(j)  (256  + 64 * (j))
#define XB_XSUB(j)  (1280 + 64 * (j))
#define XB_XGEN(j)  (2304 + 64 * (j))
#define XB_TOP      3328
#define XB_TOPGEN   3392
#define XCD_BAR_WORDS 3456
#define XB_SPIN_CAP (1u << 18)

__device__ __forceinline__ unsigned xb_ld(unsigned* p)              { return __hip_atomic_load(p, __ATOMIC_RELAXED, __HIP_MEMORY_SCOPE_AGENT); }
__device__ __forceinline__ unsigned xb_add(unsigned* p, unsigned v) { return __hip_atomic_fetch_add(p, v, __ATOMIC_RELAXED, __HIP_MEMORY_SCOPE_AGENT); }
__device__ __forceinline__ unsigned xb_xcc_id() { return (unsigned)__builtin_amdgcn_s_getreg((3 << 11) | 20) & 0xFu; }
#define XB_SPIN(cond, bar) do { unsigned _sp = 0; while (cond) { __builtin_amdgcn_s_sleep(1); \
    if ((++_sp & 255u) == 0u) { if (xb_ld(&(bar)[XB_TMO])) break; if (_sp > XB_SPIN_CAP) { atomicAdd(&(bar)[XB_TMO], 1u); break; } } } } while (0)

struct XcdBarrier {
    unsigned* bar; unsigned x;
    volatile LAS unsigned* st;
};

__device__ __forceinline__ XcdBarrier xcd_barrier_post(unsigned* bar, volatile LAS unsigned* st) {
    XcdBarrier b; b.bar = bar; b.x = xb_xcc_id(); b.st = st;
    if (threadIdx.x == 0) (void)xb_add(&bar[XB_XCNT(b.x)], 1u);
    return b;
}
__device__ __forceinline__ void xcd_barrier_complete(unsigned* bar, unsigned x, unsigned& nloc, unsigned& nx) {
    const unsigned G = gridDim.x * gridDim.y * gridDim.z;
    unsigned sum, cnt, mine, sp = 0u;
    for (;;) {
        sum = 0u; cnt = 0u; mine = 0u;
#pragma unroll
        for (unsigned j = 0; j < 16; ++j) { const unsigned c = xb_ld(&bar[XB_XCNT(j)]); sum += c; cnt += (c > 0u) ? 1u : 0u; mine = (j == x) ? c : mine; }
        if (sum == G) break;
        __builtin_amdgcn_s_sleep(1);
        if ((++sp & 255u) == 0u) { if (xb_ld(&bar[XB_TMO])) break; if (sp > XB_SPIN_CAP) { atomicAdd(&bar[XB_TMO], 1u); break; } }
    }
    nloc = mine > 0u ? mine : 1u; nx = cnt > 0u ? cnt : 1u;
}

__device__ __forceinline__ void xcd_barrier(const XcdBarrier& b) {
    asm volatile("s_waitcnt vmcnt(0)" ::: "memory");
    __syncthreads();
    if (threadIdx.x == 0) {
        unsigned* bar = b.bar;
        __builtin_amdgcn_s_waitcnt(0);
        unsigned nloc = b.st[0], nx = b.st[1];
        if (nloc == 0u) { xcd_barrier_complete(bar, b.x, nloc, nx); b.st[0] = nloc; b.st[1] = nx; }
        const unsigned old = xb_add(&bar[XB_XSUB(b.x)], 1u);
        const unsigned gen = old / nloc;
        if (old + 1u == (gen + 1u) * nloc) {
            __builtin_amdgcn_fence(__ATOMIC_RELEASE, "agent");
            asm volatile("s_waitcnt vmcnt(0)" ::: "memory");
            const unsigned og = xb_add(&bar[XB_TOP], 1u);
            const unsigned tg = og / nx;
            if (og + 1u == (tg + 1u) * nx) xb_add(&bar[XB_TOPGEN], 1u);
            else XB_SPIN(xb_ld(&bar[XB_TOPGEN]) == tg, bar);
            __builtin_amdgcn_fence(__ATOMIC_ACQUIRE, "agent");
            xb_add(&bar[XB_XGEN(b.x)], 1u);
            asm volatile("s_waitcnt vmcnt(0)" ::: "memory");
        } else {
            XB_SPIN(xb_ld(&bar[XB_XGEN(b.x)]) == gen, bar);
            __builtin_amdgcn_fence(__ATOMIC_ACQUIRE, "agent");
            asm volatile("s_waitcnt vmcnt(0)" ::: "memory");
        }
    }
    __syncthreads();
}


__global__ void __launch_bounds__(NTHR, 2) fwd_megakernel(Args a) {
    extern __shared__ __attribute__((aligned(16))) unsigned char lds_raw[];
    LAS unsigned char* lds = (LAS unsigned char*)lds_raw;
    cg::grid_group grid = cg::this_grid();
    volatile LAS unsigned* bst = (volatile LAS unsigned*)(lds + 147456 - 64);
    if (threadIdx.x < 2) bst[threadIdx.x] = 0u;
    __syncthreads();
    const XcdBarrier bar = xcd_barrier_post((unsigned*)(a.ws + WS_CTL), bst);
    const int tid0 = threadIdx.x, wave = __builtin_amdgcn_readfirstlane(tid0 >> 6), G = gridDim.x;
#define FRESH() int tid = tid0; asm volatile("" : "+v"(tid)); const int lane = tid & 63; (void)lane;
    unsigned char* ws = a.ws;
    const float* mod = (const float*)(ws + WS_MOD);
    bf16 *HB = (bf16*)(ws + WS_H), *FB = (bf16*)(ws + WS_F), *ACT = (bf16*)(ws + WS_ACT);

    { FRESH();
    p0_prologue(a, lds, tid, lane, wave);
    }
    if (a.ws == nullptr) grid.sync();
    xcd_barrier(bar);
    { FRESH();
    p0b_modreduce(a, tid);
    }
    xcd_barrier(bar);
    { FRESH();
    rowpass<false, true, false, false>(a.in[I_X], nullptr, nullptr, HB, nullptr, nullptr, 0.f, a.in[I_F1PRE], mod + 1 * DM, mod + 0 * DM, lane, wave);
    }
    xcd_barrier(bar);
    { FRESH();
    { pg8::Gemm g{HB, (const bf16*)(ws + WS_WGU1), MT, NGU, DM}; pg8::StaticOrder S; S.init(MT, NGU, G, (int)blockIdx.x); S.wg = WG_GU; pg8::EpiSwiGLU E{ACT, DFF};
      pg8::gemm_phase<pg8::EpiSwiGLU, pg8::StaticOrder, true, true>(lds, g, S, E); }
    }
    xcd_barrier(bar);
    { FRESH();
    { pg8::Gemm g{ACT, (const bf16*)(ws + WS_WD1), MT, DM, DFF}; pg8::StaticOrder S; S.init(MT, DM, G, (int)blockIdx.x); S.wg = WG_DN; pg8::EpiPlain E{FB, DM};
      pg8::gemm_phase<pg8::EpiPlain, pg8::StaticOrder, true, true>(lds, g, S, E); }
    }
    xcd_barrier(bar);
    { FRESH();
    rowpass<true, true, false, true>(a.in[I_X], FB, a.out, HB, a.in[I_F1POST], mod + 2 * DM, 0.5f, a.in[I_MIXPRE], mod + 4 * DM, mod + 3 * DM, lane, wave);
    }
    xcd_barrier(bar);
    { FRESH();
    { pg8::Gemm g{HB, (const bf16*)(ws + WS_WIN), MT, NIN, DM}; pg8::StaticOrder S; S.init(MT, NIN, G, (int)blockIdx.x); S.wg = WG_IN;
      pg8::EpiIn E{(bf16*)(ws + WS_Q), (bf16*)(ws + WS_K), (bf16*)(ws + WS_V), (bf16*)(ws + WS_U), (const float*)(ws + WS_ROPE), 0.08838834764831845f * 1.4426950408889634f};
      pg8::gemm_phase<pg8::EpiIn, pg8::StaticOrder, true, true>(lds, g, S, E); }
    }
    xcd_barrier(bar);
    { FRESH();
    attn_phase(a, lds, tid, lane, wave);
    }
    xcd_barrier(bar);
    { FRESH();
    mixpost_phase(a, lds, tid, lane, wave);
    }
    xcd_barrier(bar);
    { FRESH();
    { pg8::Gemm g{HB, (const bf16*)(ws + WS_WOUT), MT, DM, DM}; pg8::StaticOrder S; S.init(MT, DM, G, (int)blockIdx.x); S.wg = WG_DN; pg8::EpiPlain E{FB, DM};
      pg8::gemm_phase<pg8::EpiPlain, pg8::StaticOrder, true, true>(lds, g, S, E); }
    }
    xcd_barrier(bar);
    { FRESH();
    rowpass<true, true, true, true>(a.out, FB, ws + WS_O, HB, a.in[I_MIXPOST], mod + 5 * DM, 1.0f, a.in[I_F2PRE], mod + 7 * DM, mod + 6 * DM, lane, wave);
    }
    xcd_barrier(bar);
    { FRESH();
    { pg8::Gemm g{HB, (const bf16*)(ws + WS_WGU2), MT, NGU, DM}; pg8::StaticOrder S; S.init(MT, NGU, G, (int)blockIdx.x); S.wg = WG_GU; pg8::EpiSwiGLU8 E{(unsigned char*)ACT, DFF, A8_SCALE};
      pg8::gemm_phase<pg8::EpiSwiGLU8, pg8::StaticOrder, true, true>(lds, g, S, E); }
    }
    xcd_barrier(bar);
    { FRESH();
    { pg8::Gemm g{ACT, (const bf16*)(ws + WS_WD2), MT, DM, DFF / 2}; pg8::StaticOrder S; S.init(MT, DM, G, (int)blockIdx.x); S.wg = WG_DN; pg8::EpiPlainScaled E{FB, DM, O8_SCALE};
      pg8::gemm_phase<pg8::EpiPlainScaled, pg8::StaticOrder, true, true, true>(lds, g, S, E); }
    }
    xcd_barrier(bar);
    { FRESH();
    rowpass<true, false, true, false>(ws + WS_O, FB, a.out, nullptr, a.in[I_F2POST], mod + 8 * DM, 0.5f, nullptr, nullptr, nullptr, lane, wave);
    }
}

extern "C" void kernel_launch(void* const* d_in, const int* in_sizes, int n_in, void* d_out, int out_size, void* d_ws, size_t ws_size, hipStream_t stream) {
    static int grid = 0;
    if (grid == 0) {
        if (n_in != 24 || out_size != MT * DM || ws_size < WS_END) { fprintf(stderr, "kernel_launch: unexpected shapes (n_in %d, out %d, ws %zu); nothing launched\n", n_in, out_size, ws_size); grid = -1; return; }
        int dev = 0, cus = 0, per_cu = 0;
        (void)hipGetDevice(&dev); (void)hipDeviceGetAttribute(&cus, hipDeviceAttributeMultiprocessorCount, dev);
        if (hipFuncSetAttribute((const void*)fwd_megakernel, hipFuncAttributeMaxDynamicSharedMemorySize, LDS_BYTES) != hipSuccess) { fprintf(stderr, "kernel_launch: hipFuncSetAttribute failed\n"); grid = -1; return; }
        if (hipOccupancyMaxActiveBlocksPerMultiprocessor(&per_cu, (const void*)fwd_megakernel, NTHR, LDS_BYTES) != hipSuccess || per_cu < 1) { fprintf(stderr, "kernel_launch: occupancy query says %d\n", per_cu); per_cu = 1; }
        (void)hipGetLastError();
        grid = cus * 1;
        if (grid <= 0) grid = 256;
    }
    if (grid < 0) return;
    if (hipMemsetAsync((char*)d_ws + WS_CTL, 0, CTL_BYTES, stream) != hipSuccess) { fprintf(stderr, "kernel_launch: memset of the barrier words failed\n"); return; }
    Args a{};
    for (int i = 0; i < 24; ++i) a.in[i] = (const float*)d_in[i];
    a.out = (float*)d_out; a.ws = (unsigned char*)d_ws;
    void* args[] = {&a};
    hipError_t e = hipLaunchCooperativeKernel((const void*)fwd_megakernel, dim3(grid), dim3(NTHR), args, LDS_BYTES, stream);
    if (e != hipSuccess) fprintf(stderr, "cooperative launch failed: %s (grid %d)\n", hipGetErrorString(e), grid);
}
```

```cpp
#include <hip/hip_runtime.h>
#include <hip/hip_cooperative_groups.h>
#include <cstdio>
#include <cstdint>
namespace cg = cooperative_groups;
namespace pg8 {
#define PG8_LAS __attribute__((address_space(3)))
typedef unsigned short bf16_t;
typedef short bf16x8 __attribute__((ext_vector_type(8)));
typedef float f32x4 __attribute__((ext_vector_type(4)));
typedef unsigned u32x4 __attribute__((ext_vector_type(4)));
constexpr int BM = 256, BK = 64, HALF = 128, HTB = HALF * BK * 2  , STAGE_BYTES = 8 * HTB, NXCD = 8, WGM = 8;

__host__ __device__ __forceinline__ int lds_byte(int r, int c) { const int st = (r >> 4) * 2 + (c >> 5), rr = r & 15, cc = c & 31, ob = rr * 64 + cc * 2; return st * 1024 + (ob ^ (((ob >> 9) & 1) << 5)); }
__host__ __device__ __forceinline__ void stage_rc(int b, int& R, int& C) { const int st = b / 1024, sb = b % 1024, swz = sb ^ (((sb >> 9) & 1) << 5); R = (st >> 1) * 16 + swz / 64; C = (st & 1) * 32 + (swz % 64) / 2; }
__host__ __device__ __forceinline__ int perm32(int rho) { const int n = rho >> 4, i = rho & 15; return 8 * (i >> 2) + 4 * n + (i & 3); }

struct Unit { int pm, pn; };
struct Gemm { const bf16_t* A; const bf16_t* Bt; int M, N, K; int ld; };

struct StaticOrder {
    int nM, nN, nwg, G, c, wg = WGM;
    __host__ __device__ void init(int M, int N, int G_, int c_) { nM = M / BM; nN = N / BM; nwg = nM * nN; G = G_; c = c_; }
    __host__ __device__ bool next(int i, Unit& u) const {
        const long L = (long)i * G + c; if (L >= nwg) return false;
        int wgid = (int)L; { const int q = nwg / NXCD, r = nwg % NXCD, xcd = wgid % NXCD, off = wgid / NXCD; wgid = (xcd < r ? xcd * (q + 1) : r * (q + 1) + (xcd - r) * q) + off; }
        const int nig = wg * nN, gid = wgid / nig, fm = gid * wg, gsz = (nM - fm) < wg ? (nM - fm) : wg;
        u.pm = fm + ((wgid % nig) % gsz); u.pn = (wgid % nig) / gsz; return true;
    }
    __device__ __forceinline__ void a_ready(const Unit&) const {}
    __device__ __forceinline__ void done(const Unit&) const {}
};

typedef float f32x2_t __attribute__((ext_vector_type(2)));
typedef __bf16 bf16x2_t __attribute__((ext_vector_type(2)));
__device__ __forceinline__ unsigned pk_bf16(float lo, float hi) { f32x2_t v = {lo, hi}; bf16x2_t b = __builtin_convertvector(v, bf16x2_t); return __builtin_bit_cast(unsigned, b); }
__device__ __forceinline__ float sigmoid_f(float x) { return __builtin_amdgcn_rcpf(1.0f + __builtin_amdgcn_exp2f(-1.44269504089f * x)); }
typedef unsigned u32x2 __attribute__((ext_vector_type(2)));

template <int MODE> __device__ __forceinline__ void epi_glu_store(const f32x4 (&acc)[2][2][4][2], bf16_t* O, int ldc, int row0, int col0) {
#pragma unroll
    for (int ai = 0; ai < 2; ++ai)
#pragma unroll
        for (int m = 0; m < 4; ++m) {
            bf16_t* rowp = O + (size_t)(row0 + ai * HALF + m * 16) * ldc + col0;
            float r[8];
#pragma unroll
            for (int n = 0; n < 2; ++n)
#pragma unroll
                for (int e = 0; e < 4; ++e) { const float a = acc[ai][0][m][n][e], b = acc[ai][1][m][n][e];
                    r[4 * n + e] = (MODE == 0) ? (a * sigmoid_f(a)) * b : a * sigmoid_f(b); }
            u32x4 w; w.x = pk_bf16(r[0], r[1]); w.y = pk_bf16(r[2], r[3]); w.z = pk_bf16(r[4], r[5]); w.w = pk_bf16(r[6], r[7]);
            *(u32x4*)rowp = w; }
}
__device__ __forceinline__ void epi_plain_store(const f32x4 (&acc)[2][2][4][2], bf16_t* O, int ldc, int row0, int col0) {
#pragma unroll
    for (int ai = 0; ai < 2; ++ai)
#pragma unroll
        for (int m = 0; m < 4; ++m) {
            bf16_t* rowp = O + (size_t)(row0 + ai * HALF + m * 16) * ldc + col0;
#pragma unroll
            for (int bj = 0; bj < 2; ++bj) { const f32x4 v0 = acc[ai][bj][m][0], v1 = acc[ai][bj][m][1];
                u32x4 w; w.x = pk_bf16(v0[0], v0[1]); w.y = pk_bf16(v0[2], v0[3]); w.z = pk_bf16(v1[0], v1[1]); w.w = pk_bf16(v1[2], v1[3]);
                *(u32x4*)(rowp + bj * HALF) = w; } }
}
__device__ __forceinline__ float clamp448(float v) { return __builtin_fminf(__builtin_fmaxf(v, -448.0f), 448.0f); }
__device__ __forceinline__ unsigned pk4_fp8(float a, float b, float c, float d) {
    int w = 0; w = __builtin_amdgcn_cvt_pk_fp8_f32(clamp448(a), clamp448(b), w, false); w = __builtin_amdgcn_cvt_pk_fp8_f32(clamp448(c), clamp448(d), w, true); return (unsigned)w; }
struct EpiSwiGLU8 {
    static constexpr bool PERM = false, AFTER_DRAIN = false;
    unsigned char* O; int ldc; float scale;
    __device__ __forceinline__ void operator()(const f32x4 (&acc)[2][2][4][2], const Unit& u, int wr, int wc, int fr, int fq) const {
        const int row0 = u.pm * BM + wr * 64 + fr, col0 = u.pn * HALF + wc * 32 + 8 * fq;
#pragma unroll
        for (int ai = 0; ai < 2; ++ai)
#pragma unroll
            for (int m = 0; m < 4; ++m) {
                unsigned char* rowp = O + (size_t)(row0 + ai * HALF + m * 16) * ldc + col0;
                float r[8];
#pragma unroll
                for (int n = 0; n < 2; ++n)
#pragma unroll
                    for (int e = 0; e < 4; ++e) { const float a = acc[ai][0][m][n][e], b = acc[ai][1][m][n][e]; r[4 * n + e] = (a * sigmoid_f(a)) * b * scale; }
                u32x2 w; w.x = pk4_fp8(r[0], r[1], r[2], r[3]); w.y = pk4_fp8(r[4], r[5], r[6], r[7]);
                *(u32x2*)rowp = w; }
    }
};
struct EpiPlainScaled {
    static constexpr bool PERM = false, AFTER_DRAIN = false;
    bf16_t* O; int ldc; float oscale;
    __device__ __forceinline__ void operator()(const f32x4 (&acc)[2][2][4][2], const Unit& u, int wr, int wc, int fr, int fq) const {
        const int row0 = u.pm * BM + wr * 64 + fr, col0 = u.pn * BM + wc * 32 + 8 * fq;
#pragma unroll
        for (int ai = 0; ai < 2; ++ai)
#pragma unroll
            for (int m = 0; m < 4; ++m) {
                bf16_t* rowp = O + (size_t)(row0 + ai * HALF + m * 16) * ldc + col0;
#pragma unroll
                for (int bj = 0; bj < 2; ++bj) { const f32x4 v0 = acc[ai][bj][m][0] * oscale, v1 = acc[ai][bj][m][1] * oscale;
                    u32x4 w; w.x = pk_bf16(v0[0], v0[1]); w.y = pk_bf16(v0[2], v0[3]); w.z = pk_bf16(v1[0], v1[1]); w.w = pk_bf16(v1[2], v1[3]);
                    *(u32x4*)(rowp + bj * HALF) = w; } }
    }
};
__device__ __forceinline__ int f2i(float x) { return __builtin_bit_cast(int, x); }
struct EpiSwiGLUQ {
    static constexpr bool PERM = false, AFTER_DRAIN = false;
    bf16_t* O; int ldc; const float* rowmax; const float* colmax;
    __device__ __forceinline__ void operator()(const f32x4 (&acc)[2][2][4][2], const Unit& u, int wr, int wc, int fr, int fq) const {
        const int row0 = u.pm * BM + wr * 64 + fr, col0 = u.pn * HALF + wc * 32 + 8 * fq, j0 = u.pn * BM + wc * 32 + 4 * fq;
        const float k2 = 1.0f / (127.0f * 127.0f);
        f32x4 cg[2], cu[2];
#pragma unroll
        for (int n = 0; n < 2; ++n) { cg[n] = *(const f32x4*)(colmax + j0 + 16 * n) * k2; cu[n] = *(const f32x4*)(colmax + j0 + HALF + 16 * n) * k2; }
#pragma unroll
        for (int ai = 0; ai < 2; ++ai)
#pragma unroll
            for (int m = 0; m < 4; ++m) {
                const int row = row0 + ai * HALF + m * 16; const float rs = rowmax[row];
                bf16_t* rowp = O + (size_t)row * ldc + col0;
                float r[8];
#pragma unroll
                for (int n = 0; n < 2; ++n)
#pragma unroll
                    for (int e = 0; e < 4; ++e) { const float ga = acc[ai][0][m][n][e], ua = acc[ai][1][m][n][e];
                        const float a = (float)f2i(ga) * (rs * cg[n][e]), b = (float)f2i(ua) * (rs * cu[n][e]);
                        r[4 * n + e] = (a * sigmoid_f(a)) * b; }
                u32x4 w; w.x = pk_bf16(r[0], r[1]); w.y = pk_bf16(r[2], r[3]); w.z = pk_bf16(r[4], r[5]); w.w = pk_bf16(r[6], r[7]);
                *(u32x4*)rowp = w; }
    }
};
struct EpiSwiGLU {
    static constexpr bool PERM = false, AFTER_DRAIN = false;
    bf16_t* O; int ldc;
    __device__ __forceinline__ void operator()(const f32x4 (&acc)[2][2][4][2], const Unit& u, int wr, int wc, int fr, int fq) const {
        epi_glu_store<0>(acc, O, ldc, u.pm * BM + wr * 64 + fr, u.pn * HALF + wc * 32 + 8 * fq);
    }
};
struct EpiPlain {
    static constexpr bool PERM = false, AFTER_DRAIN = false;
    bf16_t* O; int ldc;
    __device__ __forceinline__ void operator()(const f32x4 (&acc)[2][2][4][2], const Unit& u, int wr, int wc, int fr, int fq) const {
        epi_plain_store(acc, O, ldc, u.pm * BM + wr * 64 + fr, u.pn * BM + wc * 32 + 8 * fq);
    }
};
struct EpiIn {
    static constexpr bool PERM = false, AFTER_DRAIN = false;
    bf16_t *Q, *K, *V, *U; const float* rope;
    float qscale;
    __device__ __forceinline__ void operator()(const f32x4 (&acc)[2][2][4][2], const Unit& u, int wr, int wc, int fr, int fq) const {
        const int row0 = u.pm * BM + wr * 64 + fr;
        if (u.pn >= 12) { epi_glu_store<1>(acc, U, 1024, row0, (u.pn - 12) * HALF + wc * 32 + 8 * fq); return; }
        if (u.pn >= 8) { epi_plain_store(acc, V, 1024, row0, (u.pn - 8) * BM + wc * 32 + 8 * fq); return; }
        const bool isq = u.pn < 4; bf16_t* base = isq ? Q : K; const float sc = isq ? qscale : 1.0f;
        const int d0 = 16 * wc + 4 * fq;
#pragma unroll
        for (int ai = 0; ai < 2; ++ai)
#pragma unroll
            for (int m = 0; m < 4; ++m) { const int row = row0 + ai * HALF + m * 16, pos = row & 4095;
                const f32x4 cs0 = *(const f32x4*)(rope + ((size_t)pos * 64 + d0) * 2), cs1 = *(const f32x4*)(rope + ((size_t)pos * 64 + d0) * 2 + 4);
                const float c[4] = {cs0[0], cs0[2], cs1[0], cs1[2]}, s[4] = {cs0[1], cs0[3], cs1[1], cs1[3]};
#pragma unroll
                for (int bj = 0; bj < 2; ++bj) { const int head = 2 * (u.pn & 3) + bj; bf16_t* p = base + (size_t)row * 1024 + head * 128 + d0;
                    float o1[4], o2[4];
#pragma unroll
                    for (int e = 0; e < 4; ++e) { const float t1 = acc[ai][bj][m][0][e], t2 = acc[ai][bj][m][1][e]; o1[e] = (t1 * c[e] - t2 * s[e]) * sc; o2[e] = (t2 * c[e] + t1 * s[e]) * sc; }
                    u32x2 w1, w2; w1.x = pk_bf16(o1[0], o1[1]); w1.y = pk_bf16(o1[2], o1[3]); w2.x = pk_bf16(o2[0], o2[1]); w2.y = pk_bf16(o2[2], o2[3]);
                    *(u32x2*)p = w1; *(u32x2*)(p + 64) = w2; } }
    }
};

typedef int i32x4 __attribute__((ext_vector_type(4)));
typedef int i32x8 __attribute__((ext_vector_type(8)));
__device__ __forceinline__ i32x8 cat8(bf16x8 lo, bf16x8 hi) { return __builtin_shufflevector(__builtin_bit_cast(i32x4, lo), __builtin_bit_cast(i32x4, hi), 0, 1, 2, 3, 4, 5, 6, 7); }
__device__ __forceinline__ void mfma_f8(f32x4& acc, const i32x8& b, const i32x8& a, int unit_scale) {
    asm volatile("v_mfma_scale_f32_16x16x128_f8f6f4 %0, %1, %2, %0, %3, %3 op_sel_hi:[0,0,0]" : "+v"(acc) : "v"(b), "v"(a), "v"(unit_scale));
}
template <class Epi, class Sched, bool ALIGN_EPI = false, bool SP2 = false, bool F8 = false, bool I8 = false>
__device__ __forceinline__ void gemm_phase(PG8_LAS unsigned char* lds, const Gemm g, const Sched& S, const Epi& E) {
    const int tid = threadIdx.x, wid = __builtin_amdgcn_readfirstlane(tid >> 6), lane = tid & 63, wr = wid >> 2, wc = wid & 3, fr = lane & 15, fq = lane >> 4;
    const int K = g.K, nt = K / BK, LD = g.ld ? g.ld : g.K;
    unsigned voffA[2], voffB[2];
#pragma unroll
    for (int i = 0; i < 2; ++i) { int R, C; stage_rc(tid * 16 + i * 8192, R, C); const int Rb = Epi::PERM ? ((R & ~31) + perm32(R & 31)) : R;
        voffA[i] = (unsigned)(R * LD + C) * 2u; voffB[i] = (unsigned)(Rb * LD + C) * 2u; }
    const size_t kstep = (size_t)(BK * 2);
    const size_t hstep = (size_t)HALF * LD * 2;
    const size_t tstep = 2 * hstep;
    const unsigned ldsw = (unsigned)wid * 1024u;
    const int aoff = lds_byte(wr * 64 + fr, fq * 8), boff = lds_byte(wc * 32 + fr, fq * 8);
#define PG8_SA(b, h) (((b) * 2 + (h)) * HTB)
#define PG8_SB(b, h) ((4 + (b) * 2 + (h)) * HTB)
#define PG8_STAGE(bufoff, gbase, voff) do { _Pragma("unroll") for (int _i = 0; _i < 2; ++_i) \
        __builtin_amdgcn_global_load_lds((const unsigned*)((const char*)(gbase) + (voff)[_i]), (PG8_LAS unsigned*)(lds + (bufoff) + ldsw + _i * 8192), 16, 0, 0); } while (0)
#define PG8_LDA(dst, b, h) do { if constexpr (F8) { _Pragma("unroll") for (int m = 0; m < 4; ++m) dst##8[m] = cat8(*(const PG8_LAS bf16x8*)(lds + PG8_SA(b, h) + aoff + m * 2048), *(const PG8_LAS bf16x8*)(lds + PG8_SA(b, h) + aoff + m * 2048 + 1024)); } \
        else { _Pragma("unroll") for (int m = 0; m < 4; ++m) _Pragma("unroll") for (int k = 0; k < 2; ++k) dst[m][k] = *(const PG8_LAS bf16x8*)(lds + PG8_SA(b, h) + aoff + m * 2048 + k * 1024); } } while (0)
#define PG8_LDB(dst, b, h) do { if constexpr (F8) { _Pragma("unroll") for (int n = 0; n < 2; ++n) dst##8[n] = cat8(*(const PG8_LAS bf16x8*)(lds + PG8_SB(b, h) + boff + n * 2048), *(const PG8_LAS bf16x8*)(lds + PG8_SB(b, h) + boff + n * 2048 + 1024)); } \
        else { _Pragma("unroll") for (int n = 0; n < 2; ++n) _Pragma("unroll") for (int k = 0; k < 2; ++k) dst[n][k] = *(const PG8_LAS bf16x8*)(lds + PG8_SB(b, h) + boff + n * 2048 + k * 1024); } } while (0)
#define PG8_MMA(ai, bj, At, Bt) do { __builtin_amdgcn_s_setprio(1); \
        if constexpr (F8) { _Pragma("unroll") for (int m = 0; m < 4; ++m) _Pragma("unroll") for (int n = 0; n < 2; ++n) \
            mfma_f8(acc[ai][bj][m][n], Bt##8[n], At##8[m], 0x7F7F7F7F); } \
        else if constexpr (I8) { _Pragma("unroll") for (int m = 0; m < 4; ++m) _Pragma("unroll") for (int n = 0; n < 2; ++n) _Pragma("unroll") for (int k = 0; k < 2; ++k) \
            acc[ai][bj][m][n] = __builtin_bit_cast(f32x4, __builtin_amdgcn_mfma_i32_16x16x64_i8(__builtin_bit_cast(i32x4, Bt[n][k]), __builtin_bit_cast(i32x4, At[m][k]), __builtin_bit_cast(i32x4, acc[ai][bj][m][n]), 0, 0, 0)); } \
        else { _Pragma("unroll") for (int m = 0; m < 4; ++m) _Pragma("unroll") for (int n = 0; n < 2; ++n) _Pragma("unroll") for (int k = 0; k < 2; ++k) \
            acc[ai][bj][m][n] = __builtin_amdgcn_mfma_f32_16x16x32_bf16(Bt[n][k], At[m][k], acc[ai][bj][m][n], 0, 0, 0); } \
        __builtin_amdgcn_s_setprio(0); } while (0)
#define PG8_WAIT_V(n) asm volatile("s_waitcnt vmcnt(" #n ")" ::: "memory")
#define PG8_WAIT_L(n) asm volatile("s_waitcnt lgkmcnt(" #n ")" ::: "memory")
#define PG8_BAR __builtin_amdgcn_s_barrier()
#define PG8_SCHED __builtin_amdgcn_sched_barrier(0)
    Unit cur, nxt; int ui = 0;
    if (!S.next(0, cur)) return;
    f32x4 acc[2][2][4][2];
#pragma unroll
    for (int a = 0; a < 2; ++a)
#pragma unroll
        for (int b = 0; b < 2; ++b)
#pragma unroll
            for (int m = 0; m < 4; ++m)
#pragma unroll
                for (int n = 0; n < 2; ++n) acc[a][b][m][n] = (f32x4){0.f, 0.f, 0.f, 0.f};
    bf16x8 At[4][2], B0[2][2], B1[2][2]; i32x8 At8[4], B08[2], B18[2];
    const char* cA = (const char*)g.A + (size_t)cur.pm * tstep; const char* cB = (const char*)g.Bt + (size_t)cur.pn * tstep;
    S.a_ready(cur);
    if constexpr (SP2) {
        PG8_STAGE(PG8_SB(0, 0), cB, voffB); PG8_STAGE(PG8_SB(0, 1), cB + hstep, voffB); PG8_STAGE(PG8_SA(0, 0), cA, voffA); PG8_STAGE(PG8_SA(0, 1), cA + hstep, voffA);
        if (wr == 1) PG8_BAR;
        PG8_WAIT_V(2); PG8_BAR;
        PG8_STAGE(PG8_SB(1, 0), cB + kstep, voffB); PG8_STAGE(PG8_SA(1, 0), cA + kstep, voffA); PG8_STAGE(PG8_SB(1, 1), cB + hstep + kstep, voffB);
        PG8_WAIT_V(6); PG8_BAR;
    } else {
        PG8_STAGE(PG8_SB(0, 0), cB, voffB); PG8_STAGE(PG8_SA(0, 0), cA, voffA); PG8_STAGE(PG8_SB(0, 1), cB + hstep, voffB); PG8_STAGE(PG8_SA(0, 1), cA + hstep, voffA);
        if (wr == 1) PG8_BAR;
        PG8_WAIT_V(4); PG8_BAR;
        PG8_STAGE(PG8_SB(1, 0), cB + kstep, voffB); PG8_STAGE(PG8_SA(1, 0), cA + kstep, voffA); PG8_STAGE(PG8_SB(1, 1), cB + hstep + kstep, voffB);
        PG8_WAIT_V(6); PG8_BAR;
    }
    for (;;) {
        const bool has_next = S.next(ui + 1, nxt);
        const char* nA = has_next ? (const char*)g.A + (size_t)nxt.pm * tstep : cA; const char* nB = has_next ? (const char*)g.Bt + (size_t)nxt.pn * tstep : cB;
        for (int t = 0; t < nt; t += 2) {
            const bool last = (t == nt - 2);
            const char* a1 = cA + (size_t)(t + 1) * kstep;
            const char* a2 = last ? nA : cA + (size_t)(t + 2) * kstep; const char* b2 = last ? nB : cB + (size_t)(t + 2) * kstep;
            const char* a3 = a2 + kstep; const char* b3 = b2 + kstep;
            if (last && has_next) S.a_ready(nxt);
            if constexpr (SP2) {
            PG8_LDB(B0, 0, 0); PG8_LDB(B1, 0, 1); PG8_SCHED; PG8_LDA(At, 0, 0); PG8_STAGE(PG8_SA(1, 1), a1 + hstep, voffA);
            PG8_WAIT_V(8); PG8_WAIT_L(0); PG8_BAR; PG8_MMA(0, 0, At, B0); PG8_MMA(0, 1, At, B1); PG8_BAR; PG8_SCHED;
            PG8_LDA(At, 0, 1); PG8_STAGE(PG8_SB(0, 0), b2, voffB); PG8_STAGE(PG8_SB(0, 1), b2 + hstep, voffB); PG8_STAGE(PG8_SA(0, 0), a2, voffA);
            PG8_WAIT_V(8); PG8_WAIT_L(0); PG8_BAR; PG8_MMA(1, 0, At, B0); PG8_MMA(1, 1, At, B1); PG8_BAR; PG8_SCHED;
            PG8_LDB(B0, 1, 0); PG8_LDB(B1, 1, 1); PG8_SCHED; PG8_LDA(At, 1, 0); PG8_STAGE(PG8_SA(0, 1), a2 + hstep, voffA);
            PG8_WAIT_V(8); PG8_WAIT_L(0); PG8_BAR; PG8_MMA(0, 0, At, B0); PG8_MMA(0, 1, At, B1); PG8_BAR; PG8_SCHED;
            PG8_LDA(At, 1, 1); PG8_STAGE(PG8_SB(1, 0), b3, voffB); PG8_STAGE(PG8_SB(1, 1), b3 + hstep, voffB); PG8_STAGE(PG8_SA(1, 0), a3, voffA);
            PG8_WAIT_V(8); PG8_WAIT_L(0); PG8_BAR; PG8_MMA(1, 0, At, B0); PG8_MMA(1, 1, At, B1); PG8_BAR; PG8_SCHED;
            } else {
            PG8_LDB(B0, 0, 0); PG8_SCHED; PG8_LDA(At, 0, 0); PG8_STAGE(PG8_SA(1, 1), a1 + hstep, voffA);
            PG8_WAIT_L(8); PG8_BAR; PG8_WAIT_L(0); PG8_MMA(0, 0, At, B0); PG8_BAR; PG8_SCHED;
            PG8_LDB(B1, 0, 1); PG8_STAGE(PG8_SB(0, 0), b2, voffB);
            PG8_BAR; PG8_WAIT_L(0); PG8_MMA(0, 1, At, B1); PG8_BAR;
            PG8_LDA(At, 0, 1); PG8_STAGE(PG8_SA(0, 0), a2, voffA);
            PG8_BAR; PG8_WAIT_L(0); PG8_MMA(1, 0, At, B0); PG8_BAR; PG8_SCHED;
            PG8_STAGE(PG8_SB(0, 1), b2 + hstep, voffB);
            PG8_WAIT_V(6); PG8_BAR; PG8_MMA(1, 1, At, B1); PG8_BAR;
            PG8_LDB(B0, 1, 0); PG8_SCHED; PG8_LDA(At, 1, 0); PG8_STAGE(PG8_SA(0, 1), a2 + hstep, voffA);
            PG8_WAIT_L(8); PG8_BAR; PG8_WAIT_L(0); PG8_MMA(0, 0, At, B0); PG8_BAR; PG8_SCHED;
            PG8_LDB(B1, 1, 1); PG8_STAGE(PG8_SB(1, 0), b3, voffB);
            PG8_BAR; PG8_WAIT_L(0); PG8_MMA(0, 1, At, B1); PG8_BAR;
            PG8_LDA(At, 1, 1); PG8_STAGE(PG8_SA(1, 0), a3, voffA);
            PG8_BAR; PG8_WAIT_L(0); PG8_MMA(1, 0, At, B0); PG8_BAR; PG8_SCHED;
            PG8_STAGE(PG8_SB(1, 1), b3 + hstep, voffB);
            PG8_WAIT_V(6); PG8_BAR; PG8_MMA(1, 1, At, B1); PG8_BAR;
            }
        }
        if constexpr (ALIGN_EPI) { if (wr == 0) PG8_BAR; }
        if constexpr (F8) asm volatile("s_nop 15\n\ts_nop 15" ::: "memory");
        if constexpr (!Epi::AFTER_DRAIN) { E(acc, cur, wr, wc, fr, fq); S.done(cur); }
        if (!has_next) break;
#pragma unroll
        for (int a = 0; a < 2; ++a)
#pragma unroll
            for (int b = 0; b < 2; ++b)
#pragma unroll
                for (int m = 0; m < 4; ++m)
#pragma unroll
                    for (int n = 0; n < 2; ++n) acc[a][b][m][n] = (f32x4){0.f, 0.f, 0.f, 0.f};
        cur = nxt; cA = nA; cB = nB; ++ui;
        if constexpr (ALIGN_EPI) { if (wr == 1) PG8_BAR; }
    }
    PG8_WAIT_V(0);
    if constexpr (!ALIGN_EPI) { if (wr == 0) PG8_BAR; }
    PG8_BAR;
    if constexpr (Epi::AFTER_DRAIN) { E.fused(acc, cur, wr, wc, fr, fq, lds, wid, lane); S.done(cur); }
#undef PG8_SA
#undef PG8_SB
#undef PG8_STAGE
#undef PG8_LDA
#undef PG8_LDB
#undef PG8_MMA
#undef PG8_WAIT_V
#undef PG8_WAIT_L
#undef PG8_BAR
#undef PG8_SCHED
}
}

#define LAS __attribute__((address_space(3)))
typedef unsigned short bf16;
typedef float f32x4 __attribute__((ext_vector_type(4)));
typedef unsigned u32x4 __attribute__((ext_vector_type(4)));
typedef unsigned u32x2 __attribute__((ext_vector_type(2)));
typedef short bf16x8 __attribute__((ext_vector_type(8)));
typedef short s16x4 __attribute__((ext_vector_type(4)));
typedef float f32x2 __attribute__((ext_vector_type(2)));
constexpr int NB = 4, SEQ = 4096, DM = 2048, MT = NB * SEQ, DFF = 5632, NGU = 2 * DFF, NIN = 5120, AW = 1024, NH = 8, NMOD = 9 * DM, CK = 31;
constexpr float EPS = 1e-6f;
constexpr int NTHR = 512, NWAVES = 8;
#ifndef WG_GU
#define WG_GU 2
#endif
#ifndef WG_DN
#define WG_DN 4
#endif
#ifndef WG_IN
#define WG_IN 2
#endif
constexpr int KSPLIT = 28, NCG = NMOD / 4;
constexpr size_t MiB = 1u << 20;
constexpr size_t WS_MODP = 0, WS_MOD = 8 * MiB, WS_CTL = 8 * MiB + 512 * 1024, WS_CMAX = WS_CTL + 16384, CTL_BYTES = 16384 + 2 * 11264 * 4  , WS_RMAX = WS_CTL + 131072, WS_ROPE = 9 * MiB;
constexpr size_t WS_WGU1 = 12 * MiB, WS_WD1 = 56 * MiB, WS_WIN = 78 * MiB, WS_WOUT = 98 * MiB, WS_WGU2 = 106 * MiB, WS_WD2 = 150 * MiB;
constexpr size_t WS_H = 172 * MiB, WS_F = 236 * MiB, WS_ACT = 300 * MiB;
constexpr size_t WS_Q = 300 * MiB, WS_K = 332 * MiB, WS_V = 364 * MiB, WS_U = 396 * MiB;
constexpr size_t WS_O = 476 * MiB, WS_LSE = 572 * MiB, WS_END = 574 * MiB;
static_assert((size_t)KSPLIT * 4 * NMOD * 4 <= 8 * MiB && WS_ACT + (size_t)MT * DFF * 2 <= WS_O && WS_U + 32 * MiB <= WS_O, "ws map");
constexpr int LDS_BYTES = 147456;

struct Args { const float* in[24]; float* out; unsigned char* ws; };
enum { I_X = 0, I_C, I_WADA, I_BADA, I_F1PRE, I_F1G, I_F1U, I_F1D, I_F1POST, I_MIXPRE, I_WIN, I_CONVW, I_CONVB, I_LNG, I_LNB, I_AOG, I_COG, I_WOUT, I_MIXPOST, I_F2PRE, I_F2G, I_F2U, I_F2D, I_F2POST };

__device__ __forceinline__ unsigned pk2(float lo, float hi) { return pg8::pk_bf16(lo, hi); }
__device__ __forceinline__ float bf_lo(unsigned w) { return __builtin_bit_cast(float, w << 16); }
__device__ __forceinline__ float bf_hi(unsigned w) { return __builtin_bit_cast(float, w & 0xffff0000u); }
__device__ __forceinline__ float wave_max(float v) {
#pragma unroll
    for (int o = 1; o < 64; o <<= 1) v = __builtin_fmaxf(v, __shfl_xor(v, o));
    return v;
}
__device__ __forceinline__ float wave_sum(float v) {
#pragma unroll
    for (int o = 1; o < 64; o <<= 1) v += __shfl_xor(v, o);
    return v;
}

__device__ __forceinline__ int inv_perm32(int hc) { return 16 * ((hc >> 2) & 1) + 4 * (hc >> 3) + (hc & 3); }
__device__ __forceinline__ int dest_row(int kind, int n) {
    if (kind == 0 || kind == 1) return 256 * (n >> 7) + 128 * kind + 32 * ((n & 127) >> 5) + inv_perm32(n & 31);
    if (kind == 2 || kind == 4) return (n & ~31) + inv_perm32(n & 31);
    if (n < 2048) { const int sec = n >> 10, hh = (n >> 7) & 7, cc = n & 127, nn = cc >> 6, d = cc & 63; return sec * 1024 + hh * 128 + 32 * (d >> 4) + 16 * nn + (d & 15); }
    if (n < 3072) return (n & ~31) + inv_perm32(n & 31);
    { const int chn = (n - 3072) & 1023, isg = (n >= 4096) ? 1 : 0; return 3072 + 256 * (chn >> 7) + 128 * isg + 32 * ((chn & 127) >> 5) + inv_perm32(chn & 31); }
}
constexpr float A8_SCALE = 4.0f, W8_SCALE = 1024.0f, O8_SCALE = 1.0f / (4.0f * 1024.0f);
struct TrItem { const float* W; bf16* WT; int K, N, kind, kb, nb; };
__device__ __forceinline__ TrItem tr_decode(const Args& a, int it) {
    constexpr int IT_G = (DM / 64) * (DFF / 64), IT_IN = (DM / 64) * (NIN / 64), IT_OUT = (DM / 64) * (DM / 64);
    unsigned char* ws = a.ws; TrItem t; int r = it;
    auto ffn = [&](int r2, const float* g, const float* u, const float* d, size_t wgu, size_t wd, int dkind) {
        const int w = r2 / IT_G; const int q = r2 - w * IT_G;
        if (w == 0) { t.W = g; t.WT = (bf16*)(ws + wgu); t.K = DM; t.N = DFF; t.kind = 0; t.kb = q / (DFF / 64); t.nb = q % (DFF / 64); }
        else if (w == 1) { t.W = u; t.WT = (bf16*)(ws + wgu); t.K = DM; t.N = DFF; t.kind = 1; t.kb = q / (DFF / 64); t.nb = q % (DFF / 64); }
        else { t.W = d; t.WT = (bf16*)(ws + wd); t.K = DFF; t.N = DM; t.kind = dkind; t.kb = q / (DM / 64); t.nb = q % (DM / 64); } };
    if (r < 3 * IT_G) { ffn(r, a.in[I_F1G], a.in[I_F1U], a.in[I_F1D], WS_WGU1, WS_WD1, 2); return t; }
    r -= 3 * IT_G;
    if (r < IT_IN) { t.W = a.in[I_WIN]; t.WT = (bf16*)(ws + WS_WIN); t.K = DM; t.N = NIN; t.kind = 3; t.kb = r / (NIN / 64); t.nb = r % (NIN / 64); return t; }
    r -= IT_IN;
    if (r < IT_OUT) { t.W = a.in[I_WOUT]; t.WT = (bf16*)(ws + WS_WOUT); t.K = DM; t.N = DM; t.kind = 2; t.kb = r / (DM / 64); t.nb = r % (DM / 64); return t; }
    r -= IT_OUT;
    ffn(r, a.in[I_F2G], a.in[I_F2U], a.in[I_F2D], WS_WGU2, WS_WD2, 2); return t;
}
__device__ __forceinline__ void tr_load(const TrItem& t, f32x4 (&v)[16], int lane) {
    const int lr = lane >> 4, lc = lane & 15;
    const f32x4* src = (const f32x4*)(t.W + (size_t)(64 * t.kb + lr) * t.N + 64 * t.nb) + lc;
#pragma unroll
    for (int i = 0; i < 16; ++i) v[i] = __builtin_nontemporal_load(src + (size_t)i * t.N);
}
__device__ __forceinline__ void tr_colmax(const TrItem& t, const f32x4 (&v)[16], float* colmax, int lane) {
    float m0 = 0.f, m1 = 0.f, m2 = 0.f, m3 = 0.f;
#pragma unroll
    for (int i = 0; i < 16; ++i) { const f32x4 w = v[i]; m0 = __builtin_fmaxf(m0, __builtin_fabsf(w.x)); m1 = __builtin_fmaxf(m1, __builtin_fabsf(w.y)); m2 = __builtin_fmaxf(m2, __builtin_fabsf(w.z)); m3 = __builtin_fmaxf(m3, __builtin_fabsf(w.w)); }
    m0 = __builtin_fmaxf(m0, __shfl_xor(m0, 16)); m0 = __builtin_fmaxf(m0, __shfl_xor(m0, 32));
    m1 = __builtin_fmaxf(m1, __shfl_xor(m1, 16)); m1 = __builtin_fmaxf(m1, __shfl_xor(m1, 32));
    m2 = __builtin_fmaxf(m2, __shfl_xor(m2, 16)); m2 = __builtin_fmaxf(m2, __shfl_xor(m2, 32));
    m3 = __builtin_fmaxf(m3, __shfl_xor(m3, 16)); m3 = __builtin_fmaxf(m3, __shfl_xor(m3, 32));
    if (lane < 16) {
        unsigned* cm = (unsigned*)colmax; const int n = 64 * t.nb + 4 * lane;
        atomicMax(cm + dest_row(t.kind, n + 0), __builtin_bit_cast(unsigned, m0));
        atomicMax(cm + dest_row(t.kind, n + 1), __builtin_bit_cast(unsigned, m1));
        atomicMax(cm + dest_row(t.kind, n + 2), __builtin_bit_cast(unsigned, m2));
        atomicMax(cm + dest_row(t.kind, n + 3), __builtin_bit_cast(unsigned, m3));
    }
}
__device__ __forceinline__ unsigned pk4_i8(float a, float b, float c, float d) {
    const int ia = (int)__builtin_rintf(a), ib = (int)__builtin_rintf(b), ic = (int)__builtin_rintf(c), id = (int)__builtin_rintf(d);
    return ((unsigned)ia & 255u) | (((unsigned)ib & 255u) << 8) | (((unsigned)ic & 255u) << 16) | ((unsigned)id << 24);
}
__device__ __forceinline__ void tr_store_q8(const TrItem& t, const f32x4 (&v)[16], LAS float* scr, const float* colmax, int lane) {
    const int k0 = 64 * t.kb, n0 = 64 * t.nb, lr = lane >> 4, lc = lane & 15;
#pragma unroll
    for (int i = 0; i < 16; ++i) { LAS float* d = scr + (4 * i + lr) * 65 + 4 * lc; d[0] = v[i][0]; d[1] = v[i][1]; d[2] = v[i][2]; d[3] = v[i][3]; }
    const int c4 = lane & 3; unsigned char* W8 = (unsigned char*)t.WT;
#pragma unroll
    for (int j = 0; j < 4; ++j) { const int nn = (lane >> 2) + 16 * j; const LAS float* s = scr + (16 * c4) * 65 + nn;
        const int dr = dest_row(t.kind, n0 + nn); const float inv = 127.0f / __builtin_fmaxf(colmax[dr], 1e-30f);
        u32x4 o;
        o.x = pk4_i8(s[0] * inv, s[65] * inv, s[2 * 65] * inv, s[3 * 65] * inv);
        o.y = pk4_i8(s[4 * 65] * inv, s[5 * 65] * inv, s[6 * 65] * inv, s[7 * 65] * inv);
        o.z = pk4_i8(s[8 * 65] * inv, s[9 * 65] * inv, s[10 * 65] * inv, s[11 * 65] * inv);
        o.w = pk4_i8(s[12 * 65] * inv, s[13 * 65] * inv, s[14 * 65] * inv, s[15 * 65] * inv);
        *(u32x4*)(W8 + (size_t)dr * t.K + k0 + 16 * c4) = o; }
}
__device__ __forceinline__ void tr_store(const TrItem& t, const f32x4 (&v)[16], LAS float* scr, int lane) {
    const int k0 = 64 * t.kb, n0 = 64 * t.nb, lr = lane >> 4, lc = lane & 15;
#pragma unroll
    for (int i = 0; i < 16; ++i) { LAS float* d = scr + (4 * i + lr) * 65 + 4 * lc; d[0] = v[i][0]; d[1] = v[i][1]; d[2] = v[i][2]; d[3] = v[i][3]; }
    if (t.kind == 4) {
        const int c4 = lane & 3; unsigned char* W8 = (unsigned char*)t.WT;
#pragma unroll
        for (int j = 0; j < 4; ++j) { const int nn = (lane >> 2) + 16 * j; const LAS float* s = scr + (16 * c4) * 65 + nn;
            u32x4 o;
            o.x = pg8::pk4_fp8(s[0] * W8_SCALE, s[65] * W8_SCALE, s[2 * 65] * W8_SCALE, s[3 * 65] * W8_SCALE);
            o.y = pg8::pk4_fp8(s[4 * 65] * W8_SCALE, s[5 * 65] * W8_SCALE, s[6 * 65] * W8_SCALE, s[7 * 65] * W8_SCALE);
            o.z = pg8::pk4_fp8(s[8 * 65] * W8_SCALE, s[9 * 65] * W8_SCALE, s[10 * 65] * W8_SCALE, s[11 * 65] * W8_SCALE);
            o.w = pg8::pk4_fp8(s[12 * 65] * W8_SCALE, s[13 * 65] * W8_SCALE, s[14 * 65] * W8_SCALE, s[15 * 65] * W8_SCALE);
            const int dr = dest_row(4, n0 + nn);
            *(u32x4*)(W8 + (size_t)dr * t.K + k0 + 16 * c4) = o; }
        return;
    }
    const int c = lane & 7;
#pragma unroll
    for (int j = 0; j < 8; ++j) { const int nn = (lane >> 3) + 8 * j; const LAS float* s = scr + (8 * c) * 65 + nn;
        u32x4 o; o.x = pk2(s[0], s[65]); o.y = pk2(s[2 * 65], s[3 * 65]); o.z = pk2(s[4 * 65], s[5 * 65]); o.w = pk2(s[6 * 65], s[7 * 65]);
        const int dr = dest_row(t.kind, n0 + nn);
        *(u32x4*)(t.WT + (size_t)dr * t.K + k0 + 8 * c) = o; }
}
__device__ __forceinline__ void p0_prologue(const Args& a, LAS unsigned char* lds, int tid, int lane, int wave) {
    unsigned char* ws = a.ws;
    const int gtid = blockIdx.x * NTHR + tid, gw = blockIdx.x * NWAVES + wave, NGT = gridDim.x * NTHR, NGW = gridDim.x * NWAVES;
    {
        LAS float* cact = (LAS float*)lds;
        for (int i = tid; i < NB * DM; i += NTHR) { const int b = i >> 11, k = i & 2047; const float v = a.in[I_C][i]; cact[k * 4 + b] = v / (1.0f + __expf(-v)); }
        __syncthreads();
        float* part = (float*)(ws + WS_MODP);
        for (int t = gtid; t < NCG * KSPLIT; t += NGT) {
            const int ks = t / NCG, cgp = t % NCG, k0 = ks * DM / KSPLIT, k1 = (ks + 1) * DM / KSPLIT;
            const f32x4* W = (const f32x4*)a.in[I_WADA] + cgp;
            f32x4 acc0 = {0, 0, 0, 0}, acc1 = acc0, acc2 = acc0, acc3 = acc0;
#pragma unroll 8
            for (int k = k0; k < k1; ++k) { const f32x4 w = __builtin_nontemporal_load(W + (size_t)k * NCG); const f32x4 cv = *(const LAS f32x4*)(cact + 4 * k);
                acc0 += w * cv[0]; acc1 += w * cv[1]; acc2 += w * cv[2]; acc3 += w * cv[3]; }
            f32x4* pp = (f32x4*)(part + (size_t)ks * 4 * NMOD) + cgp;
            pp[0] = acc0; pp[NCG] = acc1; pp[2 * NCG] = acc2; pp[3 * NCG] = acc3;
        }
        __syncthreads();
    }
    {
        float* tab = (float*)(ws + WS_ROPE);
        for (int i = gtid; i < SEQ * 64; i += NGT) { const int pos = i >> 6, f = i & 63; const float inv = powf(10000.0f, -(float)f * (1.0f / 64.0f)); const float ang = (float)pos * inv;
            float sn, cs; sincosf(ang, &sn, &cs); tab[2 * i] = cs; tab[2 * i + 1] = sn; }
    }
    {
        LAS float* scr = (LAS float*)(lds + wave * 16640);
        constexpr int NITEMS = 6 * (DM / 64) * (DFF / 64) + (DM / 64) * (NIN / 64) + (DM / 64) * (DM / 64);
        int it = gw;
        if (it < NITEMS) {
            f32x4 va[16], vb[16];
            TrItem cur = tr_decode(a, it); tr_load(cur, va, lane);
            for (;;) {
                const int nx = it + NGW; const bool more = nx < NITEMS; TrItem nxt = cur;
                if (more) { nxt = tr_decode(a, nx); tr_load(nxt, vb, lane); }
                tr_store(cur, va, scr, lane);
                if (!more) break;
#pragma unroll
                for (int i = 0; i < 16; ++i) va[i] = vb[i];
                cur = nxt; it = nx;
            }
        }
    }
}
__device__ __forceinline__ void p0b_quant_weights(const Args& a, LAS unsigned char* lds, int lane, int wave) {
    (void)lds;
    const int NGW = gridDim.x * NWAVES;
    for (int r = blockIdx.x * NWAVES + wave; r < 2 * NGU; r += NGW) {
        const int f2 = r >= NGU, j = r - f2 * NGU;
        unsigned char* rowp = a.ws + (f2 ? WS_WGU2 : WS_WGU1) + (size_t)j * (DM * 2);
        float* cm = (float*)(a.ws + WS_CMAX) + f2 * NGU;
        const u32x4* p = (const u32x4*)rowp + 4 * lane;
        u32x4 w[4]; float v[32];
#pragma unroll
        for (int i = 0; i < 4; ++i) w[i] = p[i];
#pragma unroll
        for (int i = 0; i < 4; ++i) { v[8 * i] = bf_lo(w[i].x); v[8 * i + 1] = bf_hi(w[i].x); v[8 * i + 2] = bf_lo(w[i].y); v[8 * i + 3] = bf_hi(w[i].y); v[8 * i + 4] = bf_lo(w[i].z); v[8 * i + 5] = bf_hi(w[i].z); v[8 * i + 6] = bf_lo(w[i].w); v[8 * i + 7] = bf_hi(w[i].w); }
        float mx = 0.f;
#pragma unroll
        for (int i = 0; i < 32; ++i) mx = __builtin_fmaxf(mx, __builtin_fabsf(v[i]));
        mx = __builtin_fmaxf(wave_max(mx), 1e-30f);
        const float inv = 127.0f / mx;
        u32x4 o0, o1;
        o0.x = pk4_i8(v[0] * inv, v[1] * inv, v[2] * inv, v[3] * inv); o0.y = pk4_i8(v[4] * inv, v[5] * inv, v[6] * inv, v[7] * inv); o0.z = pk4_i8(v[8] * inv, v[9] * inv, v[10] * inv, v[11] * inv); o0.w = pk4_i8(v[12] * inv, v[13] * inv, v[14] * inv, v[15] * inv);
        o1.x = pk4_i8(v[16] * inv, v[17] * inv, v[18] * inv, v[19] * inv); o1.y = pk4_i8(v[20] * inv, v[21] * inv, v[22] * inv, v[23] * inv); o1.z = pk4_i8(v[24] * inv, v[25] * inv, v[26] * inv, v[27] * inv); o1.w = pk4_i8(v[28] * inv, v[29] * inv, v[30] * inv, v[31] * inv);
        asm volatile("" ::: "memory");
        u32x4* q = (u32x4*)rowp + 2 * lane;
        q[0] = o0; q[1] = o1;
        if (lane == 0) cm[j] = mx;
    }
}
__device__ __forceinline__ void p0b_modreduce(const Args& a, int tid) {
    const float* part = (const float*)(a.ws + WS_MODP); float* mod = (float*)(a.ws + WS_MOD);
    for (int i = blockIdx.x * NTHR + tid; i < NB * NMOD; i += gridDim.x * NTHR) { const int n = i % NMOD; float s = a.in[I_BADA][n];
#pragma unroll 4
        for (int ks = 0; ks < KSPLIT; ++ks) s += part[(size_t)ks * 4 * NMOD + i];
        mod[i] = s; }
}

template <bool XIN16> struct XRow { u32x4 w[XIN16 ? 4 : 8]; };
template <bool XIN16> __device__ __forceinline__ void xrow_load(XRow<XIN16>& r, const void* xin, size_t row, int lane) {
    if (XIN16) {
#pragma unroll
        for (int j = 0; j < 4; ++j) r.w[j] = __builtin_nontemporal_load((const u32x4*)((const bf16*)xin + row * DM + 8 * (lane + 64 * j)));
    } else {
#pragma unroll
        for (int j = 0; j < 4; ++j) { const u32x4* p = (const u32x4*)((const float*)xin + row * DM + 8 * (lane + 64 * j)); r.w[2 * j] = __builtin_nontemporal_load(p); r.w[2 * j + 1] = __builtin_nontemporal_load(p + 1); }
    }
}
template <bool XIN16> __device__ __forceinline__ void xrow_unpack(const XRow<XIN16>& r, f32x4 (&x)[8]) {
    if (XIN16) {
#pragma unroll
        for (int j = 0; j < 4; ++j) { const u32x4 w = r.w[j]; x[2 * j] = (f32x4){bf_lo(w.x), bf_hi(w.x), bf_lo(w.y), bf_hi(w.y)}; x[2 * j + 1] = (f32x4){bf_lo(w.z), bf_hi(w.z), bf_lo(w.w), bf_hi(w.w)}; }
    } else {
#pragma unroll
        for (int q = 0; q < 8; ++q) x[q] = __builtin_bit_cast(f32x4, r.w[q]);
    }
}
template <bool HAS_RES, bool HAS_H, bool XIN16, bool XOUT16, bool HQ8 = false>
__device__ __forceinline__ void rowpass(const void* xin, const bf16* f, void* xout, bf16* hout, const float* post_g, const float* gate, float coef,
                                        const float* pre_g, const float* sc, const float* sh, int lane, int wave, float* rowmax = nullptr) {
    const int NGW = gridDim.x * NWAVES;
    for (int grp = blockIdx.x * NWAVES + wave; grp < MT / 8; grp += NGW) {
        const int r0 = grp * 8, b = r0 >> 12;
        f32x4 A[8], Bm[8];
#pragma unroll
        for (int j = 0; j < 4; ++j)
#pragma unroll
            for (int hh = 0; hh < 2; ++hh) { const int col = 8 * (lane + 64 * j) + 4 * hh;
                if (HAS_RES) { const f32x4 g = *(const f32x4*)(gate + (size_t)b * NMOD + col), pg = *(const f32x4*)(post_g + col); A[2 * j + hh] = g * pg * coef; }
                if (HAS_H) { const f32x4 s = *(const f32x4*)(sc + (size_t)b * NMOD + col), pg = *(const f32x4*)(pre_g + col); Bm[2 * j + hh] = pg * (s + 1.0f); }
            }
        XRow<XIN16> xc, xn; u32x4 fc[4], fn[4];
        xrow_load<XIN16>(xc, xin, (size_t)r0, lane);
        if (HAS_RES) {
#pragma unroll
            for (int j = 0; j < 4; ++j) fc[j] = __builtin_nontemporal_load((const u32x4*)(f + (size_t)r0 * DM + 8 * (lane + 64 * j)));
        }
#pragma unroll 1
        for (int rr = 0; rr < 8; ++rr) {
            const size_t row = (size_t)(r0 + rr);
            { const size_t rn = rr < 7 ? row + 1 : row;
              xrow_load<XIN16>(xn, xin, rn, lane);
              if (HAS_RES) {
#pragma unroll
                  for (int j = 0; j < 4; ++j) fn[j] = __builtin_nontemporal_load((const u32x4*)(f + rn * DM + 8 * (lane + 64 * j)));
              } }
            f32x4 x[8]; xrow_unpack<XIN16>(xc, x);
            if (HAS_RES) {
                float ss = 0.f;
#pragma unroll
                for (int j = 0; j < 4; ++j)
#pragma unroll
                    for (int e = 0; e < 4; ++e) { const float lo = bf_lo(fc[j][e]), hi = bf_hi(fc[j][e]); ss += lo * lo + hi * hi; }
                const float r1 = __builtin_amdgcn_rsqf(wave_sum(ss) * (1.0f / DM) + EPS);
#pragma unroll
                for (int j = 0; j < 4; ++j) { const u32x4 w = fc[j];
                    x[2 * j] += A[2 * j] * (f32x4){bf_lo(w.x), bf_hi(w.x), bf_lo(w.y), bf_hi(w.y)} * r1; x[2 * j + 1] += A[2 * j + 1] * (f32x4){bf_lo(w.z), bf_hi(w.z), bf_lo(w.w), bf_hi(w.w)} * r1; }
                if (XOUT16) {
#pragma unroll
                    for (int j = 0; j < 4; ++j) { u32x4 w; w.x = pk2(x[2 * j][0], x[2 * j][1]); w.y = pk2(x[2 * j][2], x[2 * j][3]); w.z = pk2(x[2 * j + 1][0], x[2 * j + 1][1]); w.w = pk2(x[2 * j + 1][2], x[2 * j + 1][3]);
                        *(u32x4*)((bf16*)xout + row * DM + 8 * (lane + 64 * j)) = w;
                        x[2 * j] = (f32x4){bf_lo(w.x), bf_hi(w.x), bf_lo(w.y), bf_hi(w.y)}; x[2 * j + 1] = (f32x4){bf_lo(w.z), bf_hi(w.z), bf_lo(w.w), bf_hi(w.w)}; }
                } else {
#pragma unroll
                    for (int j = 0; j < 4; ++j) { f32x4* p = (f32x4*)((float*)xout + row * DM + 8 * (lane + 64 * j)); p[0] = x[2 * j]; p[1] = x[2 * j + 1]; }
                }
            }
            if (HAS_H) {
                float ss = 0.f;
#pragma unroll
                for (int q = 0; q < 8; ++q) ss += (x[q][0] * x[q][0] + x[q][1] * x[q][1]) + (x[q][2] * x[q][2] + x[q][3] * x[q][3]);
                const float r2 = __builtin_amdgcn_rsqf(wave_sum(ss) * (1.0f / DM) + EPS);
                if (HQ8) {
                    float mx = 0.f;
#pragma unroll
                    for (int j = 0; j < 4; ++j) { const f32x4* shp = (const f32x4*)(sh + (size_t)b * NMOD + 8 * (lane + 64 * j));
                        x[2 * j] = x[2 * j] * r2 * Bm[2 * j] + shp[0]; x[2 * j + 1] = x[2 * j + 1] * r2 * Bm[2 * j + 1] + shp[1]; }
#pragma unroll
                    for (int q = 0; q < 8; ++q)
#pragma unroll
                        for (int e = 0; e < 4; ++e) mx = __builtin_fmaxf(mx, __builtin_fabsf(x[q][e]));
                    mx = __builtin_fmaxf(wave_max(mx), 1e-30f);
                    const float inv = 127.0f / mx;
#pragma unroll
                    for (int j = 0; j < 4; ++j) { u32x2 w; w.x = pk4_i8(x[2 * j][0] * inv, x[2 * j][1] * inv, x[2 * j][2] * inv, x[2 * j][3] * inv);
                        w.y = pk4_i8(x[2 * j + 1][0] * inv, x[2 * j + 1][1] * inv, x[2 * j + 1][2] * inv, x[2 * j + 1][3] * inv);
                        *(u32x2*)((unsigned char*)hout + row * (DM * 2) + 8 * (lane + 64 * j)) = w; }
                    if (lane == 0) rowmax[row] = mx;
                } else {
#pragma unroll
                for (int j = 0; j < 4; ++j) { const f32x4* shp = (const f32x4*)(sh + (size_t)b * NMOD + 8 * (lane + 64 * j));
                    const f32x4 h0 = x[2 * j] * r2 * Bm[2 * j] + shp[0], h1 = x[2 * j + 1] * r2 * Bm[2 * j + 1] + shp[1];
                    u32x4 w; w.x = pk2(h0[0], h0[1]); w.y = pk2(h0[2], h0[3]); w.z = pk2(h1[0], h1[1]); w.w = pk2(h1[2], h1[3]);
                    *(u32x4*)(hout + row * DM + 8 * (lane + 64 * j)) = w; }
                }
            }
            xc = xn;
            if (HAS_RES) {
#pragma unroll
                for (int j = 0; j < 4; ++j) fc[j] = fn[j];
            }
        }
    }
}

__device__ __forceinline__ unsigned swz(unsigned row, unsigned ch) { return 256u * row + 16u * (ch ^ (((row & 7u) << 1) | ((row >> 3) & 1u))); }
__device__ __forceinline__ s16x4 vtr(const LAS unsigned char* p) { return __builtin_bit_cast(s16x4, __builtin_amdgcn_ds_read_tr16_b64_v4i16((LAS s16x4*)p)); }
struct AttnItem { int dsh, b, h, r, m0; size_t obase; };
__device__ __forceinline__ AttnItem attn_decode(int idx) {
    AttnItem it; const int p = idx >> 10, rem = idx & 1023, t = rem & 31; it.b = rem >> 8; it.h = (rem >> 5) & 7; it.dsh = 2 * p;
    const int ngrp = (SEQ >> it.dsh) >> 7; it.r = t / ngrp; it.m0 = (t % ngrp) * 128; it.obase = (size_t)p; return it;
}
__device__ __forceinline__ void attn_issue(const AttnItem& it, const bf16* __restrict__ Kb, const bf16* __restrict__ Vb, int tid, u32x4 (&kreg)[8], u32x4 (&vreg)[8]) {
    const int ch = tid & 15, rr = tid >> 4, L = SEQ >> it.dsh;
    const size_t bh = (size_t)it.b * SEQ * AW + (size_t)it.h * 128 + 8 * ch;
#pragma unroll
    for (int i = 0; i < 8; ++i) { int km = it.m0 - 64 + 32 * i + rr; km = km < 0 ? 0 : (km > L - 1 ? L - 1 : km); const size_t off = bh + (size_t)((km << it.dsh) + it.r) * AW;
        kreg[i] = *(const u32x4*)(Kb + off); vreg[i] = *(const u32x4*)(Vb + off); }
}
__device__ __forceinline__ void attn_phase(const Args& a, LAS unsigned char* lds, int tid, int lane, int wave) {
    unsigned char* ws = a.ws;
    const bf16 *Q = (const bf16*)(ws + WS_Q), *Kb = (const bf16*)(ws + WS_K), *Vb = (const bf16*)(ws + WS_V);
    LAS unsigned char* kimg = lds; LAS unsigned char* vimg = lds + 65536;
    const int fr = lane & 15, fq = lane >> 4, G = gridDim.x;
    const unsigned q4 = (unsigned)(lane & 15) >> 2, p4 = (unsigned)lane & 3u;
    constexpr int NITEM = 3 * NB * NH * 32;
    const bool xcd_order = (G == 256);
    const int istep = xcd_order ? 32 : G;
    int idx = xcd_order ? ((int)(blockIdx.x & 7) * (NITEM / 8) + (int)(blockIdx.x >> 3)) : (int)blockIdx.x;
    const int iend = xcd_order ? ((int)(blockIdx.x & 7) + 1) * (NITEM / 8) : NITEM;
    if (idx >= iend) return;
    u32x4 kreg[8], vreg[8];
    AttnItem it = attn_decode(idx);
    attn_issue(it, Kb, Vb, tid, kreg, vreg);
    for (;;) {
        const int L = SEQ >> it.dsh, m0 = it.m0 + 16 * wave;
        const size_t bh = (size_t)it.b * SEQ * AW + (size_t)it.h * 128;
        const int qpos = ((m0 + fr) << it.dsh) + it.r;
        bf16x8 qf[4];
        { const bf16x8* qp = (const bf16x8*)(Q + bh + (size_t)qpos * AW) + fq;
#pragma unroll
          for (int kk = 0; kk < 4; ++kk) qf[kk] = qp[4 * kk]; }
        __syncthreads();
        { const unsigned ch = tid & 15, rr = tid >> 4;
#pragma unroll
          for (int i = 0; i < 8; ++i) { const unsigned o = swz(32u * i + rr, ch); *(LAS u32x4*)(kimg + o) = kreg[i]; *(LAS u32x4*)(vimg + o) = vreg[i]; } }
        __syncthreads();
        const int nidx = idx + istep; const bool has_next = nidx < iend;
        AttnItem nit = it;
        if (has_next) { nit = attn_decode(nidx); attn_issue(nit, Kb, Vb, tid, kreg, vreg); }
        f32x4 s[10];
        const unsigned wrow = 16u * wave;
#pragma unroll
        for (int blk = 0; blk < 9; ++blk) {
            f32x4 acc = {0.f, 0.f, 0.f, 0.f};
#pragma unroll
            for (int kk = 0; kk < 4; ++kk) { const bf16x8 kf = *(const LAS bf16x8*)(kimg + swz(wrow + 16u * blk + fr, 4u * kk + fq)); acc = __builtin_amdgcn_mfma_f32_16x16x32_bf16(kf, qf[kk], acc, 0, 0, 0); }
            s[blk] = acc;
        }
        float mx = -1e30f;
#pragma unroll
        for (int j = 0; j < 4; ++j) { s[0][j] = (4 * fq + j - fr >= 0) ? s[0][j] : -1e30f; s[8][j] = (4 * fq + j - fr <= 0) ? s[8][j] : -1e30f; }
        if (m0 < 64 || m0 + 80 > L) {
#pragma unroll
            for (int blk = 0; blk < 9; ++blk)
#pragma unroll
                for (int j = 0; j < 4; ++j) { const int km = m0 - 64 + 16 * blk + 4 * fq + j; s[blk][j] = (km >= 0 && km < L) ? s[blk][j] : -1e30f; }
        }
#pragma unroll
        for (int blk = 0; blk < 9; ++blk)
#pragma unroll
            for (int j = 0; j < 4; ++j) mx = fmaxf(mx, s[blk][j]);
        mx = fmaxf(mx, __shfl_xor(mx, 16)); mx = fmaxf(mx, __shfl_xor(mx, 32));
        float l = 0.f;
#pragma unroll
        for (int blk = 0; blk < 9; ++blk)
#pragma unroll
            for (int j = 0; j < 4; ++j) { const float p = __builtin_amdgcn_exp2f(s[blk][j] - mx); s[blk][j] = p; l += p; }
        s[9] = (f32x4){0.f, 0.f, 0.f, 0.f};
        l += __shfl_xor(l, 16); l += __shfl_xor(l, 32);
        f32x4 o[8];
#pragma unroll
        for (int c = 0; c < 8; ++c) o[c] = (f32x4){0.f, 0.f, 0.f, 0.f};
#pragma unroll
        for (int ks = 0; ks < 5; ++ks) {
            u32x4 pw; pw.x = pk2(s[2 * ks][0], s[2 * ks][1]); pw.y = pk2(s[2 * ks][2], s[2 * ks][3]); pw.z = pk2(s[2 * ks + 1][0], s[2 * ks + 1][1]); pw.w = pk2(s[2 * ks + 1][2], s[2 * ks + 1][3]);
            const bf16x8 pb = __builtin_bit_cast(bf16x8, pw);
            const unsigned r0 = wrow + 32u * ks + 4u * fq + q4, r1 = (ks == 4) ? r0 : r0 + 16u;
#pragma unroll
            for (int c = 0; c < 8; ++c) {
                const s16x4 a0 = vtr(vimg + swz(r0, 2u * c + (p4 >> 1)) + 8u * (p4 & 1u));
                const s16x4 a1 = vtr(vimg + swz(r1, 2u * c + (p4 >> 1)) + 8u * (p4 & 1u));
                const bf16x8 av = {a0[0], a0[1], a0[2], a0[3], a1[0], a1[1], a1[2], a1[3]};
                o[c] = __builtin_amdgcn_mfma_f32_16x16x32_bf16(av, pb, o[c], 0, 0, 0);
            }
        }
        const float inv = 1.0f / l;
        bf16* op = (bf16*)(ws + WS_O + it.obase * 32 * MiB) + bh + (size_t)qpos * AW + 4 * fq;
#pragma unroll
        for (int c = 0; c < 8; ++c) { u32x2 w; w.x = pk2(o[c][0] * inv, o[c][1] * inv); w.y = pk2(o[c][2] * inv, o[c][3] * inv); *(u32x2*)(op + 16 * c) = w; }
        if (fq == 0) ((float*)(ws + WS_LSE) + it.obase * MT * NH)[((size_t)it.b * SEQ + qpos) * NH + it.h] = mx + __log2f(l);
        if (!has_next) break;
        it = nit; idx = nidx;
    }
}

__device__ __forceinline__ void unpack16(const u32x4 a, const u32x4 b, float* v) {
    v[0] = bf_lo(a.x); v[1] = bf_hi(a.x); v[2] = bf_lo(a.y); v[3] = bf_hi(a.y); v[4] = bf_lo(a.z); v[5] = bf_hi(a.z); v[6] = bf_lo(a.w); v[7] = bf_hi(a.w);
    v[8] = bf_lo(b.x); v[9] = bf_hi(b.x); v[10] = bf_lo(b.y); v[11] = bf_hi(b.y); v[12] = bf_lo(b.z); v[13] = bf_hi(b.z); v[14] = bf_lo(b.w); v[15] = bf_hi(b.w);
}
__device__ __forceinline__ void store16(bf16* p, const float* v) {
    u32x4 a, b; a.x = pk2(v[0], v[1]); a.y = pk2(v[2], v[3]); a.z = pk2(v[4], v[5]); a.w = pk2(v[6], v[7]); b.x = pk2(v[8], v[9]); b.y = pk2(v[10], v[11]); b.z = pk2(v[12], v[13]); b.w = pk2(v[14], v[15]);
    ((u32x4*)p)[0] = a; ((u32x4*)p)[1] = b;
}
#ifndef RING
#define RING 4
#endif
__device__ __forceinline__ void mixpost_phase(const Args& a, LAS unsigned char* lds, int tid, int lane, int wave) {
    unsigned char* ws = a.ws;
    for (int i = tid; i < CK * 1024 / 4; i += NTHR) ((LAS f32x4*)lds)[i] = ((const f32x4*)a.in[I_CONVW])[i];
    __syncthreads();
    const bf16* U = (const bf16*)(ws + WS_U); bf16* MG = (bf16*)(ws + WS_H);
    const float* lse = (const float*)(ws + WS_LSE);
    const int NGW = gridDim.x * NWAVES, c0 = 16 * lane, head = lane >> 3;
    for (int grp = blockIdx.x * NWAVES + wave; grp < MT / 4; grp += NGW) {
        const int row0 = grp * 4, b = row0 >> 12, s0 = row0 & 4095;
#pragma unroll 1
        for (int t = 0; t < 4; ++t) {
            const size_t row = (size_t)(row0 + t);
            float l0 = lse[row * NH + head], l1 = lse[(size_t)MT * NH + row * NH + head], l2 = lse[(size_t)2 * MT * NH + row * NH + head];
            const u32x4* p0 = (const u32x4*)((const bf16*)(ws + WS_O) + row * AW + c0); const u32x4 a00 = p0[0], a01 = p0[1];
            const u32x4* p1 = (const u32x4*)((const bf16*)(ws + WS_O + 32 * MiB) + row * AW + c0); const u32x4 a10 = p1[0], a11 = p1[1];
            const u32x4* p2 = (const u32x4*)((const bf16*)(ws + WS_O + 64 * MiB) + row * AW + c0); const u32x4 a20 = p2[0], a21 = p2[1];
            const float mx = fmaxf(l0, fmaxf(l1, l2)); float w0 = __builtin_amdgcn_exp2f(l0 - mx), w1 = __builtin_amdgcn_exp2f(l1 - mx), w2 = __builtin_amdgcn_exp2f(l2 - mx);
            const float iw = 1.0f / (w0 + w1 + w2); w0 *= iw; w1 *= iw; w2 *= iw;
            float v[16], acc[16];
            unpack16(a00, a01, v);
#pragma unroll
            for (int i = 0; i < 16; ++i) acc[i] = w0 * v[i];
            unpack16(a10, a11, v);
#pragma unroll
            for (int i = 0; i < 16; ++i) acc[i] += w1 * v[i];
            unpack16(a20, a21, v);
#pragma unroll
            for (int i = 0; i < 16; ++i) acc[i] += w2 * v[i];
            float ss = 0.f;
#pragma unroll
            for (int i = 0; i < 16; ++i) ss += acc[i] * acc[i];
            const float rs = __builtin_amdgcn_rsqf(wave_sum(ss) * (1.0f / AW) + EPS);
#pragma unroll
            for (int i = 0; i < 16; i += 4) { const f32x4 g = *(const f32x4*)(a.in[I_AOG] + c0 + i); acc[i] *= rs * g[0]; acc[i + 1] *= rs * g[1]; acc[i + 2] *= rs * g[2]; acc[i + 3] *= rs * g[3]; }
            store16(MG + row * DM + c0, acc);
        }
        float cacc[4][16];
#pragma unroll
        for (int hc = 0; hc < 2; ++hc) {
            const int cc0 = c0 + 8 * hc;
            f32x2 cacc2[4][4], win[4][4]; u32x4 ring[RING];
#define CONV_ISSUE(dst, sp_) do { const int sp = (sp_); const bool ok = (sp >= 0) && (sp < SEQ); dst = *(const u32x4*)(U + ((size_t)b * SEQ + (ok ? sp : 0)) * AW + cc0); if (!ok) dst = (u32x4){0u, 0u, 0u, 0u}; } while (0)
#define CONV_UNPACK(slot, src) do { const u32x4 q0 = src; win[slot][0] = (f32x2){bf_lo(q0.x), bf_hi(q0.x)}; win[slot][1] = (f32x2){bf_lo(q0.y), bf_hi(q0.y)}; win[slot][2] = (f32x2){bf_lo(q0.z), bf_hi(q0.z)}; win[slot][3] = (f32x2){bf_lo(q0.w), bf_hi(q0.w)}; } while (0)
#pragma unroll
            for (int j = 0; j < RING; ++j) CONV_ISSUE(ring[j], s0 - 12 + j);
            { u32x4 w3; CONV_ISSUE(w3, s0 - 15); CONV_UNPACK(0, w3); CONV_ISSUE(w3, s0 - 14); CONV_UNPACK(1, w3); CONV_ISSUE(w3, s0 - 13); CONV_UNPACK(2, w3); }
#pragma unroll
            for (int t = 0; t < 4; ++t)
#pragma unroll
                for (int i = 0; i < 4; ++i) cacc2[t][i] = (f32x2){0.f, 0.f};
#pragma unroll 1
            for (int kb = 0; kb < 32; kb += RING) {
#pragma unroll
                for (int j = 0; j < RING; ++j) { const int k = kb + j;
                    if (k < CK) {
                        CONV_UNPACK((j + 3) & 3, ring[j]);
                        if (k + RING < CK) CONV_ISSUE(ring[j], s0 - 12 + k + RING);
                        f32x2 w[4];
#pragma unroll
                        for (int i = 0; i < 2; ++i) { const f32x4 wv = *(const LAS f32x4*)(lds + ((size_t)k * 1024 + cc0 + 4 * i) * 4); w[2 * i] = (f32x2){wv[0], wv[1]}; w[2 * i + 1] = (f32x2){wv[2], wv[3]}; }
#pragma unroll
                        for (int t = 0; t < 4; ++t)
#pragma unroll
                            for (int i = 0; i < 4; ++i) cacc2[t][i] = __builtin_elementwise_fma(w[i], win[(t + j) & 3][i], cacc2[t][i]);
                    } }
            }
#undef CONV_ISSUE
#undef CONV_UNPACK
#pragma unroll
            for (int t = 0; t < 4; ++t)
#pragma unroll
                for (int i = 0; i < 4; ++i) { cacc[t][8 * hc + 2 * i] = cacc2[t][i][0]; cacc[t][8 * hc + 2 * i + 1] = cacc2[t][i][1]; }
        }
        asm volatile("" ::: "memory");
        float cb[16], lg[16], lb[16], og[16];
#pragma unroll
        for (int i = 0; i < 16; i += 4) { const f32x4 x0 = *(const f32x4*)(a.in[I_CONVB] + c0 + i), x1 = *(const f32x4*)(a.in[I_LNG] + c0 + i), x2 = *(const f32x4*)(a.in[I_LNB] + c0 + i), x3 = *(const f32x4*)(a.in[I_COG] + c0 + i);
#pragma unroll
            for (int e = 0; e < 4; ++e) { cb[i + e] = x0[e]; lg[i + e] = x1[e]; lb[i + e] = x2[e]; og[i + e] = x3[e]; } }
#pragma unroll
        for (int t = 0; t < 4; ++t) {
            float sm = 0.f;
#pragma unroll
            for (int i = 0; i < 16; ++i) { cacc[t][i] += cb[i]; sm += cacc[t][i]; }
            const float mu = wave_sum(sm) * (1.0f / 1024.0f); float sv = 0.f;
#pragma unroll
            for (int i = 0; i < 16; ++i) { cacc[t][i] -= mu; sv += cacc[t][i] * cacc[t][i]; }
            const float rs = __builtin_amdgcn_rsqf(wave_sum(sv) * (1.0f / 1024.0f) + EPS); float s2 = 0.f;
#pragma unroll
            for (int i = 0; i < 16; ++i) { const float y = cacc[t][i] * rs * lg[i] + lb[i]; const float z = y * pg8::sigmoid_f(y); cacc[t][i] = z; s2 += z * z; }
            const float r2 = __builtin_amdgcn_rsqf(wave_sum(s2) * (1.0f / 1024.0f) + EPS);
#pragma unroll
            for (int i = 0; i < 16; ++i) cacc[t][i] *= r2 * og[i];
            store16(MG + (size_t)(row0 + t) * DM + 1024 + c0, cacc[t]);
        }
    }
}

#define XB_TMO      128
#define XB_XCNT(j)  (256  + 64 * (j))
#define XB_XSUB(j)  (1280 + 64 * (j))
#define XB_XGEN(j)  (2304 + 64 * (j))
#define XB_TOP      3328
#define XB_TOPGEN   3392
#define XCD_BAR_WORDS 3456
#define XB_SPIN_CAP (1u << 18)

__device__ __forceinline__ unsigned xb_ld(unsigned* p)              { return __hip_atomic_load(p, __ATOMIC_RELAXED, __HIP_MEMORY_SCOPE_AGENT); }
__device__ __forceinline__ unsigned xb_add(unsigned* p, unsigned v) { return __hip_atomic_fetch_add(p, v, __ATOMIC_RELAXED, __HIP_MEMORY_SCOPE_AGENT); }
__device__ __forceinline__ unsigned xb_xcc_id() { return (unsigned)__builtin_amdgcn_s_getreg((3 << 11) | 20) & 0xFu; }
#define XB_SPIN(cond, bar) do { unsigned _sp = 0; while (cond) { __builtin_amdgcn_s_sleep(1); \
    if ((++_sp & 255u) == 0u) { if (xb_ld(&(bar)[XB_TMO])) break; if (_sp > XB_SPIN_CAP) { atomicAdd(&(bar)[XB_TMO], 1u); break; } } } } while (0)

struct XcdBarrier {
    unsigned* bar; unsigned x;
    volatile LAS unsigned* st;
};

__device__ __forceinline__ XcdBarrier xcd_barrier_post(unsigned* bar, volatile LAS unsigned* st) {
    XcdBarrier b; b.bar = bar; b.x = xb_xcc_id(); b.st = st;
    if (threadIdx.x == 0) (void)xb_add(&bar[XB_XCNT(b.x)], 1u);
    return b;
}
__device__ __forceinline__ void xcd_barrier_complete(unsigned* bar, unsigned x, unsigned& nloc, unsigned& nx) {
    const unsigned G = gridDim.x * gridDim.y * gridDim.z;
    unsigned sum, cnt, mine, sp = 0u;
    for (;;) {
        sum = 0u; cnt = 0u; mine = 0u;
#pragma unroll
        for (unsigned j = 0; j < 16; ++j) { const unsigned c = xb_ld(&bar[XB_XCNT(j)]); sum += c; cnt += (c > 0u) ? 1u : 0u; mine = (j == x) ? c : mine; }
        if (sum == G) break;
        __builtin_amdgcn_s_sleep(1);
        if ((++sp & 255u) == 0u) { if (xb_ld(&bar[XB_TMO])) break; if (sp > XB_SPIN_CAP) { atomicAdd(&bar[XB_TMO], 1u); break; } }
    }
    nloc = mine > 0u ? mine : 1u; nx = cnt > 0u ? cnt : 1u;
}

__device__ __forceinline__ void xcd_barrier(const XcdBarrier& b) {
    asm volatile("s_waitcnt vmcnt(0)" ::: "memory");
    __syncthreads();
    if (threadIdx.x == 0) {
        unsigned* bar = b.bar;
        __builtin_amdgcn_s_waitcnt(0);
        unsigned nloc = b.st[0], nx = b.st[1];
        if (nloc == 0u) { xcd_barrier_complete(bar, b.x, nloc, nx); b.st[0] = nloc; b.st[1] = nx; }
        const unsigned old = xb_add(&bar[XB_XSUB(b.x)], 1u);
        const unsigned gen = old / nloc;
        if (old + 1u == (gen + 1u) * nloc) {
            __builtin_amdgcn_fence(__ATOMIC_RELEASE, "agent");
            asm volatile("s_waitcnt vmcnt(0)" ::: "memory");
            const unsigned og = xb_add(&bar[XB_TOP], 1u);
            const unsigned tg = og / nx;
            if (og + 1u == (tg + 1u) * nx) xb_add(&bar[XB_TOPGEN], 1u);
            else XB_SPIN(xb_ld(&bar[XB_TOPGEN]) == tg, bar);
            __builtin_amdgcn_fence(__ATOMIC_ACQUIRE, "agent");
            xb_add(&bar[XB_XGEN(b.x)], 1u);
            asm volatile("s_waitcnt vmcnt(0)" ::: "memory");
        } else {
            XB_SPIN(xb_ld(&bar[XB_XGEN(b.x)]) == gen, bar);
            __builtin_amdgcn_fence(__ATOMIC_ACQUIRE, "agent");
            asm volatile("s_waitcnt vmcnt(0)" ::: "memory");
        }
    }
    __syncthreads();
}


__global__ void __launch_bounds__(NTHR, 2) fwd_megakernel(Args a) {
    extern __shared__ __attribute__((aligned(16))) unsigned char lds_raw[];
    LAS unsigned char* lds = (LAS unsigned char*)lds_raw;
    cg::grid_group grid = cg::this_grid();
    volatile LAS unsigned* bst = (volatile LAS unsigned*)(lds + 147456 - 64);
    if (threadIdx.x < 2) bst[threadIdx.x] = 0u;
    __syncthreads();
    const XcdBarrier bar = xcd_barrier_post((unsigned*)(a.ws + WS_CTL), bst);
    const int tid0 = threadIdx.x, wave = __builtin_amdgcn_readfirstlane(tid0 >> 6), G = gridDim.x;
#define FRESH() int tid = tid0; asm volatile("" : "+v"(tid)); const int lane = tid & 63; (void)lane;
    unsigned char* ws = a.ws;
    const float* mod = (const float*)(ws + WS_MOD);
    bf16 *HB = (bf16*)(ws + WS_H), *FB = (bf16*)(ws + WS_F), *ACT = (bf16*)(ws + WS_ACT);

    { FRESH();
    p0_prologue(a, lds, tid, lane, wave);
    }
    if (a.ws == nullptr) grid.sync();
    xcd_barrier(bar);
    { FRESH();
    p0b_modreduce(a, tid);
    p0b_quant_weights(a, lds, lane, wave);
    }
    xcd_barrier(bar);
    { FRESH();
    rowpass<false, true, false, false, true>(a.in[I_X], nullptr, nullptr, HB, nullptr, nullptr, 0.f, a.in[I_F1PRE], mod + 1 * DM, mod + 0 * DM, lane, wave, (float*)(ws + WS_RMAX));
    }
    xcd_barrier(bar);
    { FRESH();
    { pg8::Gemm g{HB, (const bf16*)(ws + WS_WGU1), MT, NGU, DM / 2, DM}; pg8::StaticOrder S; S.init(MT, NGU, G, (int)blockIdx.x); S.wg = WG_GU;
      pg8::EpiSwiGLUQ E{ACT, DFF, (const float*)(ws + WS_RMAX), (const float*)(ws + WS_CMAX)};
      pg8::gemm_phase<pg8::EpiSwiGLUQ, pg8::StaticOrder, true, true, false, true>(lds, g, S, E); }
    }
    xcd_barrier(bar);
    { FRESH();
    { pg8::Gemm g{ACT, (const bf16*)(ws + WS_WD1), MT, DM, DFF}; pg8::StaticOrder S; S.init(MT, DM, G, (int)blockIdx.x); S.wg = WG_DN; pg8::EpiPlain E{FB, DM};
      pg8::gemm_phase<pg8::EpiPlain, pg8::StaticOrder, true, true>(lds, g, S, E); }
    }
    xcd_barrier(bar);
    { FRESH();
    rowpass<true, true, false, true>(a.in[I_X], FB, a.out, HB, a.in[I_F1POST], mod + 2 * DM, 0.5f, a.in[I_MIXPRE], mod + 4 * DM, mod + 3 * DM, lane, wave);
    }
    xcd_barrier(bar);
    { FRESH();
    { pg8::Gemm g{HB, (const bf16*)(ws + WS_WIN), MT, NIN, DM}; pg8::StaticOrder S; S.init(MT, NIN, G, (int)blockIdx.x); S.wg = WG_IN;
      pg8::EpiIn E{(bf16*)(ws + WS_Q), (bf16*)(ws + WS_K), (bf16*)(ws + WS_V), (bf16*)(ws + WS_U), (const float*)(ws + WS_ROPE), 0.08838834764831845f * 1.4426950408889634f};
      pg8::gemm_phase<pg8::EpiIn, pg8::StaticOrder, true, true>(lds, g, S, E); }
    }
    xcd_barrier(bar);
    { FRESH();
    attn_phase(a, lds, tid, lane, wave);
    }
    xcd_barrier(bar);
    { FRESH();
    mixpost_phase(a, lds, tid, lane, wave);
    }
    xcd_barrier(bar);
    { FRESH();
    { pg8::Gemm g{HB, (const bf16*)(ws + WS_WOUT), MT, DM, DM}; pg8::StaticOrder S; S.init(MT, DM, G, (int)blockIdx.x); S.wg = WG_DN; pg8::EpiPlain E{FB, DM};
      pg8::gemm_phase<pg8::EpiPlain, pg8::StaticOrder, true, true>(lds, g, S, E); }
    }
    xcd_barrier(bar);
    { FRESH();
    rowpass<true, true, true, true, true>(a.out, FB, ws + WS_O, HB, a.in[I_MIXPOST], mod + 5 * DM, 1.0f, a.in[I_F2PRE], mod + 7 * DM, mod + 6 * DM, lane, wave, (float*)(ws + WS_RMAX));
    }
    xcd_barrier(bar);
    { FRESH();
    { pg8::Gemm g{HB, (const bf16*)(ws + WS_WGU2), MT, NGU, DM / 2, DM}; pg8::StaticOrder S; S.init(MT, NGU, G, (int)blockIdx.x); S.wg = WG_GU;
      pg8::EpiSwiGLUQ E{ACT, DFF, (const float*)(ws + WS_RMAX), (const float*)(ws + WS_CMAX) + NGU};
      pg8::gemm_phase<pg8::EpiSwiGLUQ, pg8::StaticOrder, true, true, false, true>(lds, g, S, E); }
    }
    xcd_barrier(bar);
    { FRESH();
    { pg8::Gemm g{ACT, (const bf16*)(ws + WS_WD2), MT, DM, DFF}; pg8::StaticOrder S; S.init(MT, DM, G, (int)blockIdx.x); S.wg = WG_DN; pg8::EpiPlain E{FB, DM};
      pg8::gemm_phase<pg8::EpiPlain, pg8::StaticOrder, true, true>(lds, g, S, E); }
    }
    xcd_barrier(bar);
    { FRESH();
    rowpass<true, false, true, false>(ws + WS_O, FB, a.out, nullptr, a.in[I_F2POST], mod + 8 * DM, 0.5f, nullptr, nullptr, nullptr, lane, wave);
    }
}

extern "C" void kernel_launch(void* const* d_in, const int* in_sizes, int n_in, void* d_out, int out_size, void* d_ws, size_t ws_size, hipStream_t stream) {
    static int grid = 0;
    if (grid == 0) {
        if (n_in != 24 || out_size != MT * DM || ws_size < WS_END) { fprintf(stderr, "kernel_launch: unexpected shapes (n_in %d, out %d, ws %zu); nothing launched\n", n_in, out_size, ws_size); grid = -1; return; }
        int dev = 0, cus = 0, per_cu = 0;
        (void)hipGetDevice(&dev); (void)hipDeviceGetAttribute(&cus, hipDeviceAttributeMultiprocessorCount, dev);
        if (hipFuncSetAttribute((const void*)fwd_megakernel, hipFuncAttributeMaxDynamicSharedMemorySize, LDS_BYTES) != hipSuccess) { fprintf(stderr, "kernel_launch: hipFuncSetAttribute failed\n"); grid = -1; return; }
        if (hipOccupancyMaxActiveBlocksPerMultiprocessor(&per_cu, (const void*)fwd_megakernel, NTHR, LDS_BYTES) != hipSuccess || per_cu < 1) { fprintf(stderr, "kernel_launch: occupancy query says %d\n", per_cu); per_cu = 1; }
        (void)hipGetLastError();
        grid = cus * 1;
        if (grid <= 0) grid = 256;
    }
    if (grid < 0) return;
    if (hipMemsetAsync((char*)d_ws + WS_CTL, 0, CTL_BYTES, stream) != hipSuccess) { fprintf(stderr, "kernel_launch: memset of the barrier words failed\n"); return; }
    Args a{};
    for (int i = 0; i < 24; ++i) a.in[i] = (const float*)d_in[i];
    a.out = (float*)d_out; a.ws = (unsigned char*)d_ws;
    void* args[] = {&a};
    hipError_t e = hipLaunchCooperativeKernel((const void*)fwd_megakernel, dim3(grid), dim3(NTHR), args, LDS_BYTES, stream);
    if (e != hipSuccess) fprintf(stderr, "cooperative launch failed: %s (grid %d)\n", hipGetErrorString(e), grid);
}
```

```cpp
#include <hip/hip_runtime.h>
#include <hip/hip_cooperative_groups.h>
#include <cstdio>
#include <cstdint>
namespace cg = cooperative_groups;
namespace pg8 {
#define PG8_LAS __attribute__((address_space(3)))
typedef unsigned short bf16_t;
typedef short bf16x8 __attribute__((ext_vector_type(8)));
typedef float f32x4 __attribute__((ext_vector_type(4)));
typedef unsigned u32x4 __attribute__((ext_vector_type(4)));
constexpr int BM = 256, BK = 64, HALF = 128, HTB = HALF * BK * 2  , STAGE_BYTES = 8 * HTB, NXCD = 8, WGM = 8;

__host__ __device__ __forceinline__ int lds_byte(int r, int c) { const int st = (r >> 4) * 2 + (c >> 5), rr = r & 15, cc = c & 31, ob = rr * 64 + cc * 2; return st * 1024 + (ob ^ (((ob >> 9) & 1) << 5)); }
__host__ __device__ __forceinline__ void stage_rc(int b, int& R, int& C) { const int st = b / 1024, sb = b % 1024, swz = sb ^ (((sb >> 9) & 1) << 5); R = (st >> 1) * 16 + swz / 64; C = (st & 1) * 32 + (swz % 64) / 2; }
__host__ __device__ __forceinline__ int perm32(int rho) { const int n = rho >> 4, i = rho & 15; return 8 * (i >> 2) + 4 * n + (i & 3); }

struct Unit { int pm, pn; };
struct Gemm { const bf16_t* A; const bf16_t* Bt; int M, N, K; int ld; };

struct StaticOrder {
    int nM, nN, nwg, G, c, wg = WGM;
    __host__ __device__ void init(int M, int N, int G_, int c_) { nM = M / BM; nN = N / BM; nwg = nM * nN; G = G_; c = c_; }
    __host__ __device__ bool next(int i, Unit& u) const {
        const long L = (long)i * G + c; if (L >= nwg) return false;
        int wgid = (int)L; { const int q = nwg / NXCD, r = nwg % NXCD, xcd = wgid % NXCD, off = wgid / NXCD; wgid = (xcd < r ? xcd * (q + 1) : r * (q + 1) + (xcd - r) * q) + off; }
        const int nig = wg * nN, gid = wgid / nig, fm = gid * wg, gsz = (nM - fm) < wg ? (nM - fm) : wg;
        u.pm = fm + ((wgid % nig) % gsz); u.pn = (wgid % nig) / gsz; return true;
    }
    __device__ __forceinline__ void a_ready(const Unit&) const {}
    __device__ __forceinline__ void done(const Unit&) const {}
};

typedef float f32x2_t __attribute__((ext_vector_type(2)));
typedef __bf16 bf16x2_t __attribute__((ext_vector_type(2)));
__device__ __forceinline__ unsigned pk_bf16(float lo, float hi) { f32x2_t v = {lo, hi}; bf16x2_t b = __builtin_convertvector(v, bf16x2_t); return __builtin_bit_cast(unsigned, b); }
__device__ __forceinline__ float sigmoid_f(float x) { return __builtin_amdgcn_rcpf(1.0f + __builtin_amdgcn_exp2f(-1.44269504089f * x)); }
typedef unsigned u32x2 __attribute__((ext_vector_type(2)));

template <int MODE> __device__ __forceinline__ void epi_glu_store(const f32x4 (&acc)[2][2][4][2], bf16_t* O, int ldc, int row0, int col0) {
#pragma unroll
    for (int ai = 0; ai < 2; ++ai)
#pragma unroll
        for (int m = 0; m < 4; ++m) {
            bf16_t* rowp = O + (size_t)(row0 + ai * HALF + m * 16) * ldc + col0;
            float r[8];
#pragma unroll
            for (int n = 0; n < 2; ++n)
#pragma unroll
                for (int e = 0; e < 4; ++e) { const float a = acc[ai][0][m][n][e], b = acc[ai][1][m][n][e];
                    r[4 * n + e] = (MODE == 0) ? (a * sigmoid_f(a)) * b : a * sigmoid_f(b); }
            u32x4 w; w.x = pk_bf16(r[0], r[1]); w.y = pk_bf16(r[2], r[3]); w.z = pk_bf16(r[4], r[5]); w.w = pk_bf16(r[6], r[7]);
            *(u32x4*)rowp = w; }
}
__device__ __forceinline__ void epi_plain_store(const f32x4 (&acc)[2][2][4][2], bf16_t* O, int ldc, int row0, int col0) {
#pragma unroll
    for (int ai = 0; ai < 2; ++ai)
#pragma unroll
        for (int m = 0; m < 4; ++m) {
            bf16_t* rowp = O + (size_t)(row0 + ai * HALF + m * 16) * ldc + col0;
#pragma unroll
            for (int bj = 0; bj < 2; ++bj) { const f32x4 v0 = acc[ai][bj][m][0], v1 = acc[ai][bj][m][1];
                u32x4 w; w.x = pk_bf16(v0[0], v0[1]); w.y = pk_bf16(v0[2], v0[3]); w.z = pk_bf16(v1[0], v1[1]); w.w = pk_bf16(v1[2], v1[3]);
                *(u32x4*)(rowp + bj * HALF) = w; } }
}
__device__ __forceinline__ float clamp448(float v) { return __builtin_fminf(__builtin_fmaxf(v, -448.0f), 448.0f); }
__device__ __forceinline__ unsigned pk4_fp8(float a, float b, float c, float d) {
    int w = 0; w = __builtin_amdgcn_cvt_pk_fp8_f32(clamp448(a), clamp448(b), w, false); w = __builtin_amdgcn_cvt_pk_fp8_f32(clamp448(c), clamp448(d), w, true); return (unsigned)w; }
struct EpiSwiGLU8 {
    static constexpr bool PERM = false, AFTER_DRAIN = false;
    unsigned char* O; int ldc; float scale;
    __device__ __forceinline__ void operator()(const f32x4 (&acc)[2][2][4][2], const Unit& u, int wr, int wc, int fr, int fq) const {
        const int row0 = u.pm * BM + wr * 64 + fr, col0 = u.pn * HALF + wc * 32 + 8 * fq;
#pragma unroll
        for (int ai = 0; ai < 2; ++ai)
#pragma unroll
            for (int m = 0; m < 4; ++m) {
                unsigned char* rowp = O + (size_t)(row0 + ai * HALF + m * 16) * ldc + col0;
                float r[8];
#pragma unroll
                for (int n = 0; n < 2; ++n)
#pragma unroll
                    for (int e = 0; e < 4; ++e) { const float a = acc[ai][0][m][n][e], b = acc[ai][1][m][n][e]; r[4 * n + e] = (a * sigmoid_f(a)) * b * scale; }
                u32x2 w; w.x = pk4_fp8(r[0], r[1], r[2], r[3]); w.y = pk4_fp8(r[4], r[5], r[6], r[7]);
                *(u32x2*)rowp = w; }
    }
};
struct EpiPlainScaled {
    static constexpr bool PERM = false, AFTER_DRAIN = false;
    bf16_t* O; int ldc; float oscale;
    __device__ __forceinline__ void operator()(const f32x4 (&acc)[2][2][4][2], const Unit& u, int wr, int wc, int fr, int fq) const {
        const int row0 = u.pm * BM + wr * 64 + fr, col0 = u.pn * BM + wc * 32 + 8 * fq;
#pragma unroll
        for (int ai = 0; ai < 2; ++ai)
#pragma unroll
            for (int m = 0; m < 4; ++m) {
                bf16_t* rowp = O + (size_t)(row0 + ai * HALF + m * 16) * ldc + col0;
#pragma unroll
                for (int bj = 0; bj < 2; ++bj) { const f32x4 v0 = acc[ai][bj][m][0] * oscale, v1 = acc[ai][bj][m][1] * oscale;
                    u32x4 w; w.x = pk_bf16(v0[0], v0[1]); w.y = pk_bf16(v0[2], v0[3]); w.z = pk_bf16(v1[0], v1[1]); w.w = pk_bf16(v1[2], v1[3]);
                    *(u32x4*)(rowp + bj * HALF) = w; } }
    }
};
__device__ __forceinline__ int f2i(float x) { return __builtin_bit_cast(int, x); }
struct EpiSwiGLUQ {
    static constexpr bool PERM = false, AFTER_DRAIN = false;
    bf16_t* O; int ldc; const float* rowmax; const float* colmax;
    __device__ __forceinline__ void operator()(const f32x4 (&acc)[2][2][4][2], const Unit& u, int wr, int wc, int fr, int fq) const {
        const int row0 = u.pm * BM + wr * 64 + fr, col0 = u.pn * HALF + wc * 32 + 8 * fq, j0 = u.pn * BM + wc * 32 + 4 * fq;
        const float k2 = 1.0f / (127.0f * 127.0f);
        f32x4 cg[2], cu[2];
#pragma unroll
        for (int n = 0; n < 2; ++n) { cg[n] = *(const f32x4*)(colmax + j0 + 16 * n) * k2; cu[n] = *(const f32x4*)(colmax + j0 + HALF + 16 * n) * k2; }
#pragma unroll
        for (int ai = 0; ai < 2; ++ai)
#pragma unroll
            for (int m = 0; m < 4; ++m) {
                const int row = row0 + ai * HALF + m * 16; const float rs = rowmax[row];
                bf16_t* rowp = O + (size_t)row * ldc + col0;
                float r[8];
#pragma unroll
                for (int n = 0; n < 2; ++n)
#pragma unroll
                    for (int e = 0; e < 4; ++e) { const float ga = acc[ai][0][m][n][e], ua = acc[ai][1][m][n][e];
                        const float a = (float)f2i(ga) * (rs * cg[n][e]), b = (float)f2i(ua) * (rs * cu[n][e]);
                        r[4 * n + e] = (a * sigmoid_f(a)) * b; }
                u32x4 w; w.x = pk_bf16(r[0], r[1]); w.y = pk_bf16(r[2], r[3]); w.z = pk_bf16(r[4], r[5]); w.w = pk_bf16(r[6], r[7]);
                *(u32x4*)rowp = w; }
    }
};
struct EpiSwiGLU {
    static constexpr bool PERM = false, AFTER_DRAIN = false;
    bf16_t* O; int ldc;
    __device__ __forceinline__ void operator()(const f32x4 (&acc)[2][2][4][2], const Unit& u, int wr, int wc, int fr, int fq) const {
        epi_glu_store<0>(acc, O, ldc, u.pm * BM + wr * 64 + fr, u.pn * HALF + wc * 32 + 8 * fq);
    }
};
struct EpiPlain {
    static constexpr bool PERM = false, AFTER_DRAIN = false;
    bf16_t* O; int ldc;
    __device__ __forceinline__ void operator()(const f32x4 (&acc)[2][2][4][2], const Unit& u, int wr, int wc, int fr, int fq) const {
        epi_plain_store(acc, O, ldc, u.pm * BM + wr * 64 + fr, u.pn * BM + wc * 32 + 8 * fq);
    }
};
struct EpiInQ {
    static constexpr bool PERM = false, AFTER_DRAIN = false;
    bf16_t *Q, *K, *V, *U; const float* rope; float qscale; const float* rowmax; const float* colmax;
    __device__ __forceinline__ void operator()(const f32x4 (&acc)[2][2][4][2], const Unit& u, int wr, int wc, int fr, int fq) const {
        const int row0 = u.pm * BM + wr * 64 + fr, jb = u.pn * BM + wc * 32 + 4 * fq, d0 = 16 * wc + 4 * fq;
        const float k2 = 1.0f / (127.0f * 127.0f);
        f32x4 cs[2][2];
#pragma unroll
        for (int bj = 0; bj < 2; ++bj)
#pragma unroll
            for (int n = 0; n < 2; ++n) cs[bj][n] = *(const f32x4*)(colmax + jb + HALF * bj + 16 * n) * k2;
        const bool isq = u.pn < 4; bf16_t* base = isq ? Q : K; const float sc = isq ? qscale : 1.0f;
#pragma unroll
        for (int ai = 0; ai < 2; ++ai)
#pragma unroll
            for (int m = 0; m < 4; ++m) { const int row = row0 + ai * HALF + m * 16, pos = row & 4095; const float rs = rowmax[row];
                float v[2][2][4];
#pragma unroll
                for (int bj = 0; bj < 2; ++bj)
#pragma unroll
                    for (int n = 0; n < 2; ++n)
#pragma unroll
                        for (int e = 0; e < 4; ++e) { const float t = acc[ai][bj][m][n][e]; v[bj][n][e] = (float)f2i(t) * (rs * cs[bj][n][e]); }
                if (u.pn >= 12) {
                    float r[8];
#pragma unroll
                    for (int n = 0; n < 2; ++n)
#pragma unroll
                        for (int e = 0; e < 4; ++e) r[4 * n + e] = v[0][n][e] * sigmoid_f(v[1][n][e]);
                    u32x4 w; w.x = pk_bf16(r[0], r[1]); w.y = pk_bf16(r[2], r[3]); w.z = pk_bf16(r[4], r[5]); w.w = pk_bf16(r[6], r[7]);
                    *(u32x4*)(U + (size_t)row * 1024 + (u.pn - 12) * HALF + wc * 32 + 8 * fq) = w;
                } else if (u.pn >= 8) {
#pragma unroll
                    for (int bj = 0; bj < 2; ++bj) { u32x4 w; w.x = pk_bf16(v[bj][0][0], v[bj][0][1]); w.y = pk_bf16(v[bj][0][2], v[bj][0][3]); w.z = pk_bf16(v[bj][1][0], v[bj][1][1]); w.w = pk_bf16(v[bj][1][2], v[bj][1][3]);
                        *(u32x4*)(V + (size_t)row * 1024 + (u.pn - 8) * BM + wc * 32 + 8 * fq + bj * HALF) = w; }
                } else {
                    const f32x4 cs0 = *(const f32x4*)(rope + ((size_t)pos * 64 + d0) * 2), cs1 = *(const f32x4*)(rope + ((size_t)pos * 64 + d0) * 2 + 4);
                    const float c[4] = {cs0[0], cs0[2], cs1[0], cs1[2]}, s[4] = {cs0[1], cs0[3], cs1[1], cs1[3]};
#pragma unroll
                    for (int bj = 0; bj < 2; ++bj) { const int head = 2 * (u.pn & 3) + bj; bf16_t* p = base + (size_t)row * 1024 + head * 128 + d0;
                        float o1[4], o2[4];
#pragma unroll
                        for (int e = 0; e < 4; ++e) { const float t1 = v[bj][0][e], t2 = v[bj][1][e]; o1[e] = (t1 * c[e] - t2 * s[e]) * sc; o2[e] = (t2 * c[e] + t1 * s[e]) * sc; }
                        u32x2 w1, w2; w1.x = pk_bf16(o1[0], o1[1]); w1.y = pk_bf16(o1[2], o1[3]); w2.x = pk_bf16(o2[0], o2[1]); w2.y = pk_bf16(o2[2], o2[3]);
                        *(u32x2*)p = w1; *(u32x2*)(p + 64) = w2; }
                } }
    }
};
struct EpiIn {
    static constexpr bool PERM = false, AFTER_DRAIN = false;
    bf16_t *Q, *K, *V, *U; const float* rope;
    float qscale;
    __device__ __forceinline__ void operator()(const f32x4 (&acc)[2][2][4][2], const Unit& u, int wr, int wc, int fr, int fq) const {
        const int row0 = u.pm * BM + wr * 64 + fr;
        if (u.pn >= 12) { epi_glu_store<1>(acc, U, 1024, row0, (u.pn - 12) * HALF + wc * 32 + 8 * fq); return; }
        if (u.pn >= 8) { epi_plain_store(acc, V, 1024, row0, (u.pn - 8) * BM + wc * 32 + 8 * fq); return; }
        const bool isq = u.pn < 4; bf16_t* base = isq ? Q : K; const float sc = isq ? qscale : 1.0f;
        const int d0 = 16 * wc + 4 * fq;
#pragma unroll
        for (int ai = 0; ai < 2; ++ai)
#pragma unroll
            for (int m = 0; m < 4; ++m) { const int row = row0 + ai * HALF + m * 16, pos = row & 4095;
                const f32x4 cs0 = *(const f32x4*)(rope + ((size_t)pos * 64 + d0) * 2), cs1 = *(const f32x4*)(rope + ((size_t)pos * 64 + d0) * 2 + 4);
                const float c[4] = {cs0[0], cs0[2], cs1[0], cs1[2]}, s[4] = {cs0[1], cs0[3], cs1[1], cs1[3]};
#pragma unroll
                for (int bj = 0; bj < 2; ++bj) { const int head = 2 * (u.pn & 3) + bj; bf16_t* p = base + (size_t)row * 1024 + head * 128 + d0;
                    float o1[4], o2[4];
#pragma unroll
                    for (int e = 0; e < 4; ++e) { const float t1 = acc[ai][bj][m][0][e], t2 = acc[ai][bj][m][1][e]; o1[e] = (t1 * c[e] - t2 * s[e]) * sc; o2[e] = (t2 * c[e] + t1 * s[e]) * sc; }
                    u32x2 w1, w2; w1.x = pk_bf16(o1[0], o1[1]); w1.y = pk_bf16(o1[2], o1[3]); w2.x = pk_bf16(o2[0], o2[1]); w2.y = pk_bf16(o2[2], o2[3]);
                    *(u32x2*)p = w1; *(u32x2*)(p + 64) = w2; } }
    }
};

typedef int i32x4 __attribute__((ext_vector_type(4)));
typedef int i32x8 __attribute__((ext_vector_type(8)));
__device__ __forceinline__ i32x8 cat8(bf16x8 lo, bf16x8 hi) { return __builtin_shufflevector(__builtin_bit_cast(i32x4, lo), __builtin_bit_cast(i32x4, hi), 0, 1, 2, 3, 4, 5, 6, 7); }
__device__ __forceinline__ void mfma_f8(f32x4& acc, const i32x8& b, const i32x8& a, int unit_scale) {
    asm volatile("v_mfma_scale_f32_16x16x128_f8f6f4 %0, %1, %2, %0, %3, %3 op_sel_hi:[0,0,0]" : "+v"(acc) : "v"(b), "v"(a), "v"(unit_scale));
}
template <class Epi, class Sched, bool ALIGN_EPI = false, bool SP2 = false, bool F8 = false, bool I8 = false>
__device__ __forceinline__ void gemm_phase(PG8_LAS unsigned char* lds, const Gemm g, const Sched& S, const Epi& E) {
    const int tid = threadIdx.x, wid = __builtin_amdgcn_readfirstlane(tid >> 6), lane = tid & 63, wr = wid >> 2, wc = wid & 3, fr = lane & 15, fq = lane >> 4;
    const int K = g.K, nt = K / BK, LD = g.ld ? g.ld : g.K;
    unsigned voffA[2], voffB[2];
#pragma unroll
    for (int i = 0; i < 2; ++i) { int R, C; stage_rc(tid * 16 + i * 8192, R, C); const int Rb = Epi::PERM ? ((R & ~31) + perm32(R & 31)) : R;
        voffA[i] = (unsigned)(R * LD + C) * 2u; voffB[i] = (unsigned)(Rb * LD + C) * 2u; }
    const size_t kstep = (size_t)(BK * 2);
    const size_t hstep = (size_t)HALF * LD * 2;
    const size_t tstep = 2 * hstep;
    const unsigned ldsw = (unsigned)wid * 1024u;
    const int aoff = lds_byte(wr * 64 + fr, fq * 8), boff = lds_byte(wc * 32 + fr, fq * 8);
#define PG8_SA(b, h) (((b) * 2 + (h)) * HTB)
#define PG8_SB(b, h) ((4 + (b) * 2 + (h)) * HTB)
#define PG8_STAGE(bufoff, gbase, voff) do { _Pragma("unroll") for (int _i = 0; _i < 2; ++_i) \
        __builtin_amdgcn_global_load_lds((const unsigned*)((const char*)(gbase) + (voff)[_i]), (PG8_LAS unsigned*)(lds + (bufoff) + ldsw + _i * 8192), 16, 0, 0); } while (0)
#define PG8_LDA(dst, b, h) do { if constexpr (F8) { _Pragma("unroll") for (int m = 0; m < 4; ++m) dst##8[m] = cat8(*(const PG8_LAS bf16x8*)(lds + PG8_SA(b, h) + aoff + m * 2048), *(const PG8_LAS bf16x8*)(lds + PG8_SA(b, h) + aoff + m * 2048 + 1024)); } \
        else { _Pragma("unroll") for (int m = 0; m < 4; ++m) _Pragma("unroll") for (int k = 0; k < 2; ++k) dst[m][k] = *(const PG8_LAS bf16x8*)(lds + PG8_SA(b, h) + aoff + m * 2048 + k * 1024); } } while (0)
#define PG8_LDB(dst, b, h) do { if constexpr (F8) { _Pragma("unroll") for (int n = 0; n < 2; ++n) dst##8[n] = cat8(*(const PG8_LAS bf16x8*)(lds + PG8_SB(b, h) + boff + n * 2048), *(const PG8_LAS bf16x8*)(lds + PG8_SB(b, h) + boff + n * 2048 + 1024)); } \
        else { _Pragma("unroll") for (int n = 0; n < 2; ++n) _Pragma("unroll") for (int k = 0; k < 2; ++k) dst[n][k] = *(const PG8_LAS bf16x8*)(lds + PG8_SB(b, h) + boff + n * 2048 + k * 1024); } } while (0)
#define PG8_MMA(ai, bj, At, Bt) do { __builtin_amdgcn_s_setprio(1); \
        if constexpr (F8) { _Pragma("unroll") for (int m = 0; m < 4; ++m) _Pragma("unroll") for (int n = 0; n < 2; ++n) \
            mfma_f8(acc[ai][bj][m][n], Bt##8[n], At##8[m], 0x7F7F7F7F); } \
        else if constexpr (I8) { _Pragma("unroll") for (int m = 0; m < 4; ++m) _Pragma("unroll") for (int n = 0; n < 2; ++n) _Pragma("unroll") for (int k = 0; k < 2; ++k) \
            acc[ai][bj][m][n] = __builtin_bit_cast(f32x4, __builtin_amdgcn_mfma_i32_16x16x64_i8(__builtin_bit_cast(i32x4, Bt[n][k]), __builtin_bit_cast(i32x4, At[m][k]), __builtin_bit_cast(i32x4, acc[ai][bj][m][n]), 0, 0, 0)); } \
        else { _Pragma("unroll") for (int m = 0; m < 4; ++m) _Pragma("unroll") for (int n = 0; n < 2; ++n) _Pragma("unroll") for (int k = 0; k < 2; ++k) \
            acc[ai][bj][m][n] = __builtin_amdgcn_mfma_f32_16x16x32_bf16(Bt[n][k], At[m][k], acc[ai][bj][m][n], 0, 0, 0); } \
        __builtin_amdgcn_s_setprio(0); } while (0)
#define PG8_WAIT_V(n) asm volatile("s_waitcnt vmcnt(" #n ")" ::: "memory")
#define PG8_WAIT_L(n) asm volatile("s_waitcnt lgkmcnt(" #n ")" ::: "memory")
#define PG8_BAR __builtin_amdgcn_s_barrier()
#define PG8_SCHED __builtin_amdgcn_sched_barrier(0)
    Unit cur, nxt; int ui = 0;
    if (!S.next(0, cur)) return;
    f32x4 acc[2][2][4][2];
#pragma unroll
    for (int a = 0; a < 2; ++a)
#pragma unroll
        for (int b = 0; b < 2; ++b)
#pragma unroll
            for (int m = 0; m < 4; ++m)
#pragma unroll
                for (int n = 0; n < 2; ++n) acc[a][b][m][n] = (f32x4){0.f, 0.f, 0.f, 0.f};
    bf16x8 At[4][2], B0[2][2], B1[2][2]; i32x8 At8[4], B08[2], B18[2];
    const char* cA = (const char*)g.A + (size_t)cur.pm * tstep; const char* cB = (const char*)g.Bt + (size_t)cur.pn * tstep;
    S.a_ready(cur);
    if constexpr (SP2) {
        PG8_STAGE(PG8_SB(0, 0), cB, voffB); PG8_STAGE(PG8_SB(0, 1), cB + hstep, voffB); PG8_STAGE(PG8_SA(0, 0), cA, voffA); PG8_STAGE(PG8_SA(0, 1), cA + hstep, voffA);
        if (wr == 1) PG8_BAR;
        PG8_WAIT_V(2); PG8_BAR;
        PG8_STAGE(PG8_SB(1, 0), cB + kstep, voffB); PG8_STAGE(PG8_SA(1, 0), cA + kstep, voffA); PG8_STAGE(PG8_SB(1, 1), cB + hstep + kstep, voffB);
        PG8_WAIT_V(6); PG8_BAR;
    } else {
        PG8_STAGE(PG8_SB(0, 0), cB, voffB); PG8_STAGE(PG8_SA(0, 0), cA, voffA); PG8_STAGE(PG8_SB(0, 1), cB + hstep, voffB); PG8_STAGE(PG8_SA(0, 1), cA + hstep, voffA);
        if (wr == 1) PG8_BAR;
        PG8_WAIT_V(4); PG8_BAR;
        PG8_STAGE(PG8_SB(1, 0), cB + kstep, voffB); PG8_STAGE(PG8_SA(1, 0), cA + kstep, voffA); PG8_STAGE(PG8_SB(1, 1), cB + hstep + kstep, voffB);
        PG8_WAIT_V(6); PG8_BAR;
    }
    for (;;) {
        const bool has_next = S.next(ui + 1, nxt);
        const char* nA = has_next ? (const char*)g.A + (size_t)nxt.pm * tstep : cA; const char* nB = has_next ? (const char*)g.Bt + (size_t)nxt.pn * tstep : cB;
        for (int t = 0; t < nt; t += 2) {
            const bool last = (t == nt - 2);
            const char* a1 = cA + (size_t)(t + 1) * kstep;
            const char* a2 = last ? nA : cA + (size_t)(t + 2) * kstep; const char* b2 = last ? nB : cB + (size_t)(t + 2) * kstep;
            const char* a3 = a2 + kstep; const char* b3 = b2 + kstep;
            if (last && has_next) S.a_ready(nxt);
            if constexpr (SP2) {
            PG8_LDB(B0, 0, 0); PG8_LDB(B1, 0, 1); PG8_SCHED; PG8_LDA(At, 0, 0); PG8_STAGE(PG8_SA(1, 1), a1 + hstep, voffA);
            PG8_WAIT_V(8); PG8_WAIT_L(0); PG8_BAR; PG8_MMA(0, 0, At, B0); PG8_MMA(0, 1, At, B1); PG8_BAR; PG8_SCHED;
            PG8_LDA(At, 0, 1); PG8_STAGE(PG8_SB(0, 0), b2, voffB); PG8_STAGE(PG8_SB(0, 1), b2 + hstep, voffB); PG8_STAGE(PG8_SA(0, 0), a2, voffA);
            PG8_WAIT_V(8); PG8_WAIT_L(0); PG8_BAR; PG8_MMA(1, 0, At, B0); PG8_MMA(1, 1, At, B1); PG8_BAR; PG8_SCHED;
            PG8_LDB(B0, 1, 0); PG8_LDB(B1, 1, 1); PG8_SCHED; PG8_LDA(At, 1, 0); PG8_STAGE(PG8_SA(0, 1), a2 + hstep, voffA);
            PG8_WAIT_V(8); PG8_WAIT_L(0); PG8_BAR; PG8_MMA(0, 0, At, B0); PG8_MMA(0, 1, At, B1); PG8_BAR; PG8_SCHED;
            PG8_LDA(At, 1, 1); PG8_STAGE(PG8_SB(1, 0), b3, voffB); PG8_STAGE(PG8_SB(1, 1), b3 + hstep, voffB); PG8_STAGE(PG8_SA(1, 0), a3, voffA);
            PG8_WAIT_V(8); PG8_WAIT_L(0); PG8_BAR; PG8_MMA(1, 0, At, B0); PG8_MMA(1, 1, At, B1); PG8_BAR; PG8_SCHED;
            } else {
            PG8_LDB(B0, 0, 0); PG8_SCHED; PG8_LDA(At, 0, 0); PG8_STAGE(PG8_SA(1, 1), a1 + hstep, voffA);
            PG8_WAIT_L(8); PG8_BAR; PG8_WAIT_L(0); PG8_MMA(0, 0, At, B0); PG8_BAR; PG8_SCHED;
            PG8_LDB(B1, 0, 1); PG8_STAGE(PG8_SB(0, 0), b2, voffB);
            PG8_BAR; PG8_WAIT_L(0); PG8_MMA(0, 1, At, B1); PG8_BAR;
            PG8_LDA(At, 0, 1); PG8_STAGE(PG8_SA(0, 0), a2, voffA);
            PG8_BAR; PG8_WAIT_L(0); PG8_MMA(1, 0, At, B0); PG8_BAR; PG8_SCHED;
            PG8_STAGE(PG8_SB(0, 1), b2 + hstep, voffB);
            PG8_WAIT_V(6); PG8_BAR; PG8_MMA(1, 1, At, B1); PG8_BAR;
            PG8_LDB(B0, 1, 0); PG8_SCHED; PG8_LDA(At, 1, 0); PG8_STAGE(PG8_SA(0, 1), a2 + hstep, voffA);
            PG8_WAIT_L(8); PG8_BAR; PG8_WAIT_L(0); PG8_MMA(0, 0, At, B0); PG8_BAR; PG8_SCHED;
            PG8_LDB(B1, 1, 1); PG8_STAGE(PG8_SB(1, 0), b3, voffB);
            PG8_BAR; PG8_WAIT_L(0); PG8_MMA(0, 1, At, B1); PG8_BAR;
            PG8_LDA(At, 1, 1); PG8_STAGE(PG8_SA(1, 0), a3, voffA);
            PG8_BAR; PG8_WAIT_L(0); PG8_MMA(1, 0, At, B0); PG8_BAR; PG8_SCHED;
            PG8_STAGE(PG8_SB(1, 1), b3 + hstep, voffB);
            PG8_WAIT_V(6); PG8_BAR; PG8_MMA(1, 1, At, B1); PG8_BAR;
            }
        }
        if constexpr (ALIGN_EPI) { if (wr == 0) PG8_BAR; }
        if constexpr (F8) asm volatile("s_nop 15\n\ts_nop 15" ::: "memory");
        if constexpr (!Epi::AFTER_DRAIN) { E(acc, cur, wr, wc, fr, fq); S.done(cur); }
        if (!has_next) break;
#pragma unroll
        for (int a = 0; a < 2; ++a)
#pragma unroll
            for (int b = 0; b < 2; ++b)
#pragma unroll
                for (int m = 0; m < 4; ++m)
#pragma unroll
                    for (int n = 0; n < 2; ++n) acc[a][b][m][n] = (f32x4){0.f, 0.f, 0.f, 0.f};
        cur = nxt; cA = nA; cB = nB; ++ui;
        if constexpr (ALIGN_EPI) { if (wr == 1) PG8_BAR; }
    }
    PG8_WAIT_V(0);
    if constexpr (!ALIGN_EPI) { if (wr == 0) PG8_BAR; }
    PG8_BAR;
    if constexpr (Epi::AFTER_DRAIN) { E.fused(acc, cur, wr, wc, fr, fq, lds, wid, lane); S.done(cur); }
#undef PG8_SA
#undef PG8_SB
#undef PG8_STAGE
#undef PG8_LDA
#undef PG8_LDB
#undef PG8_MMA
#undef PG8_WAIT_V
#undef PG8_WAIT_L
#undef PG8_BAR
#undef PG8_SCHED
}
}

#define LAS __attribute__((address_space(3)))
typedef unsigned short bf16;
typedef float f32x4 __attribute__((ext_vector_type(4)));
typedef unsigned u32x4 __attribute__((ext_vector_type(4)));
typedef unsigned u32x2 __attribute__((ext_vector_type(2)));
typedef short bf16x8 __attribute__((ext_vector_type(8)));
typedef short s16x4 __attribute__((ext_vector_type(4)));
typedef float f32x2 __attribute__((ext_vector_type(2)));
constexpr int NB = 4, SEQ = 4096, DM = 2048, MT = NB * SEQ, DFF = 5632, NGU = 2 * DFF, NIN = 5120, AW = 1024, NH = 8, NMOD = 9 * DM, CK = 31;
constexpr float EPS = 1e-6f;
constexpr int NTHR = 512, NWAVES = 8;
#ifndef WG_GU
#define WG_GU 2
#endif
#ifndef WG_DN
#define WG_DN 4
#endif
#ifndef WG_IN
#define WG_IN 2
#endif
constexpr int KSPLIT = 28, NCG = NMOD / 4;
constexpr size_t MiB = 1u << 20;
constexpr size_t WS_MODP = 0, WS_MOD = 8 * MiB, WS_CTL = 8 * MiB + 512 * 1024, WS_CMAX = WS_CTL + 16384, CTL_BYTES = 16384 + (2 * 11264 + 5120) * 4  , WS_RMAX = WS_CTL + 131072, WS_ROPE = 9 * MiB;
constexpr size_t WS_WGU1 = 12 * MiB, WS_WD1 = 56 * MiB, WS_WIN = 78 * MiB, WS_WOUT = 98 * MiB, WS_WGU2 = 106 * MiB, WS_WD2 = 150 * MiB;
constexpr size_t WS_H = 172 * MiB, WS_F = 236 * MiB, WS_ACT = 300 * MiB;
constexpr size_t WS_Q = 300 * MiB, WS_K = 332 * MiB, WS_V = 364 * MiB, WS_U = 396 * MiB;
constexpr size_t WS_O = 476 * MiB, WS_LSE = 572 * MiB, WS_END = 574 * MiB;
static_assert((size_t)KSPLIT * 4 * NMOD * 4 <= 8 * MiB && WS_ACT + (size_t)MT * DFF * 2 <= WS_O && WS_U + 32 * MiB <= WS_O, "ws map");
constexpr int LDS_BYTES = 147456;

struct Args { const float* in[24]; float* out; unsigned char* ws; };
enum { I_X = 0, I_C, I_WADA, I_BADA, I_F1PRE, I_F1G, I_F1U, I_F1D, I_F1POST, I_MIXPRE, I_WIN, I_CONVW, I_CONVB, I_LNG, I_LNB, I_AOG, I_COG, I_WOUT, I_MIXPOST, I_F2PRE, I_F2G, I_F2U, I_F2D, I_F2POST };

__device__ __forceinline__ unsigned pk2(float lo, float hi) { return pg8::pk_bf16(lo, hi); }
__device__ __forceinline__ float bf_lo(unsigned w) { return __builtin_bit_cast(float, w << 16); }
__device__ __forceinline__ float bf_hi(unsigned w) { return __builtin_bit_cast(float, w & 0xffff0000u); }
__device__ __forceinline__ float wave_max(float v) {
#pragma unroll
    for (int o = 1; o < 64; o <<= 1) v = __builtin_fmaxf(v, __shfl_xor(v, o));
    return v;
}
__device__ __forceinline__ float wave_sum(float v) {
#pragma unroll
    for (int o = 1; o < 64; o <<= 1) v += __shfl_xor(v, o);
    return v;
}

__device__ __forceinline__ int inv_perm32(int hc) { return 16 * ((hc >> 2) & 1) + 4 * (hc >> 3) + (hc & 3); }
__device__ __forceinline__ int dest_row(int kind, int n) {
    if (kind == 0 || kind == 1) return 256 * (n >> 7) + 128 * kind + 32 * ((n & 127) >> 5) + inv_perm32(n & 31);
    if (kind == 2 || kind == 4) return (n & ~31) + inv_perm32(n & 31);
    if (n < 2048) { const int sec = n >> 10, hh = (n >> 7) & 7, cc = n & 127, nn = cc >> 6, d = cc & 63; return sec * 1024 + hh * 128 + 32 * (d >> 4) + 16 * nn + (d & 15); }
    if (n < 3072) return (n & ~31) + inv_perm32(n & 31);
    { const int chn = (n - 3072) & 1023, isg = (n >= 4096) ? 1 : 0; return 3072 + 256 * (chn >> 7) + 128 * isg + 32 * ((chn & 127) >> 5) + inv_perm32(chn & 31); }
}
constexpr float A8_SCALE = 4.0f, W8_SCALE = 1024.0f, O8_SCALE = 1.0f / (4.0f * 1024.0f);
struct TrItem { const float* W; bf16* WT; int K, N, kind, kb, nb; };
__device__ __forceinline__ TrItem tr_decode(const Args& a, int it) {
    constexpr int IT_G = (DM / 64) * (DFF / 64), IT_IN = (DM / 64) * (NIN / 64), IT_OUT = (DM / 64) * (DM / 64);
    unsigned char* ws = a.ws; TrItem t; int r = it;
    auto ffn = [&](int r2, const float* g, const float* u, const float* d, size_t wgu, size_t wd, int dkind) {
        const int w = r2 / IT_G; const int q = r2 - w * IT_G;
        if (w == 0) { t.W = g; t.WT = (bf16*)(ws + wgu); t.K = DM; t.N = DFF; t.kind = 0; t.kb = q / (DFF / 64); t.nb = q % (DFF / 64); }
        else if (w == 1) { t.W = u; t.WT = (bf16*)(ws + wgu); t.K = DM; t.N = DFF; t.kind = 1; t.kb = q / (DFF / 64); t.nb = q % (DFF / 64); }
        else { t.W = d; t.WT = (bf16*)(ws + wd); t.K = DFF; t.N = DM; t.kind = dkind; t.kb = q / (DM / 64); t.nb = q % (DM / 64); } };
    if (r < 3 * IT_G) { ffn(r, a.in[I_F1G], a.in[I_F1U], a.in[I_F1D], WS_WGU1, WS_WD1, 2); return t; }
    r -= 3 * IT_G;
    if (r < IT_IN) { t.W = a.in[I_WIN]; t.WT = (bf16*)(ws + WS_WIN); t.K = DM; t.N = NIN; t.kind = 3; t.kb = r / (NIN / 64); t.nb = r % (NIN / 64); return t; }
    r -= IT_IN;
    if (r < IT_OUT) { t.W = a.in[I_WOUT]; t.WT = (bf16*)(ws + WS_WOUT); t.K = DM; t.N = DM; t.kind = 2; t.kb = r / (DM / 64); t.nb = r % (DM / 64); return t; }
    r -= IT_OUT;
    ffn(r, a.in[I_F2G], a.in[I_F2U], a.in[I_F2D], WS_WGU2, WS_WD2, 2); return t;
}
__device__ __forceinline__ void tr_load(const TrItem& t, f32x4 (&v)[16], int lane) {
    const int lr = lane >> 4, lc = lane & 15;
    const f32x4* src = (const f32x4*)(t.W + (size_t)(64 * t.kb + lr) * t.N + 64 * t.nb) + lc;
#pragma unroll
    for (int i = 0; i < 16; ++i) v[i] = __builtin_nontemporal_load(src + (size_t)i * t.N);
}
__device__ __forceinline__ void tr_colmax(const TrItem& t, const f32x4 (&v)[16], float* colmax, int lane) {
    float m0 = 0.f, m1 = 0.f, m2 = 0.f, m3 = 0.f;
#pragma unroll
    for (int i = 0; i < 16; ++i) { const f32x4 w = v[i]; m0 = __builtin_fmaxf(m0, __builtin_fabsf(w.x)); m1 = __builtin_fmaxf(m1, __builtin_fabsf(w.y)); m2 = __builtin_fmaxf(m2, __builtin_fabsf(w.z)); m3 = __builtin_fmaxf(m3, __builtin_fabsf(w.w)); }
    m0 = __builtin_fmaxf(m0, __shfl_xor(m0, 16)); m0 = __builtin_fmaxf(m0, __shfl_xor(m0, 32));
    m1 = __builtin_fmaxf(m1, __shfl_xor(m1, 16)); m1 = __builtin_fmaxf(m1, __shfl_xor(m1, 32));
    m2 = __builtin_fmaxf(m2, __shfl_xor(m2, 16)); m2 = __builtin_fmaxf(m2, __shfl_xor(m2, 32));
    m3 = __builtin_fmaxf(m3, __shfl_xor(m3, 16)); m3 = __builtin_fmaxf(m3, __shfl_xor(m3, 32));
    if (lane < 16) {
        unsigned* cm = (unsigned*)colmax; const int n = 64 * t.nb + 4 * lane;
        atomicMax(cm + dest_row(t.kind, n + 0), __builtin_bit_cast(unsigned, m0));
        atomicMax(cm + dest_row(t.kind, n + 1), __builtin_bit_cast(unsigned, m1));
        atomicMax(cm + dest_row(t.kind, n + 2), __builtin_bit_cast(unsigned, m2));
        atomicMax(cm + dest_row(t.kind, n + 3), __builtin_bit_cast(unsigned, m3));
    }
}
__device__ __forceinline__ unsigned pk4_i8(float a, float b, float c, float d) {
    const int ia = (int)__builtin_rintf(a), ib = (int)__builtin_rintf(b), ic = (int)__builtin_rintf(c), id = (int)__builtin_rintf(d);
    return ((unsigned)ia & 255u) | (((unsigned)ib & 255u) << 8) | (((unsigned)ic & 255u) << 16) | ((unsigned)id << 24);
}
__device__ __forceinline__ void tr_store_q8(const TrItem& t, const f32x4 (&v)[16], LAS float* scr, const float* colmax, int lane) {
    const int k0 = 64 * t.kb, n0 = 64 * t.nb, lr = lane >> 4, lc = lane & 15;
#pragma unroll
    for (int i = 0; i < 16; ++i) { LAS float* d = scr + (4 * i + lr) * 65 + 4 * lc; d[0] = v[i][0]; d[1] = v[i][1]; d[2] = v[i][2]; d[3] = v[i][3]; }
    const int c4 = lane & 3; unsigned char* W8 = (unsigned char*)t.WT;
#pragma unroll
    for (int j = 0; j < 4; ++j) { const int nn = (lane >> 2) + 16 * j; const LAS float* s = scr + (16 * c4) * 65 + nn;
        const int dr = dest_row(t.kind, n0 + nn); const float inv = 127.0f / __builtin_fmaxf(colmax[dr], 1e-30f);
        u32x4 o;
        o.x = pk4_i8(s[0] * inv, s[65] * inv, s[2 * 65] * inv, s[3 * 65] * inv);
        o.y = pk4_i8(s[4 * 65] * inv, s[5 * 65] * inv, s[6 * 65] * inv, s[7 * 65] * inv);
        o.z = pk4_i8(s[8 * 65] * inv, s[9 * 65] * inv, s[10 * 65] * inv, s[11 * 65] * inv);
        o.w = pk4_i8(s[12 * 65] * inv, s[13 * 65] * inv, s[14 * 65] * inv, s[15 * 65] * inv);
        *(u32x4*)(W8 + (size_t)dr * t.K + k0 + 16 * c4) = o; }
}
__device__ __forceinline__ void tr_store(const TrItem& t, const f32x4 (&v)[16], LAS float* scr, int lane) {
    const int k0 = 64 * t.kb, n0 = 64 * t.nb, lr = lane >> 4, lc = lane & 15;
#pragma unroll
    for (int i = 0; i < 16; ++i) { LAS float* d = scr + (4 * i + lr) * 65 + 4 * lc; d[0] = v[i][0]; d[1] = v[i][1]; d[2] = v[i][2]; d[3] = v[i][3]; }
    if (t.kind == 4) {
        const int c4 = lane & 3; unsigned char* W8 = (unsigned char*)t.WT;
#pragma unroll
        for (int j = 0; j < 4; ++j) { const int nn = (lane >> 2) + 16 * j; const LAS float* s = scr + (16 * c4) * 65 + nn;
            u32x4 o;
            o.x = pg8::pk4_fp8(s[0] * W8_SCALE, s[65] * W8_SCALE, s[2 * 65] * W8_SCALE, s[3 * 65] * W8_SCALE);
            o.y = pg8::pk4_fp8(s[4 * 65] * W8_SCALE, s[5 * 65] * W8_SCALE, s[6 * 65] * W8_SCALE, s[7 * 65] * W8_SCALE);
            o.z = pg8::pk4_fp8(s[8 * 65] * W8_SCALE, s[9 * 65] * W8_SCALE, s[10 * 65] * W8_SCALE, s[11 * 65] * W8_SCALE);
            o.w = pg8::pk4_fp8(s[12 * 65] * W8_SCALE, s[13 * 65] * W8_SCALE, s[14 * 65] * W8_SCALE, s[15 * 65] * W8_SCALE);
            const int dr = dest_row(4, n0 + nn);
            *(u32x4*)(W8 + (size_t)dr * t.K + k0 + 16 * c4) = o; }
        return;
    }
    const int c = lane & 7;
#pragma unroll
    for (int j = 0; j < 8; ++j) { const int nn = (lane >> 3) + 8 * j; const LAS float* s = scr + (8 * c) * 65 + nn;
        u32x4 o; o.x = pk2(s[0], s[65]); o.y = pk2(s[2 * 65], s[3 * 65]); o.z = pk2(s[4 * 65], s[5 * 65]); o.w = pk2(s[6 * 65], s[7 * 65]);
        const int dr = dest_row(t.kind, n0 + nn);
        *(u32x4*)(t.WT + (size_t)dr * t.K + k0 + 8 * c) = o; }
}
__device__ __forceinline__ void p0_prologue(const Args& a, LAS unsigned char* lds, int tid, int lane, int wave) {
    unsigned char* ws = a.ws;
    const int gtid = blockIdx.x * NTHR + tid, gw = blockIdx.x * NWAVES + wave, NGT = gridDim.x * NTHR, NGW = gridDim.x * NWAVES;
    {
        LAS float* cact = (LAS float*)lds;
        for (int i = tid; i < NB * DM; i += NTHR) { const int b = i >> 11, k = i & 2047; const float v = a.in[I_C][i]; cact[k * 4 + b] = v / (1.0f + __expf(-v)); }
        __syncthreads();
        float* part = (float*)(ws + WS_MODP);
        for (int t = gtid; t < NCG * KSPLIT; t += NGT) {
            const int ks = t / NCG, cgp = t % NCG, k0 = ks * DM / KSPLIT, k1 = (ks + 1) * DM / KSPLIT;
            const f32x4* W = (const f32x4*)a.in[I_WADA] + cgp;
            f32x4 acc0 = {0, 0, 0, 0}, acc1 = acc0, acc2 = acc0, acc3 = acc0;
#pragma unroll 8
            for (int k = k0; k < k1; ++k) { const f32x4 w = __builtin_nontemporal_load(W + (size_t)k * NCG); const f32x4 cv = *(const LAS f32x4*)(cact + 4 * k);
                acc0 += w * cv[0]; acc1 += w * cv[1]; acc2 += w * cv[2]; acc3 += w * cv[3]; }
            f32x4* pp = (f32x4*)(part + (size_t)ks * 4 * NMOD) + cgp;
            pp[0] = acc0; pp[NCG] = acc1; pp[2 * NCG] = acc2; pp[3 * NCG] = acc3;
        }
        __syncthreads();
    }
    {
        float* tab = (float*)(ws + WS_ROPE);
        for (int i = gtid; i < SEQ * 64; i += NGT) { const int pos = i >> 6, f = i & 63; const float inv = powf(10000.0f, -(float)f * (1.0f / 64.0f)); const float ang = (float)pos * inv;
            float sn, cs; sincosf(ang, &sn, &cs); tab[2 * i] = cs; tab[2 * i + 1] = sn; }
    }
    {
        LAS float* scr = (LAS float*)(lds + wave * 16640);
        constexpr int NITEMS = 6 * (DM / 64) * (DFF / 64) + (DM / 64) * (NIN / 64) + (DM / 64) * (DM / 64);
        int it = gw;
        if (it < NITEMS) {
            f32x4 va[16], vb[16];
            TrItem cur = tr_decode(a, it); tr_load(cur, va, lane);
            for (;;) {
                const int nx = it + NGW; const bool more = nx < NITEMS; TrItem nxt = cur;
                if (more) { nxt = tr_decode(a, nx); tr_load(nxt, vb, lane); }
                tr_store(cur, va, scr, lane);
                if (!more) break;
#pragma unroll
                for (int i = 0; i < 16; ++i) va[i] = vb[i];
                cur = nxt; it = nx;
            }
        }
    }
}
__device__ __forceinline__ void p0b_quant_weights(const Args& a, LAS unsigned char* lds, int lane, int wave) {
    (void)lds;
    const int NGW = gridDim.x * NWAVES;
    for (int r = blockIdx.x * NWAVES + wave; r < 2 * NGU + NIN; r += NGW) {
        const int mt = r >= 2 * NGU ? 2 : (r >= NGU ? 1 : 0), j = r - mt * NGU;
        unsigned char* rowp = a.ws + (mt == 0 ? WS_WGU1 : (mt == 1 ? WS_WGU2 : WS_WIN)) + (size_t)j * (DM * 2);
        float* cm = (float*)(a.ws + WS_CMAX) + mt * NGU;
        const u32x4* p = (const u32x4*)rowp + 4 * lane;
        u32x4 w[4]; float v[32];
#pragma unroll
        for (int i = 0; i < 4; ++i) w[i] = p[i];
#pragma unroll
        for (int i = 0; i < 4; ++i) { v[8 * i] = bf_lo(w[i].x); v[8 * i + 1] = bf_hi(w[i].x); v[8 * i + 2] = bf_lo(w[i].y); v[8 * i + 3] = bf_hi(w[i].y); v[8 * i + 4] = bf_lo(w[i].z); v[8 * i + 5] = bf_hi(w[i].z); v[8 * i + 6] = bf_lo(w[i].w); v[8 * i + 7] = bf_hi(w[i].w); }
        float mx = 0.f;
#pragma unroll
        for (int i = 0; i < 32; ++i) mx = __builtin_fmaxf(mx, __builtin_fabsf(v[i]));
        mx = __builtin_fmaxf(wave_max(mx), 1e-30f);
        const float inv = 127.0f / mx;
        u32x4 o0, o1;
        o0.x = pk4_i8(v[0] * inv, v[1] * inv, v[2] * inv, v[3] * inv); o0.y = pk4_i8(v[4] * inv, v[5] * inv, v[6] * inv, v[7] * inv); o0.z = pk4_i8(v[8] * inv, v[9] * inv, v[10] * inv, v[11] * inv); o0.w = pk4_i8(v[12] * inv, v[13] * inv, v[14] * inv, v[15] * inv);
        o1.x = pk4_i8(v[16] * inv, v[17] * inv, v[18] * inv, v[19] * inv); o1.y = pk4_i8(v[20] * inv, v[21] * inv, v[22] * inv, v[23] * inv); o1.z = pk4_i8(v[24] * inv, v[25] * inv, v[26] * inv, v[27] * inv); o1.w = pk4_i8(v[28] * inv, v[29] * inv, v[30] * inv, v[31] * inv);
        asm volatile("" ::: "memory");
        u32x4* q = (u32x4*)rowp + 2 * lane;
        q[0] = o0; q[1] = o1;
        if (lane == 0) cm[j] = mx;
    }
}
__device__ __forceinline__ void p0b_modreduce(const Args& a, int tid) {
    const float* part = (const float*)(a.ws + WS_MODP); float* mod = (float*)(a.ws + WS_MOD);
    for (int i = blockIdx.x * NTHR + tid; i < NB * NMOD; i += gridDim.x * NTHR) { const int n = i % NMOD; float s = a.in[I_BADA][n];
#pragma unroll 4
        for (int ks = 0; ks < KSPLIT; ++ks) s += part[(size_t)ks * 4 * NMOD + i];
        mod[i] = s; }
}

template <bool XIN16> struct XRow { u32x4 w[XIN16 ? 4 : 8]; };
template <bool XIN16> __device__ __forceinline__ void xrow_load(XRow<XIN16>& r, const void* xin, size_t row, int lane) {
    if (XIN16) {
#pragma unroll
        for (int j = 0; j < 4; ++j) r.w[j] = __builtin_nontemporal_load((const u32x4*)((const bf16*)xin + row * DM + 8 * (lane + 64 * j)));
    } else {
#pragma unroll
        for (int j = 0; j < 4; ++j) { const u32x4* p = (const u32x4*)((const float*)xin + row * DM + 8 * (lane + 64 * j)); r.w[2 * j] = __builtin_nontemporal_load(p); r.w[2 * j + 1] = __builtin_nontemporal_load(p + 1); }
    }
}
template <bool XIN16> __device__ __forceinline__ void xrow_unpack(const XRow<XIN16>& r, f32x4 (&x)[8]) {
    if (XIN16) {
#pragma unroll
        for (int j = 0; j < 4; ++j) { const u32x4 w = r.w[j]; x[2 * j] = (f32x4){bf_lo(w.x), bf_hi(w.x), bf_lo(w.y), bf_hi(w.y)}; x[2 * j + 1] = (f32x4){bf_lo(w.z), bf_hi(w.z), bf_lo(w.w), bf_hi(w.w)}; }
    } else {
#pragma unroll
        for (int q = 0; q < 8; ++q) x[q] = __builtin_bit_cast(f32x4, r.w[q]);
    }
}
template <bool HAS_RES, bool HAS_H, bool XIN16, bool XOUT16, bool HQ8 = false>
__device__ __forceinline__ void rowpass(const void* xin, const bf16* f, void* xout, bf16* hout, const float* post_g, const float* gate, float coef,
                                        const float* pre_g, const float* sc, const float* sh, int lane, int wave, float* rowmax = nullptr) {
    const int NGW = gridDim.x * NWAVES;
    for (int grp = blockIdx.x * NWAVES + wave; grp < MT / 8; grp += NGW) {
        const int r0 = grp * 8, b = r0 >> 12;
        f32x4 A[8], Bm[8];
#pragma unroll
        for (int j = 0; j < 4; ++j)
#pragma unroll
            for (int hh = 0; hh < 2; ++hh) { const int col = 8 * (lane + 64 * j) + 4 * hh;
                if (HAS_RES) { const f32x4 g = *(const f32x4*)(gate + (size_t)b * NMOD + col), pg = *(const f32x4*)(post_g + col); A[2 * j + hh] = g * pg * coef; }
                if (HAS_H) { const f32x4 s = *(const f32x4*)(sc + (size_t)b * NMOD + col), pg = *(const f32x4*)(pre_g + col); Bm[2 * j + hh] = pg * (s + 1.0f); }
            }
        XRow<XIN16> xc, xn; u32x4 fc[4], fn[4];
        xrow_load<XIN16>(xc, xin, (size_t)r0, lane);
        if (HAS_RES) {
#pragma unroll
            for (int j = 0; j < 4; ++j) fc[j] = __builtin_nontemporal_load((const u32x4*)(f + (size_t)r0 * DM + 8 * (lane + 64 * j)));
        }
#pragma unroll 1
        for (int rr = 0; rr < 8; ++rr) {
            const size_t row = (size_t)(r0 + rr);
            { const size_t rn = rr < 7 ? row + 1 : row;
              xrow_load<XIN16>(xn, xin, rn, lane);
              if (HAS_RES) {
#pragma unroll
                  for (int j = 0; j < 4; ++j) fn[j] = __builtin_nontemporal_load((const u32x4*)(f + rn * DM + 8 * (lane + 64 * j)));
              } }
            f32x4 x[8]; xrow_unpack<XIN16>(xc, x);
            if (HAS_RES) {
                float ss = 0.f;
#pragma unroll
                for (int j = 0; j < 4; ++j)
#pragma unroll
                    for (int e = 0; e < 4; ++e) { const float lo = bf_lo(fc[j][e]), hi = bf_hi(fc[j][e]); ss += lo * lo + hi * hi; }
                const float r1 = __builtin_amdgcn_rsqf(wave_sum(ss) * (1.0f / DM) + EPS);
#pragma unroll
                for (int j = 0; j < 4; ++j) { const u32x4 w = fc[j];
                    x[2 * j] += A[2 * j] * (f32x4){bf_lo(w.x), bf_hi(w.x), bf_lo(w.y), bf_hi(w.y)} * r1; x[2 * j + 1] += A[2 * j + 1] * (f32x4){bf_lo(w.z), bf_hi(w.z), bf_lo(w.w), bf_hi(w.w)} * r1; }
                if (XOUT16) {
#pragma unroll
                    for (int j = 0; j < 4; ++j) { u32x4 w; w.x = pk2(x[2 * j][0], x[2 * j][1]); w.y = pk2(x[2 * j][2], x[2 * j][3]); w.z = pk2(x[2 * j + 1][0], x[2 * j + 1][1]); w.w = pk2(x[2 * j + 1][2], x[2 * j + 1][3]);
                        *(u32x4*)((bf16*)xout + row * DM + 8 * (lane + 64 * j)) = w;
                        x[2 * j] = (f32x4){bf_lo(w.x), bf_hi(w.x), bf_lo(w.y), bf_hi(w.y)}; x[2 * j + 1] = (f32x4){bf_lo(w.z), bf_hi(w.z), bf_lo(w.w), bf_hi(w.w)}; }
                } else {
#pragma unroll
                    for (int j = 0; j < 4; ++j) { f32x4* p = (f32x4*)((float*)xout + row * DM + 8 * (lane + 64 * j)); p[0] = x[2 * j]; p[1] = x[2 * j + 1]; }
                }
            }
            if (HAS_H) {
                float ss = 0.f;
#pragma unroll
                for (int q = 0; q < 8; ++q) ss += (x[q][0] * x[q][0] + x[q][1] * x[q][1]) + (x[q][2] * x[q][2] + x[q][3] * x[q][3]);
                const float r2 = __builtin_amdgcn_rsqf(wave_sum(ss) * (1.0f / DM) + EPS);
                if (HQ8) {
                    float mx = 0.f;
#pragma unroll
                    for (int j = 0; j < 4; ++j) { const f32x4* shp = (const f32x4*)(sh + (size_t)b * NMOD + 8 * (lane + 64 * j));
                        x[2 * j] = x[2 * j] * r2 * Bm[2 * j] + shp[0]; x[2 * j + 1] = x[2 * j + 1] * r2 * Bm[2 * j + 1] + shp[1]; }
#pragma unroll
                    for (int q = 0; q < 8; ++q)
#pragma unroll
                        for (int e = 0; e < 4; ++e) mx = __builtin_fmaxf(mx, __builtin_fabsf(x[q][e]));
                    mx = __builtin_fmaxf(wave_max(mx), 1e-30f);
                    const float inv = 127.0f / mx;
#pragma unroll
                    for (int j = 0; j < 4; ++j) { u32x2 w; w.x = pk4_i8(x[2 * j][0] * inv, x[2 * j][1] * inv, x[2 * j][2] * inv, x[2 * j][3] * inv);
                        w.y = pk4_i8(x[2 * j + 1][0] * inv, x[2 * j + 1][1] * inv, x[2 * j + 1][2] * inv, x[2 * j + 1][3] * inv);
                        *(u32x2*)((unsigned char*)hout + row * (DM * 2) + 8 * (lane + 64 * j)) = w; }
                    if (lane == 0) rowmax[row] = mx;
                } else {
#pragma unroll
                for (int j = 0; j < 4; ++j) { const f32x4* shp = (const f32x4*)(sh + (size_t)b * NMOD + 8 * (lane + 64 * j));
                    const f32x4 h0 = x[2 * j] * r2 * Bm[2 * j] + shp[0], h1 = x[2 * j + 1] * r2 * Bm[2 * j + 1] + shp[1];
                    u32x4 w; w.x = pk2(h0[0], h0[1]); w.y = pk2(h0[2], h0[3]); w.z = pk2(h1[0], h1[1]); w.w = pk2(h1[2], h1[3]);
                    *(u32x4*)(hout + row * DM + 8 * (lane + 64 * j)) = w; }
                }
            }
            xc = xn;
            if (HAS_RES) {
#pragma unroll
                for (int j = 0; j < 4; ++j) fc[j] = fn[j];
            }
        }
    }
}

__device__ __forceinline__ unsigned swz(unsigned row, unsigned ch) { return 256u * row + 16u * (ch ^ (((row & 7u) << 1) | ((row >> 3) & 1u))); }
__device__ __forceinline__ s16x4 vtr(const LAS unsigned char* p) { return __builtin_bit_cast(s16x4, __builtin_amdgcn_ds_read_tr16_b64_v4i16((LAS s16x4*)p)); }
struct AttnItem { int dsh, b, h, r, m0; size_t obase; };
__device__ __forceinline__ AttnItem attn_decode(int idx) {
    AttnItem it; const int p = idx >> 10, rem = idx & 1023, t = rem & 31; it.b = rem >> 8; it.h = (rem >> 5) & 7; it.dsh = 2 * p;
    const int ngrp = (SEQ >> it.dsh) >> 7; it.r = t / ngrp; it.m0 = (t % ngrp) * 128; it.obase = (size_t)p; return it;
}
__device__ __forceinline__ void attn_issue(const AttnItem& it, const bf16* __restrict__ Kb, const bf16* __restrict__ Vb, int tid, u32x4 (&kreg)[8], u32x4 (&vreg)[8]) {
    const int ch = tid & 15, rr = tid >> 4, L = SEQ >> it.dsh;
    const size_t bh = (size_t)it.b * SEQ * AW + (size_t)it.h * 128 + 8 * ch;
#pragma unroll
    for (int i = 0; i < 8; ++i) { int km = it.m0 - 64 + 32 * i + rr; km = km < 0 ? 0 : (km > L - 1 ? L - 1 : km); const size_t off = bh + (size_t)((km << it.dsh) + it.r) * AW;
        kreg[i] = *(const u32x4*)(Kb + off); vreg[i] = *(const u32x4*)(Vb + off); }
}
__device__ __forceinline__ void attn_phase(const Args& a, LAS unsigned char* lds, int tid, int lane, int wave) {
    unsigned char* ws = a.ws;
    const bf16 *Q = (const bf16*)(ws + WS_Q), *Kb = (const bf16*)(ws + WS_K), *Vb = (const bf16*)(ws + WS_V);
    LAS unsigned char* kimg = lds; LAS unsigned char* vimg = lds + 65536;
    const int fr = lane & 15, fq = lane >> 4, G = gridDim.x;
    const unsigned q4 = (unsigned)(lane & 15) >> 2, p4 = (unsigned)lane & 3u;
    constexpr int NITEM = 3 * NB * NH * 32;
    const bool xcd_order = (G == 256);
    const int istep = xcd_order ? 32 : G;
    int idx = xcd_order ? ((int)(blockIdx.x & 7) * (NITEM / 8) + (int)(blockIdx.x >> 3)) : (int)blockIdx.x;
    const int iend = xcd_order ? ((int)(blockIdx.x & 7) + 1) * (NITEM / 8) : NITEM;
    if (idx >= iend) return;
    u32x4 kreg[8], vreg[8];
    AttnItem it = attn_decode(idx);
    attn_issue(it, Kb, Vb, tid, kreg, vreg);
    for (;;) {
        const int L = SEQ >> it.dsh, m0 = it.m0 + 16 * wave;
        const size_t bh = (size_t)it.b * SEQ * AW + (size_t)it.h * 128;
        const int qpos = ((m0 + fr) << it.dsh) + it.r;
        bf16x8 qf[4];
        { const bf16x8* qp = (const bf16x8*)(Q + bh + (size_t)qpos * AW) + fq;
#pragma unroll
          for (int kk = 0; kk < 4; ++kk) qf[kk] = qp[4 * kk]; }
        __syncthreads();
        { const unsigned ch = tid & 15, rr = tid >> 4;
#pragma unroll
          for (int i = 0; i < 8; ++i) { const unsigned o = swz(32u * i + rr, ch); *(LAS u32x4*)(kimg + o) = kreg[i]; *(LAS u32x4*)(vimg + o) = vreg[i]; } }
        __syncthreads();
        const int nidx = idx + istep; const bool has_next = nidx < iend;
        AttnItem nit = it;
        if (has_next) { nit = attn_decode(nidx); attn_issue(nit, Kb, Vb, tid, kreg, vreg); }
        f32x4 s[10];
        const unsigned wrow = 16u * wave;
#pragma unroll
        for (int blk = 0; blk < 9; ++blk) {
            f32x4 acc = {0.f, 0.f, 0.f, 0.f};
#pragma unroll
            for (int kk = 0; kk < 4; ++kk) { const bf16x8 kf = *(const LAS bf16x8*)(kimg + swz(wrow + 16u * blk + fr, 4u * kk + fq)); acc = __builtin_amdgcn_mfma_f32_16x16x32_bf16(kf, qf[kk], acc, 0, 0, 0); }
            s[blk] = acc;
        }
        float mx = -1e30f;
#pragma unroll
        for (int j = 0; j < 4; ++j) { s[0][j] = (4 * fq + j - fr >= 0) ? s[0][j] : -1e30f; s[8][j] = (4 * fq + j - fr <= 0) ? s[8][j] : -1e30f; }
        if (m0 < 64 || m0 + 80 > L) {
#pragma unroll
            for (int blk = 0; blk < 9; ++blk)
#pragma unroll
                for (int j = 0; j < 4; ++j) { const int km = m0 - 64 + 16 * blk + 4 * fq + j; s[blk][j] = (km >= 0 && km < L) ? s[blk][j] : -1e30f; }
        }
#pragma unroll
        for (int blk = 0; blk < 9; ++blk)
#pragma unroll
            for (int j = 0; j < 4; ++j) mx = fmaxf(mx, s[blk][j]);
        mx = fmaxf(mx, __shfl_xor(mx, 16)); mx = fmaxf(mx, __shfl_xor(mx, 32));
        float l = 0.f;
#pragma unroll
        for (int blk = 0; blk < 9; ++blk)
#pragma unroll
            for (int j = 0; j < 4; ++j) { const float p = __builtin_amdgcn_exp2f(s[blk][j] - mx); s[blk][j] = p; l += p; }
        s[9] = (f32x4){0.f, 0.f, 0.f, 0.f};
        l += __shfl_xor(l, 16); l += __shfl_xor(l, 32);
        f32x4 o[8];
#pragma unroll
        for (int c = 0; c < 8; ++c) o[c] = (f32x4){0.f, 0.f, 0.f, 0.f};
#pragma unroll
        for (int ks = 0; ks < 5; ++ks) {
            u32x4 pw; pw.x = pk2(s[2 * ks][0], s[2 * ks][1]); pw.y = pk2(s[2 * ks][2], s[2 * ks][3]); pw.z = pk2(s[2 * ks + 1][0], s[2 * ks + 1][1]); pw.w = pk2(s[2 * ks + 1][2], s[2 * ks + 1][3]);
            const bf16x8 pb = __builtin_bit_cast(bf16x8, pw);
            const unsigned r0 = wrow + 32u * ks + 4u * fq + q4, r1 = (ks == 4) ? r0 : r0 + 16u;
#pragma unroll
            for (int c = 0; c < 8; ++c) {
                const s16x4 a0 = vtr(vimg + swz(r0, 2u * c + (p4 >> 1)) + 8u * (p4 & 1u));
                const s16x4 a1 = vtr(vimg + swz(r1, 2u * c + (p4 >> 1)) + 8u * (p4 & 1u));
                const bf16x8 av = {a0[0], a0[1], a0[2], a0[3], a1[0], a1[1], a1[2], a1[3]};
                o[c] = __builtin_amdgcn_mfma_f32_16x16x32_bf16(av, pb, o[c], 0, 0, 0);
            }
        }
        const float inv = 1.0f / l;
        bf16* op = (bf16*)(ws + WS_O + it.obase * 32 * MiB) + bh + (size_t)qpos * AW + 4 * fq;
#pragma unroll
        for (int c = 0; c < 8; ++c) { u32x2 w; w.x = pk2(o[c][0] * inv, o[c][1] * inv); w.y = pk2(o[c][2] * inv, o[c][3] * inv); *(u32x2*)(op + 16 * c) = w; }
        if (fq == 0) ((float*)(ws + WS_LSE) + it.obase * MT * NH)[((size_t)it.b * SEQ + qpos) * NH + it.h] = mx + __log2f(l);
        if (!has_next) break;
        it = nit; idx = nidx;
    }
}

__device__ __forceinline__ void unpack16(const u32x4 a, const u32x4 b, float* v) {
    v[0] = bf_lo(a.x); v[1] = bf_hi(a.x); v[2] = bf_lo(a.y); v[3] = bf_hi(a.y); v[4] = bf_lo(a.z); v[5] = bf_hi(a.z); v[6] = bf_lo(a.w); v[7] = bf_hi(a.w);
    v[8] = bf_lo(b.x); v[9] = bf_hi(b.x); v[10] = bf_lo(b.y); v[11] = bf_hi(b.y); v[12] = bf_lo(b.z); v[13] = bf_hi(b.z); v[14] = bf_lo(b.w); v[15] = bf_hi(b.w);
}
__device__ __forceinline__ void store16(bf16* p, const float* v) {
    u32x4 a, b; a.x = pk2(v[0], v[1]); a.y = pk2(v[2], v[3]); a.z = pk2(v[4], v[5]); a.w = pk2(v[6], v[7]); b.x = pk2(v[8], v[9]); b.y = pk2(v[10], v[11]); b.z = pk2(v[12], v[13]); b.w = pk2(v[14], v[15]);
    ((u32x4*)p)[0] = a; ((u32x4*)p)[1] = b;
}
#ifndef RING
#define RING 4
#endif
__device__ __forceinline__ void mixpost_phase(const Args& a, LAS unsigned char* lds, int tid, int lane, int wave) {
    unsigned char* ws = a.ws;
    for (int i = tid; i < CK * 1024 / 4; i += NTHR) ((LAS f32x4*)lds)[i] = ((const f32x4*)a.in[I_CONVW])[i];
    __syncthreads();
    const bf16* U = (const bf16*)(ws + WS_U); bf16* MG = (bf16*)(ws + WS_H);
    const float* lse = (const float*)(ws + WS_LSE);
    const int NGW = gridDim.x * NWAVES, c0 = 16 * lane, head = lane >> 3;
    for (int grp = blockIdx.x * NWAVES + wave; grp < MT / 4; grp += NGW) {
        const int row0 = grp * 4, b = row0 >> 12, s0 = row0 & 4095;
#pragma unroll 1
        for (int t = 0; t < 4; ++t) {
            const size_t row = (size_t)(row0 + t);
            float l0 = lse[row * NH + head], l1 = lse[(size_t)MT * NH + row * NH + head], l2 = lse[(size_t)2 * MT * NH + row * NH + head];
            const u32x4* p0 = (const u32x4*)((const bf16*)(ws + WS_O) + row * AW + c0); const u32x4 a00 = p0[0], a01 = p0[1];
            const u32x4* p1 = (const u32x4*)((const bf16*)(ws + WS_O + 32 * MiB) + row * AW + c0); const u32x4 a10 = p1[0], a11 = p1[1];
            const u32x4* p2 = (const u32x4*)((const bf16*)(ws + WS_O + 64 * MiB) + row * AW + c0); const u32x4 a20 = p2[0], a21 = p2[1];
            const float mx = fmaxf(l0, fmaxf(l1, l2)); float w0 = __builtin_amdgcn_exp2f(l0 - mx), w1 = __builtin_amdgcn_exp2f(l1 - mx), w2 = __builtin_amdgcn_exp2f(l2 - mx);
            const float iw = 1.0f / (w0 + w1 + w2); w0 *= iw; w1 *= iw; w2 *= iw;
            float v[16], acc[16];
            unpack16(a00, a01, v);
#pragma unroll
            for (int i = 0; i < 16; ++i) acc[i] = w0 * v[i];
            unpack16(a10, a11, v);
#pragma unroll
            for (int i = 0; i < 16; ++i) acc[i] += w1 * v[i];
            unpack16(a20, a21, v);
#pragma unroll
            for (int i = 0; i < 16; ++i) acc[i] += w2 * v[i];
            float ss = 0.f;
#pragma unroll
            for (int i = 0; i < 16; ++i) ss += acc[i] * acc[i];
            const float rs = __builtin_amdgcn_rsqf(wave_sum(ss) * (1.0f / AW) + EPS);
#pragma unroll
            for (int i = 0; i < 16; i += 4) { const f32x4 g = *(const f32x4*)(a.in[I_AOG] + c0 + i); acc[i] *= rs * g[0]; acc[i + 1] *= rs * g[1]; acc[i + 2] *= rs * g[2]; acc[i + 3] *= rs * g[3]; }
            store16(MG + row * DM + c0, acc);
        }
        float cacc[4][16];
#pragma unroll
        for (int hc = 0; hc < 2; ++hc) {
            const int cc0 = c0 + 8 * hc;
            f32x2 cacc2[4][4], win[4][4]; u32x4 ring[RING];
#define CONV_ISSUE(dst, sp_) do { const int sp = (sp_); const bool ok = (sp >= 0) && (sp < SEQ); dst = *(const u32x4*)(U + ((size_t)b * SEQ + (ok ? sp : 0)) * AW + cc0); if (!ok) dst = (u32x4){0u, 0u, 0u, 0u}; } while (0)
#define CONV_UNPACK(slot, src) do { const u32x4 q0 = src; win[slot][0] = (f32x2){bf_lo(q0.x), bf_hi(q0.x)}; win[slot][1] = (f32x2){bf_lo(q0.y), bf_hi(q0.y)}; win[slot][2] = (f32x2){bf_lo(q0.z), bf_hi(q0.z)}; win[slot][3] = (f32x2){bf_lo(q0.w), bf_hi(q0.w)}; } while (0)
#pragma unroll
            for (int j = 0; j < RING; ++j) CONV_ISSUE(ring[j], s0 - 12 + j);
            { u32x4 w3; CONV_ISSUE(w3, s0 - 15); CONV_UNPACK(0, w3); CONV_ISSUE(w3, s0 - 14); CONV_UNPACK(1, w3); CONV_ISSUE(w3, s0 - 13); CONV_UNPACK(2, w3); }
#pragma unroll
            for (int t = 0; t < 4; ++t)
#pragma unroll
                for (int i = 0; i < 4; ++i) cacc2[t][i] = (f32x2){0.f, 0.f};
#pragma unroll 1
            for (int kb = 0; kb < 32; kb += RING) {
#pragma unroll
                for (int j = 0; j < RING; ++j) { const int k = kb + j;
                    if (k < CK) {
                        CONV_UNPACK((j + 3) & 3, ring[j]);
                        if (k + RING < CK) CONV_ISSUE(ring[j], s0 - 12 + k + RING);
                        f32x2 w[4];
#pragma unroll
                        for (int i = 0; i < 2; ++i) { const f32x4 wv = *(const LAS f32x4*)(lds + ((size_t)k * 1024 + cc0 + 4 * i) * 4); w[2 * i] = (f32x2){wv[0], wv[1]}; w[2 * i + 1] = (f32x2){wv[2], wv[3]}; }
#pragma unroll
                        for (int t = 0; t < 4; ++t)
#pragma unroll
                            for (int i = 0; i < 4; ++i) cacc2[t][i] = __builtin_elementwise_fma(w[i], win[(t + j) & 3][i], cacc2[t][i]);
                    } }
            }
#undef CONV_ISSUE
#undef CONV_UNPACK
#pragma unroll
            for (int t = 0; t < 4; ++t)
#pragma unroll
                for (int i = 0; i < 4; ++i) { cacc[t][8 * hc + 2 * i] = cacc2[t][i][0]; cacc[t][8 * hc + 2 * i + 1] = cacc2[t][i][1]; }
        }
        asm volatile("" ::: "memory");
        float cb[16], lg[16], lb[16], og[16];
#pragma unroll
        for (int i = 0; i < 16; i += 4) { const f32x4 x0 = *(const f32x4*)(a.in[I_CONVB] + c0 + i), x1 = *(const f32x4*)(a.in[I_LNG] + c0 + i), x2 = *(const f32x4*)(a.in[I_LNB] + c0 + i), x3 = *(const f32x4*)(a.in[I_COG] + c0 + i);
#pragma unroll
            for (int e = 0; e < 4; ++e) { cb[i + e] = x0[e]; lg[i + e] = x1[e]; lb[i + e] = x2[e]; og[i + e] = x3[e]; } }
#pragma unroll
        for (int t = 0; t < 4; ++t) {
            float sm = 0.f;
#pragma unroll
            for (int i = 0; i < 16; ++i) { cacc[t][i] += cb[i]; sm += cacc[t][i]; }
            const float mu = wave_sum(sm) * (1.0f / 1024.0f); float sv = 0.f;
#pragma unroll
            for (int i = 0; i < 16; ++i) { cacc[t][i] -= mu; sv += cacc[t][i] * cacc[t][i]; }
            const float rs = __builtin_amdgcn_rsqf(wave_sum(sv) * (1.0f / 1024.0f) + EPS); float s2 = 0.f;
#pragma unroll
            for (int i = 0; i < 16; ++i) { const float y = cacc[t][i] * rs * lg[i] + lb[i]; const float z = y * pg8::sigmoid_f(y); cacc[t][i] = z; s2 += z * z; }
            const float r2 = __builtin_amdgcn_rsqf(wave_sum(s2) * (1.0f / 1024.0f) + EPS);
#pragma unroll
            for (int i = 0; i < 16; ++i) cacc[t][i] *= r2 * og[i];
            store16(MG + (size_t)(row0 + t) * DM + 1024 + c0, cacc[t]);
        }
    }
}

#define XB_TMO      128
#define XB_XCNT(j)  (256  + 64 * (j))
#define XB_XSUB(j)  (1280 + 64 * (j))
#define XB_XGEN(j)  (2304 + 64 * (j))
#define XB_TOP      3328
#define XB_TOPGEN   3392
#define XCD_BAR_WORDS 3456
#define XB_SPIN_CAP (1u << 18)

__device__ __forceinline__ unsigned xb_ld(unsigned* p)              { return __hip_atomic_load(p, __ATOMIC_RELAXED, __HIP_MEMORY_SCOPE_AGENT); }
__device__ __forceinline__ unsigned xb_add(unsigned* p, unsigned v) { return __hip_atomic_fetch_add(p, v, __ATOMIC_RELAXED, __HIP_MEMORY_SCOPE_AGENT); }
__device__ __forceinline__ unsigned xb_xcc_id() { return (unsigned)__builtin_amdgcn_s_getreg((3 << 11) | 20) & 0xFu; }
#define XB_SPIN(cond, bar) do { unsigned _sp = 0; while (cond) { __builtin_amdgcn_s_sleep(1); \
    if ((++_sp & 255u) == 0u) { if (xb_ld(&(bar)[XB_TMO])) break; if (_sp > XB_SPIN_CAP) { atomicAdd(&(bar)[XB_TMO], 1u); break; } } } } while (0)

struct XcdBarrier {
    unsigned* bar; unsigned x;
    volatile LAS unsigned* st;
};

__device__ __forceinline__ XcdBarrier xcd_barrier_post(unsigned* bar, volatile LAS unsigned* st) {
    XcdBarrier b; b.bar = bar; b.x = xb_xcc_id(); b.st = st;
    if (threadIdx.x == 0) (void)xb_add(&bar[XB_XCNT(b.x)], 1u);
    return b;
}
__device__ __forceinline__ void xcd_barrier_complete(unsigned* bar, unsigned x, unsigned& nloc, unsigned& nx) {
    const unsigned G = gridDim.x * gridDim.y * gridDim.z;
    unsigned sum, cnt, mine, sp = 0u;
    for (;;) {
        sum = 0u; cnt = 0u; mine = 0u;
#pragma unroll
        for (unsigned j = 0; j < 16; ++j) { const unsigned c = xb_ld(&bar[XB_XCNT(j)]); sum += c; cnt += (c > 0u) ? 1u : 0u; mine = (j == x) ? c : mine; }
        if (sum == G) break;
        __builtin_amdgcn_s_sleep(1);
        if ((++sp & 255u) == 0u) { if (xb_ld(&bar[XB_TMO])) break; if (sp > XB_SPIN_CAP) { atomicAdd(&bar[XB_TMO], 1u); break; } }
    }
    nloc = mine > 0u ? mine : 1u; nx = cnt > 0u ? cnt : 1u;
}

__device__ __forceinline__ void xcd_barrier(const XcdBarrier& b) {
    asm volatile("s_waitcnt vmcnt(0)" ::: "memory");
    __syncthreads();
    if (threadIdx.x == 0) {
        unsigned* bar = b.bar;
        __builtin_amdgcn_s_waitcnt(0);
        unsigned nloc = b.st[0], nx = b.st[1];
        if (nloc == 0u) { xcd_barrier_complete(bar, b.x, nloc, nx); b.st[0] = nloc; b.st[1] = nx; }
        const unsigned old = xb_add(&bar[XB_XSUB(b.x)], 1u);
        const unsigned gen = old / nloc;
        if (old + 1u == (gen + 1u) * nloc) {
            __builtin_amdgcn_fence(__ATOMIC_RELEASE, "agent");
            asm volatile("s_waitcnt vmcnt(0)" ::: "memory");
            const unsigned og = xb_add(&bar[XB_TOP], 1u);
            const unsigned tg = og / nx;
            if (og + 1u == (tg + 1u) * nx) xb_add(&bar[XB_TOPGEN], 1u);
            else XB_SPIN(xb_ld(&bar[XB_TOPGEN]) == tg, bar);
            __builtin_amdgcn_fence(__ATOMIC_ACQUIRE, "agent");
            xb_add(&bar[XB_XGEN(b.x)], 1u);
            asm volatile("s_waitcnt vmcnt(0)" ::: "memory");
        } else {
            XB_SPIN(xb_ld(&bar[XB_XGEN(b.x)]) == gen, bar);
            __builtin_amdgcn_fence(__ATOMIC_ACQUIRE, "agent");
            asm volatile("s_waitcnt vmcnt(0)" ::: "memory");
        }
    }
    __syncthreads();
}


__global__ void __launch_bounds__(NTHR, 2) fwd_megakernel(Args a) {
    extern __shared__ __attribute__((aligned(16))) unsigned char lds_raw[];
    LAS unsigned char* lds = (LAS unsigned char*)lds_raw;
    cg::grid_group grid = cg::this_grid();
    volatile LAS unsigned* bst = (volatile LAS unsigned*)(lds + 147456 - 64);
    if (threadIdx.x < 2) bst[threadIdx.x] = 0u;
    __syncthreads();
    const XcdBarrier bar = xcd_barrier_post((unsigned*)(a.ws + WS_CTL), bst);
    const int tid0 = threadIdx.x, wave = __builtin_amdgcn_readfirstlane(tid0 >> 6), G = gridDim.x;
#define FRESH() int tid = tid0; asm volatile("" : "+v"(tid)); const int lane = tid & 63; (void)lane;
    unsigned char* ws = a.ws;
    const float* mod = (const float*)(ws + WS_MOD);
    bf16 *HB = (bf16*)(ws + WS_H), *FB = (bf16*)(ws + WS_F), *ACT = (bf16*)(ws + WS_ACT);

    { FRESH();
    p0_prologue(a, lds, tid, lane, wave);
    }
    if (a.ws == nullptr) grid.sync();
    xcd_barrier(bar);
    { FRESH();
    p0b_modreduce(a, tid);
    p0b_quant_weights(a, lds, lane, wave);
    }
    xcd_barrier(bar);
    { FRESH();
    rowpass<false, true, false, false, true>(a.in[I_X], nullptr, nullptr, HB, nullptr, nullptr, 0.f, a.in[I_F1PRE], mod + 1 * DM, mod + 0 * DM, lane, wave, (float*)(ws + WS_RMAX));
    }
    xcd_barrier(bar);
    { FRESH();
    { pg8::Gemm g{HB, (const bf16*)(ws + WS_WGU1), MT, NGU, DM / 2, DM}; pg8::StaticOrder S; S.init(MT, NGU, G, (int)blockIdx.x); S.wg = WG_GU;
      pg8::EpiSwiGLUQ E{ACT, DFF, (const float*)(ws + WS_RMAX), (const float*)(ws + WS_CMAX)};
      pg8::gemm_phase<pg8::EpiSwiGLUQ, pg8::StaticOrder, true, true, false, true>(lds, g, S, E); }
    }
    xcd_barrier(bar);
    { FRESH();
    { pg8::Gemm g{ACT, (const bf16*)(ws + WS_WD1), MT, DM, DFF}; pg8::StaticOrder S; S.init(MT, DM, G, (int)blockIdx.x); S.wg = WG_DN; pg8::EpiPlain E{FB, DM};
      pg8::gemm_phase<pg8::EpiPlain, pg8::StaticOrder, true, true>(lds, g, S, E); }
    }
    xcd_barrier(bar);
    { FRESH();
    rowpass<true, true, false, true, true>(a.in[I_X], FB, a.out, HB, a.in[I_F1POST], mod + 2 * DM, 0.5f, a.in[I_MIXPRE], mod + 4 * DM, mod + 3 * DM, lane, wave, (float*)(ws + WS_RMAX));
    }
    xcd_barrier(bar);
    { FRESH();
    { pg8::Gemm g{HB, (const bf16*)(ws + WS_WIN), MT, NIN, DM / 2, DM}; pg8::StaticOrder S; S.init(MT, NIN, G, (int)blockIdx.x); S.wg = WG_IN;
      pg8::EpiInQ E{(bf16*)(ws + WS_Q), (bf16*)(ws + WS_K), (bf16*)(ws + WS_V), (bf16*)(ws + WS_U), (const float*)(ws + WS_ROPE), 0.08838834764831845f * 1.4426950408889634f,
                    (const float*)(ws + WS_RMAX), (const float*)(ws + WS_CMAX) + 2 * NGU};
      pg8::gemm_phase<pg8::EpiInQ, pg8::StaticOrder, true, true, false, true>(lds, g, S, E); }
    }
    xcd_barrier(bar);
    { FRESH();
    attn_phase(a, lds, tid, lane, wave);
    }
    xcd_barrier(bar);
    { FRESH();
    mixpost_phase(a, lds, tid, lane, wave);
    }
    xcd_barrier(bar);
    { FRESH();
    { pg8::Gemm g{HB, (const bf16*)(ws + WS_WOUT), MT, DM, DM}; pg8::StaticOrder S; S.init(MT, DM, G, (int)blockIdx.x); S.wg = WG_DN; pg8::EpiPlain E{FB, DM};
      pg8::gemm_phase<pg8::EpiPlain, pg8::StaticOrder, true, true>(lds, g, S, E); }
    }
    xcd_barrier(bar);
    { FRESH();
    rowpass<true, true, true, true, true>(a.out, FB, ws + WS_O, HB, a.in[I_MIXPOST], mod + 5 * DM, 1.0f, a.in[I_F2PRE], mod + 7 * DM, mod + 6 * DM, lane, wave, (float*)(ws + WS_RMAX));
    }
    xcd_barrier(bar);
    { FRESH();
    { pg8::Gemm g{HB, (const bf16*)(ws + WS_WGU2), MT, NGU, DM / 2, DM}; pg8::StaticOrder S; S.init(MT, NGU, G, (int)blockIdx.x); S.wg = WG_GU;
      pg8::EpiSwiGLUQ E{ACT, DFF, (const float*)(ws + WS_RMAX), (const float*)(ws + WS_CMAX) + NGU};
      pg8::gemm_phase<pg8::EpiSwiGLUQ, pg8::StaticOrder, true, true, false, true>(lds, g, S, E); }
    }
    xcd_barrier(bar);
    { FRESH();
    { pg8::Gemm g{ACT, (const bf16*)(ws + WS_WD2), MT, DM, DFF}; pg8::StaticOrder S; S.init(MT, DM, G, (int)blockIdx.x); S.wg = WG_DN; pg8::EpiPlain E{FB, DM};
      pg8::gemm_phase<pg8::EpiPlain, pg8::StaticOrder, true, true>(lds, g, S, E); }
    }
    xcd_barrier(bar);
    { FRESH();
    rowpass<true, false, true, false>(ws + WS_O, FB, a.out, nullptr, a.in[I_F2POST], mod + 8 * DM, 0.5f, nullptr, nullptr, nullptr, lane, wave);
    }
}

extern "C" void kernel_launch(void* const* d_in, const int* in_sizes, int n_in, void* d_out, int out_size, void* d_ws, size_t ws_size, hipStream_t stream) {
    static int grid = 0;
    if (grid == 0) {
        if (n_in != 24 || out_size != MT * DM || ws_size < WS_END) { fprintf(stderr, "kernel_launch: unexpected shapes (n_in %d, out %d, ws %zu); nothing launched\n", n_in, out_size, ws_size); grid = -1; return; }
        int dev = 0, cus = 0, per_cu = 0;
        (void)hipGetDevice(&dev); (void)hipDeviceGetAttribute(&cus, hipDeviceAttributeMultiprocessorCount, dev);
        if (hipFuncSetAttribute((const void*)fwd_megakernel, hipFuncAttributeMaxDynamicSharedMemorySize, LDS_BYTES) != hipSuccess) { fprintf(stderr, "kernel_launch: hipFuncSetAttribute failed\n"); grid = -1; return; }
        if (hipOccupancyMaxActiveBlocksPerMultiprocessor(&per_cu, (const void*)fwd_megakernel, NTHR, LDS_BYTES) != hipSuccess || per_cu < 1) { fprintf(stderr, "kernel_launch: occupancy query says %d\n", per_cu); per_cu = 1; }
        (void)hipGetLastError();
        grid = cus * 1;
        if (grid <= 0) grid = 256;
    }
    if (grid < 0) return;
    if (hipMemsetAsync((char*)d_ws + WS_CTL, 0, CTL_BYTES, stream) != hipSuccess) { fprintf(stderr, "kernel_launch: memset of the barrier words failed\n"); return; }
    Args a{};
    for (int i = 0; i < 24; ++i) a.in[i] = (const float*)d_in[i];
    a.out = (float*)d_out; a.ws = (unsigned char*)d_ws;
    void* args[] = {&a};
    hipError_t e = hipLaunchCooperativeKernel((const void*)fwd_megakernel, dim3(grid), dim3(NTHR), args, LDS_BYTES, stream);
    if (e != hipSuccess) fprintf(stderr, "cooperative launch failed: %s (grid %d)\n", hipGetErrorString(e), grid);
}
```

```cpp
#include <hip/hip_runtime.h>
#include <hip/hip_cooperative_groups.h>
#include <cstdio>
#include <cstdint>
namespace cg = cooperative_groups;
namespace pg8 {
#define PG8_LAS __attribute__((address_space(3)))
typedef unsigned short bf16_t;
typedef short bf16x8 __attribute__((ext_vector_type(8)));
typedef float f32x4 __attribute__((ext_vector_type(4)));
typedef unsigned u32x4 __attribute__((ext_vector_type(4)));
constexpr int BM = 256, BK = 64, HALF = 128, HTB = HALF * BK * 2  , STAGE_BYTES = 8 * HTB, NXCD = 8, WGM = 8;

__host__ __device__ __forceinline__ int lds_byte(int r, int c) { const int st = (r >> 4) * 2 + (c >> 5), rr = r & 15, cc = c & 31, ob = rr * 64 + cc * 2; return st * 1024 + (ob ^ (((ob >> 9) & 1) << 5)); }
__host__ __device__ __forceinline__ void stage_rc(int b, int& R, int& C) { const int st = b / 1024, sb = b % 1024, swz = sb ^ (((sb >> 9) & 1) << 5); R = (st >> 1) * 16 + swz / 64; C = (st & 1) * 32 + (swz % 64) / 2; }
__host__ __device__ __forceinline__ int perm32(int rho) { const int n = rho >> 4, i = rho & 15; return 8 * (i >> 2) + 4 * n + (i & 3); }

struct Unit { int pm, pn; };
struct Gemm { const bf16_t* A; const bf16_t* Bt; int M, N, K; int ld; };

struct StaticOrder {
    int nM, nN, nwg, G, c, wg = WGM;
    __host__ __device__ void init(int M, int N, int G_, int c_) { nM = M / BM; nN = N / BM; nwg = nM * nN; G = G_; c = c_; }
    __host__ __device__ bool next(int i, Unit& u) const {
        const long L = (long)i * G + c; if (L >= nwg) return false;
        int wgid = (int)L; { const int q = nwg / NXCD, r = nwg % NXCD, xcd = wgid % NXCD, off = wgid / NXCD; wgid = (xcd < r ? xcd * (q + 1) : r * (q + 1) + (xcd - r) * q) + off; }
        const int nig = wg * nN, gid = wgid / nig, fm = gid * wg, gsz = (nM - fm) < wg ? (nM - fm) : wg;
        u.pm = fm + ((wgid % nig) % gsz); u.pn = (wgid % nig) / gsz; return true;
    }
    __device__ __forceinline__ void a_ready(const Unit&) const {}
    __device__ __forceinline__ void done(const Unit&) const {}
};

typedef float f32x2_t __attribute__((ext_vector_type(2)));
typedef __bf16 bf16x2_t __attribute__((ext_vector_type(2)));
__device__ __forceinline__ unsigned pk_bf16(float lo, float hi) { f32x2_t v = {lo, hi}; bf16x2_t b = __builtin_convertvector(v, bf16x2_t); return __builtin_bit_cast(unsigned, b); }
__device__ __forceinline__ float sigmoid_f(float x) { return __builtin_amdgcn_rcpf(1.0f + __builtin_amdgcn_exp2f(-1.44269504089f * x)); }
typedef unsigned u32x2 __attribute__((ext_vector_type(2)));

__device__ __forceinline__ void epi_plain_store(const f32x4 (&acc)[2][2][4][2], bf16_t* O, int ldc, int row0, int col0) {
#pragma unroll
    for (int ai = 0; ai < 2; ++ai)
#pragma unroll
        for (int m = 0; m < 4; ++m) {
            bf16_t* rowp = O + (size_t)(row0 + ai * HALF + m * 16) * ldc + col0;
#pragma unroll
            for (int bj = 0; bj < 2; ++bj) { const f32x4 v0 = acc[ai][bj][m][0], v1 = acc[ai][bj][m][1];
                u32x4 w; w.x = pk_bf16(v0[0], v0[1]); w.y = pk_bf16(v0[2], v0[3]); w.z = pk_bf16(v1[0], v1[1]); w.w = pk_bf16(v1[2], v1[3]);
                *(u32x4*)(rowp + bj * HALF) = w; } }
}
__device__ __forceinline__ int f2i(float x) { return __builtin_bit_cast(int, x); }
struct EpiSwiGLUQ {
    static constexpr bool PERM = false, AFTER_DRAIN = false;
    bf16_t* O; int ldc; const float* rowmax; const float* colmax;
    __device__ __forceinline__ void operator()(const f32x4 (&acc)[2][2][4][2], const Unit& u, int wr, int wc, int fr, int fq) const {
        const int row0 = u.pm * BM + wr * 64 + fr, col0 = u.pn * HALF + wc * 32 + 8 * fq, j0 = u.pn * BM + wc * 32 + 4 * fq;
        const float k2 = 1.0f / (127.0f * 127.0f);
        f32x4 cg[2], cu[2];
#pragma unroll
        for (int n = 0; n < 2; ++n) { cg[n] = *(const f32x4*)(colmax + j0 + 16 * n) * k2; cu[n] = *(const f32x4*)(colmax + j0 + HALF + 16 * n) * k2; }
#pragma unroll
        for (int ai = 0; ai < 2; ++ai)
#pragma unroll
            for (int m = 0; m < 4; ++m) {
                const int row = row0 + ai * HALF + m * 16; const float rs = rowmax[row];
                bf16_t* rowp = O + (size_t)row * ldc + col0;
                float r[8];
#pragma unroll
                for (int n = 0; n < 2; ++n)
#pragma unroll
                    for (int e = 0; e < 4; ++e) { const float ga = acc[ai][0][m][n][e], ua = acc[ai][1][m][n][e];
                        const float a = (float)f2i(ga) * (rs * cg[n][e]), b = (float)f2i(ua) * (rs * cu[n][e]);
                        r[4 * n + e] = (a * sigmoid_f(a)) * b; }
                u32x4 w; w.x = pk_bf16(r[0], r[1]); w.y = pk_bf16(r[2], r[3]); w.z = pk_bf16(r[4], r[5]); w.w = pk_bf16(r[6], r[7]);
                *(u32x4*)rowp = w; }
    }
};
struct EpiPlain {
    static constexpr bool PERM = false, AFTER_DRAIN = false;
    bf16_t* O; int ldc;
    __device__ __forceinline__ void operator()(const f32x4 (&acc)[2][2][4][2], const Unit& u, int wr, int wc, int fr, int fq) const {
        epi_plain_store(acc, O, ldc, u.pm * BM + wr * 64 + fr, u.pn * BM + wc * 32 + 8 * fq);
    }
};
struct EpiInQ {
    static constexpr bool PERM = false, AFTER_DRAIN = false;
    bf16_t *Q, *K, *V, *U; const float* rope; float qscale; const float* rowmax; const float* colmax;
    __device__ __forceinline__ void operator()(const f32x4 (&acc)[2][2][4][2], const Unit& u, int wr, int wc, int fr, int fq) const {
        const int row0 = u.pm * BM + wr * 64 + fr, jb = u.pn * BM + wc * 32 + 4 * fq, d0 = 16 * wc + 4 * fq;
        const float k2 = 1.0f / (127.0f * 127.0f);
        f32x4 cs[2][2];
#pragma unroll
        for (int bj = 0; bj < 2; ++bj)
#pragma unroll
            for (int n = 0; n < 2; ++n) cs[bj][n] = *(const f32x4*)(colmax + jb + HALF * bj + 16 * n) * k2;
        const bool isq = u.pn < 4; bf16_t* base = isq ? Q : K; const float sc = isq ? qscale : 1.0f;
#pragma unroll
        for (int ai = 0; ai < 2; ++ai)
#pragma unroll
            for (int m = 0; m < 4; ++m) { const int row = row0 + ai * HALF + m * 16, pos = row & 4095; const float rs = rowmax[row];
                float v[2][2][4];
#pragma unroll
                for (int bj = 0; bj < 2; ++bj)
#pragma unroll
                    for (int n = 0; n < 2; ++n)
#pragma unroll
                        for (int e = 0; e < 4; ++e) { const float t = acc[ai][bj][m][n][e]; v[bj][n][e] = (float)f2i(t) * (rs * cs[bj][n][e]); }
                if (u.pn >= 12) {
                    float r[8];
#pragma unroll
                    for (int n = 0; n < 2; ++n)
#pragma unroll
                        for (int e = 0; e < 4; ++e) r[4 * n + e] = v[0][n][e] * sigmoid_f(v[1][n][e]);
                    u32x4 w; w.x = pk_bf16(r[0], r[1]); w.y = pk_bf16(r[2], r[3]); w.z = pk_bf16(r[4], r[5]); w.w = pk_bf16(r[6], r[7]);
                    *(u32x4*)(U + (size_t)row * 1024 + (u.pn - 12) * HALF + wc * 32 + 8 * fq) = w;
                } else if (u.pn >= 8) {
#pragma unroll
                    for (int bj = 0; bj < 2; ++bj) { u32x4 w; w.x = pk_bf16(v[bj][0][0], v[bj][0][1]); w.y = pk_bf16(v[bj][0][2], v[bj][0][3]); w.z = pk_bf16(v[bj][1][0], v[bj][1][1]); w.w = pk_bf16(v[bj][1][2], v[bj][1][3]);
                        *(u32x4*)(V + (size_t)row * 1024 + (u.pn - 8) * BM + wc * 32 + 8 * fq + bj * HALF) = w; }
                } else {
                    const f32x4 cs0 = *(const f32x4*)(rope + ((size_t)pos * 64 + d0) * 2), cs1 = *(const f32x4*)(rope + ((size_t)pos * 64 + d0) * 2 + 4);
                    const float c[4] = {cs0[0], cs0[2], cs1[0], cs1[2]}, s[4] = {cs0[1], cs0[3], cs1[1], cs1[3]};
#pragma unroll
                    for (int bj = 0; bj < 2; ++bj) { const int head = 2 * (u.pn & 3) + bj; bf16_t* p = base + (size_t)row * 1024 + head * 128 + d0;
                        float o1[4], o2[4];
#pragma unroll
                        for (int e = 0; e < 4; ++e) { const float t1 = v[bj][0][e], t2 = v[bj][1][e]; o1[e] = (t1 * c[e] - t2 * s[e]) * sc; o2[e] = (t2 * c[e] + t1 * s[e]) * sc; }
                        u32x2 w1, w2; w1.x = pk_bf16(o1[0], o1[1]); w1.y = pk_bf16(o1[2], o1[3]); w2.x = pk_bf16(o2[0], o2[1]); w2.y = pk_bf16(o2[2], o2[3]);
                        *(u32x2*)p = w1; *(u32x2*)(p + 64) = w2; }
                } }
    }
};
typedef int i32x4 __attribute__((ext_vector_type(4)));
template <class Epi, class Sched, bool ALIGN_EPI = false, bool SP2 = false, bool I8 = false>
__device__ __forceinline__ void gemm_phase(PG8_LAS unsigned char* lds, const Gemm g, const Sched& S, const Epi& E) {
    const int tid = threadIdx.x, wid = __builtin_amdgcn_readfirstlane(tid >> 6), lane = tid & 63, wr = wid >> 2, wc = wid & 3, fr = lane & 15, fq = lane >> 4;
    const int K = g.K, nt = K / BK, LD = g.ld ? g.ld : g.K;
    unsigned voffA[2], voffB[2];
#pragma unroll
    for (int i = 0; i < 2; ++i) { int R, C; stage_rc(tid * 16 + i * 8192, R, C); const int Rb = Epi::PERM ? ((R & ~31) + perm32(R & 31)) : R;
        voffA[i] = (unsigned)(R * LD + C) * 2u; voffB[i] = (unsigned)(Rb * LD + C) * 2u; }
    const size_t kstep = (size_t)(BK * 2);
    const size_t hstep = (size_t)HALF * LD * 2;
    const size_t tstep = 2 * hstep;
    const unsigned ldsw = (unsigned)wid * 1024u;
    const int aoff = lds_byte(wr * 64 + fr, fq * 8), boff = lds_byte(wc * 32 + fr, fq * 8);
#define PG8_SA(b, h) (((b) * 2 + (h)) * HTB)
#define PG8_SB(b, h) ((4 + (b) * 2 + (h)) * HTB)
#define PG8_STAGE(bufoff, gbase, voff) do { _Pragma("unroll") for (int _i = 0; _i < 2; ++_i) \
        __builtin_amdgcn_global_load_lds((const unsigned*)((const char*)(gbase) + (voff)[_i]), (PG8_LAS unsigned*)(lds + (bufoff) + ldsw + _i * 8192), 16, 0, 0); } while (0)
#define PG8_LDA(dst, b, h) do { _Pragma("unroll") for (int m = 0; m < 4; ++m) _Pragma("unroll") for (int k = 0; k < 2; ++k) dst[m][k] = *(const PG8_LAS bf16x8*)(lds + PG8_SA(b, h) + aoff + m * 2048 + k * 1024); } while (0)
#define PG8_LDB(dst, b, h) do { _Pragma("unroll") for (int n = 0; n < 2; ++n) _Pragma("unroll") for (int k = 0; k < 2; ++k) dst[n][k] = *(const PG8_LAS bf16x8*)(lds + PG8_SB(b, h) + boff + n * 2048 + k * 1024); } while (0)
#define PG8_MMA(ai, bj, At, Bt) do { __builtin_amdgcn_s_setprio(1); \
        if constexpr (I8) { _Pragma("unroll") for (int m = 0; m < 4; ++m) _Pragma("unroll") for (int n = 0; n < 2; ++n) _Pragma("unroll") for (int k = 0; k < 2; ++k) \
            acc[ai][bj][m][n] = __builtin_bit_cast(f32x4, __builtin_amdgcn_mfma_i32_16x16x64_i8(__builtin_bit_cast(i32x4, Bt[n][k]), __builtin_bit_cast(i32x4, At[m][k]), __builtin_bit_cast(i32x4, acc[ai][bj][m][n]), 0, 0, 0)); } \
        else { _Pragma("unroll") for (int m = 0; m < 4; ++m) _Pragma("unroll") for (int n = 0; n < 2; ++n) _Pragma("unroll") for (int k = 0; k < 2; ++k) \
            acc[ai][bj][m][n] = __builtin_amdgcn_mfma_f32_16x16x32_bf16(Bt[n][k], At[m][k], acc[ai][bj][m][n], 0, 0, 0); } \
        __builtin_amdgcn_s_setprio(0); } while (0)
#define PG8_WAIT_V(n) asm volatile("s_waitcnt vmcnt(" #n ")" ::: "memory")
#define PG8_WAIT_L(n) asm volatile("s_waitcnt lgkmcnt(" #n ")" ::: "memory")
#define PG8_BAR __builtin_amdgcn_s_barrier()
#define PG8_SCHED __builtin_amdgcn_sched_barrier(0)
    Unit cur, nxt; int ui = 0;
    if (!S.next(0, cur)) return;
    f32x4 acc[2][2][4][2];
#pragma unroll
    for (int a = 0; a < 2; ++a)
#pragma unroll
        for (int b = 0; b < 2; ++b)
#pragma unroll
            for (int m = 0; m < 4; ++m)
#pragma unroll
                for (int n = 0; n < 2; ++n) acc[a][b][m][n] = (f32x4){0.f, 0.f, 0.f, 0.f};
    bf16x8 At[4][2], B0[2][2], B1[2][2];
    const char* cA = (const char*)g.A + (size_t)cur.pm * tstep; const char* cB = (const char*)g.Bt + (size_t)cur.pn * tstep;
    S.a_ready(cur);
    if constexpr (SP2) {
        PG8_STAGE(PG8_SB(0, 0), cB, voffB); PG8_STAGE(PG8_SB(0, 1), cB + hstep, voffB); PG8_STAGE(PG8_SA(0, 0), cA, voffA); PG8_STAGE(PG8_SA(0, 1), cA + hstep, voffA);
        if (wr == 1) PG8_BAR;
        PG8_WAIT_V(2); PG8_BAR;
        PG8_STAGE(PG8_SB(1, 0), cB + kstep, voffB); PG8_STAGE(PG8_SA(1, 0), cA + kstep, voffA); PG8_STAGE(PG8_SB(1, 1), cB + hstep + kstep, voffB);
        PG8_WAIT_V(6); PG8_BAR;
    } else {
        PG8_STAGE(PG8_SB(0, 0), cB, voffB); PG8_STAGE(PG8_SA(0, 0), cA, voffA); PG8_STAGE(PG8_SB(0, 1), cB + hstep, voffB); PG8_STAGE(PG8_SA(0, 1), cA + hstep, voffA);
        if (wr == 1) PG8_BAR;
        PG8_WAIT_V(4); PG8_BAR;
        PG8_STAGE(PG8_SB(1, 0), cB + kstep, voffB); PG8_STAGE(PG8_SA(1, 0), cA + kstep, voffA); PG8_STAGE(PG8_SB(1, 1), cB + hstep + kstep, voffB);
        PG8_WAIT_V(6); PG8_BAR;
    }
    for (;;) {
        const bool has_next = S.next(ui + 1, nxt);
        const char* nA = has_next ? (const char*)g.A + (size_t)nxt.pm * tstep : cA; const char* nB = has_next ? (const char*)g.Bt + (size_t)nxt.pn * tstep : cB;
        for (int t = 0; t < nt; t += 2) {
            const bool last = (t == nt - 2);
            const char* a1 = cA + (size_t)(t + 1) * kstep;
            const char* a2 = last ? nA : cA + (size_t)(t + 2) * kstep; const char* b2 = last ? nB : cB + (size_t)(t + 2) * kstep;
            const char* a3 = a2 + kstep; const char* b3 = b2 + kstep;
            if (last && has_next) S.a_ready(nxt);
            if constexpr (SP2) {
            PG8_LDB(B0, 0, 0); PG8_LDB(B1, 0, 1); PG8_SCHED; PG8_LDA(At, 0, 0); PG8_STAGE(PG8_SA(1, 1), a1 + hstep, voffA);
            PG8_WAIT_V(8); PG8_WAIT_L(0); PG8_BAR; PG8_MMA(0, 0, At, B0); PG8_MMA(0, 1, At, B1); PG8_BAR; PG8_SCHED;
            PG8_LDA(At, 0, 1); PG8_STAGE(PG8_SB(0, 0), b2, voffB); PG8_STAGE(PG8_SB(0, 1), b2 + hstep, voffB); PG8_STAGE(PG8_SA(0, 0), a2, voffA);
            PG8_WAIT_V(8); PG8_WAIT_L(0); PG8_BAR; PG8_MMA(1, 0, At, B0); PG8_MMA(1, 1, At, B1); PG8_BAR; PG8_SCHED;
            PG8_LDB(B0, 1, 0); PG8_LDB(B1, 1, 1); PG8_SCHED; PG8_LDA(At, 1, 0); PG8_STAGE(PG8_SA(0, 1), a2 + hstep, voffA);
            PG8_WAIT_V(8); PG8_WAIT_L(0); PG8_BAR; PG8_MMA(0, 0, At, B0); PG8_MMA(0, 1, At, B1); PG8_BAR; PG8_SCHED;
            PG8_LDA(At, 1, 1); PG8_STAGE(PG8_SB(1, 0), b3, voffB); PG8_STAGE(PG8_SB(1, 1), b3 + hstep, voffB); PG8_STAGE(PG8_SA(1, 0), a3, voffA);
            PG8_WAIT_V(8); PG8_WAIT_L(0); PG8_BAR; PG8_MMA(1, 0, At, B0); PG8_MMA(1, 1, At, B1); PG8_BAR; PG8_SCHED;
            } else {
            PG8_LDB(B0, 0, 0); PG8_SCHED; PG8_LDA(At, 0, 0); PG8_STAGE(PG8_SA(1, 1), a1 + hstep, voffA);
            PG8_WAIT_L(8); PG8_BAR; PG8_WAIT_L(0); PG8_MMA(0, 0, At, B0); PG8_BAR; PG8_SCHED;
            PG8_LDB(B1, 0, 1); PG8_STAGE(PG8_SB(0, 0), b2, voffB);
            PG8_BAR; PG8_WAIT_L(0); PG8_MMA(0, 1, At, B1); PG8_BAR;
            PG8_LDA(At, 0, 1); PG8_STAGE(PG8_SA(0, 0), a2, voffA);
            PG8_BAR; PG8_WAIT_L(0); PG8_MMA(1, 0, At, B0); PG8_BAR; PG8_SCHED;
            PG8_STAGE(PG8_SB(0, 1), b2 + hstep, voffB);
            PG8_WAIT_V(6); PG8_BAR; PG8_MMA(1, 1, At, B1); PG8_BAR;
            PG8_LDB(B0, 1, 0); PG8_SCHED; PG8_LDA(At, 1, 0); PG8_STAGE(PG8_SA(0, 1), a2 + hstep, voffA);
            PG8_WAIT_L(8); PG8_BAR; PG8_WAIT_L(0); PG8_MMA(0, 0, At, B0); PG8_BAR; PG8_SCHED;
            PG8_LDB(B1, 1, 1); PG8_STAGE(PG8_SB(1, 0), b3, voffB);
            PG8_BAR; PG8_WAIT_L(0); PG8_MMA(0, 1, At, B1); PG8_BAR;
            PG8_LDA(At, 1, 1); PG8_STAGE(PG8_SA(1, 0), a3, voffA);
            PG8_BAR; PG8_WAIT_L(0); PG8_MMA(1, 0, At, B0); PG8_BAR; PG8_SCHED;
            PG8_STAGE(PG8_SB(1, 1), b3 + hstep, voffB);
            PG8_WAIT_V(6); PG8_BAR; PG8_MMA(1, 1, At, B1); PG8_BAR;
            }
        }
        if constexpr (ALIGN_EPI) { if (wr == 0) PG8_BAR; }
        if constexpr (!Epi::AFTER_DRAIN) { E(acc, cur, wr, wc, fr, fq); S.done(cur); }
        if (!has_next) break;
#pragma unroll
        for (int a = 0; a < 2; ++a)
#pragma unroll
            for (int b = 0; b < 2; ++b)
#pragma unroll
                for (int m = 0; m < 4; ++m)
#pragma unroll
                    for (int n = 0; n < 2; ++n) acc[a][b][m][n] = (f32x4){0.f, 0.f, 0.f, 0.f};
        cur = nxt; cA = nA; cB = nB; ++ui;
        if constexpr (ALIGN_EPI) { if (wr == 1) PG8_BAR; }
    }
    PG8_WAIT_V(0);
    if constexpr (!ALIGN_EPI) { if (wr == 0) PG8_BAR; }
    PG8_BAR;
    if constexpr (Epi::AFTER_DRAIN) { E.fused(acc, cur, wr, wc, fr, fq, lds, wid, lane); S.done(cur); }
#undef PG8_SA
#undef PG8_SB
#undef PG8_STAGE
#undef PG8_LDA
#undef PG8_LDB
#undef PG8_MMA
#undef PG8_WAIT_V
#undef PG8_WAIT_L
#undef PG8_BAR
#undef PG8_SCHED
}
}

#define LAS __attribute__((address_space(3)))
typedef unsigned short bf16;
typedef float f32x4 __attribute__((ext_vector_type(4)));
typedef unsigned u32x4 __attribute__((ext_vector_type(4)));
typedef unsigned u32x2 __attribute__((ext_vector_type(2)));
typedef short bf16x8 __attribute__((ext_vector_type(8)));
typedef short s16x4 __attribute__((ext_vector_type(4)));
typedef float f32x2 __attribute__((ext_vector_type(2)));
constexpr int NB = 4, SEQ = 4096, DM = 2048, MT = NB * SEQ, DFF = 5632, NGU = 2 * DFF, NIN = 5120, AW = 1024, NH = 8, NMOD = 9 * DM, CK = 31;
constexpr float EPS = 1e-6f;
constexpr int NTHR = 512, NWAVES = 8;
#ifndef WG_GU
#define WG_GU 2
#endif
#ifndef WG_DN
#define WG_DN 4
#endif
#ifndef WG_IN
#define WG_IN 2
#endif
constexpr int KSPLIT = 28, NCG = NMOD / 4;
constexpr size_t MiB = 1u << 20;
constexpr size_t WS_MODP = 0, WS_MOD = 8 * MiB, WS_CTL = 8 * MiB + 512 * 1024, WS_CMAX = WS_CTL + 16384, CTL_BYTES = 16384  , WS_RMAX = WS_CTL + 131072, WS_ROPE = 9 * MiB;
constexpr size_t WS_WGU1 = 12 * MiB, WS_WD1 = 56 * MiB, WS_WIN = 78 * MiB, WS_WOUT = 98 * MiB, WS_WGU2 = 106 * MiB, WS_WD2 = 150 * MiB;
constexpr size_t WS_H = 172 * MiB, WS_F = 236 * MiB, WS_ACT = 300 * MiB;
constexpr size_t WS_Q = 300 * MiB, WS_K = 332 * MiB, WS_V = 364 * MiB, WS_U = 396 * MiB;
constexpr size_t WS_O = 476 * MiB, WS_LSE = 572 * MiB, WS_END = 574 * MiB;
static_assert((size_t)KSPLIT * 4 * NMOD * 4 <= 8 * MiB && WS_ACT + (size_t)MT * DFF * 2 <= WS_O && WS_U + 32 * MiB <= WS_O, "ws map");
constexpr int LDS_BYTES = 147456;

struct Args { const float* in[24]; float* out; unsigned char* ws; };
enum { I_X = 0, I_C, I_WADA, I_BADA, I_F1PRE, I_F1G, I_F1U, I_F1D, I_F1POST, I_MIXPRE, I_WIN, I_CONVW, I_CONVB, I_LNG, I_LNB, I_AOG, I_COG, I_WOUT, I_MIXPOST, I_F2PRE, I_F2G, I_F2U, I_F2D, I_F2POST };

__device__ __forceinline__ unsigned pk2(float lo, float hi) { return pg8::pk_bf16(lo, hi); }
__device__ __forceinline__ float bf_lo(unsigned w) { return __builtin_bit_cast(float, w << 16); }
__device__ __forceinline__ float bf_hi(unsigned w) { return __builtin_bit_cast(float, w & 0xffff0000u); }
__device__ __forceinline__ float wave_max(float v) {
#pragma unroll
    for (int o = 1; o < 64; o <<= 1) v = __builtin_fmaxf(v, __shfl_xor(v, o));
    return v;
}
__device__ __forceinline__ float wave_sum(float v) {
#pragma unroll
    for (int o = 1; o < 64; o <<= 1) v += __shfl_xor(v, o);
    return v;
}

__device__ __forceinline__ int inv_perm32(int hc) { return 16 * ((hc >> 2) & 1) + 4 * (hc >> 3) + (hc & 3); }
__device__ __forceinline__ int dest_row(int kind, int n) {
    if (kind == 0 || kind == 1) return 256 * (n >> 7) + 128 * kind + 32 * ((n & 127) >> 5) + inv_perm32(n & 31);
    if (kind == 2) return (n & ~31) + inv_perm32(n & 31);
    if (n < 2048) { const int sec = n >> 10, hh = (n >> 7) & 7, cc = n & 127, nn = cc >> 6, d = cc & 63; return sec * 1024 + hh * 128 + 32 * (d >> 4) + 16 * nn + (d & 15); }
    if (n < 3072) return (n & ~31) + inv_perm32(n & 31);
    { const int chn = (n - 3072) & 1023, isg = (n >= 4096) ? 1 : 0; return 3072 + 256 * (chn >> 7) + 128 * isg + 32 * ((chn & 127) >> 5) + inv_perm32(chn & 31); }
}
struct TrItem { const float* W; bf16* WT; int K, N, kind, kb, nb; };
__device__ __forceinline__ TrItem tr_decode(const Args& a, int it) {
    constexpr int IT_G = (DM / 64) * (DFF / 64), IT_IN = (DM / 64) * (NIN / 64), IT_OUT = (DM / 64) * (DM / 64);
    unsigned char* ws = a.ws; TrItem t; int r = it;
    auto ffn = [&](int r2, const float* g, const float* u, const float* d, size_t wgu, size_t wd) {
        const int w = r2 / IT_G; const int q = r2 - w * IT_G;
        if (w == 0) { t.W = g; t.WT = (bf16*)(ws + wgu); t.K = DM; t.N = DFF; t.kind = 0; t.kb = q / (DFF / 64); t.nb = q % (DFF / 64); }
        else if (w == 1) { t.W = u; t.WT = (bf16*)(ws + wgu); t.K = DM; t.N = DFF; t.kind = 1; t.kb = q / (DFF / 64); t.nb = q % (DFF / 64); }
        else { t.W = d; t.WT = (bf16*)(ws + wd); t.K = DFF; t.N = DM; t.kind = 2; t.kb = q / (DM / 64); t.nb = q % (DM / 64); } };
    if (r < 3 * IT_G) { ffn(r, a.in[I_F1G], a.in[I_F1U], a.in[I_F1D], WS_WGU1, WS_WD1); return t; }
    r -= 3 * IT_G;
    if (r < IT_IN) { t.W = a.in[I_WIN]; t.WT = (bf16*)(ws + WS_WIN); t.K = DM; t.N = NIN; t.kind = 3; t.kb = r / (NIN / 64); t.nb = r % (NIN / 64); return t; }
    r -= IT_IN;
    if (r < IT_OUT) { t.W = a.in[I_WOUT]; t.WT = (bf16*)(ws + WS_WOUT); t.K = DM; t.N = DM; t.kind = 2; t.kb = r / (DM / 64); t.nb = r % (DM / 64); return t; }
    r -= IT_OUT;
    ffn(r, a.in[I_F2G], a.in[I_F2U], a.in[I_F2D], WS_WGU2, WS_WD2); return t;
}
__device__ __forceinline__ void tr_load(const TrItem& t, f32x4 (&v)[16], int lane) {
    const int lr = lane >> 4, lc = lane & 15;
    const f32x4* src = (const f32x4*)(t.W + (size_t)(64 * t.kb + lr) * t.N + 64 * t.nb) + lc;
#pragma unroll
    for (int i = 0; i < 16; ++i) v[i] = __builtin_nontemporal_load(src + (size_t)i * t.N);
}
__device__ __forceinline__ unsigned pk4_i8(float a, float b, float c, float d) {
    const int ia = (int)__builtin_rintf(a), ib = (int)__builtin_rintf(b), ic = (int)__builtin_rintf(c), id = (int)__builtin_rintf(d);
    return ((unsigned)ia & 255u) | (((unsigned)ib & 255u) << 8) | (((unsigned)ic & 255u) << 16) | ((unsigned)id << 24);
}
__device__ __forceinline__ void tr_store(const TrItem& t, const f32x4 (&v)[16], LAS float* scr, int lane) {
    const int k0 = 64 * t.kb, n0 = 64 * t.nb, lr = lane >> 4, lc = lane & 15;
#pragma unroll
    for (int i = 0; i < 16; ++i) { LAS float* d = scr + (4 * i + lr) * 65 + 4 * lc; d[0] = v[i][0]; d[1] = v[i][1]; d[2] = v[i][2]; d[3] = v[i][3]; }
    const int c = lane & 7;
#pragma unroll
    for (int j = 0; j < 8; ++j) { const int nn = (lane >> 3) + 8 * j; const LAS float* s = scr + (8 * c) * 65 + nn;
        u32x4 o; o.x = pk2(s[0], s[65]); o.y = pk2(s[2 * 65], s[3 * 65]); o.z = pk2(s[4 * 65], s[5 * 65]); o.w = pk2(s[6 * 65], s[7 * 65]);
        const int dr = dest_row(t.kind, n0 + nn);
        *(u32x4*)(t.WT + (size_t)dr * t.K + k0 + 8 * c) = o; }
}
__device__ __forceinline__ void p0_prologue(const Args& a, LAS unsigned char* lds, int tid, int lane, int wave) {
    unsigned char* ws = a.ws;
    const int gtid = blockIdx.x * NTHR + tid, gw = blockIdx.x * NWAVES + wave, NGT = gridDim.x * NTHR, NGW = gridDim.x * NWAVES;
    {
        LAS float* cact = (LAS float*)lds;
        for (int i = tid; i < NB * DM; i += NTHR) { const int b = i >> 11, k = i & 2047; const float v = a.in[I_C][i]; cact[k * 4 + b] = v / (1.0f + __expf(-v)); }
        __syncthreads();
        float* part = (float*)(ws + WS_MODP);
        for (int t = gtid; t < NCG * KSPLIT; t += NGT) {
            const int ks = t / NCG, cgp = t % NCG, k0 = ks * DM / KSPLIT, k1 = (ks + 1) * DM / KSPLIT;
            const f32x4* W = (const f32x4*)a.in[I_WADA] + cgp;
            f32x4 acc0 = {0, 0, 0, 0}, acc1 = acc0, acc2 = acc0, acc3 = acc0;
#pragma unroll 8
            for (int k = k0; k < k1; ++k) { const f32x4 w = __builtin_nontemporal_load(W + (size_t)k * NCG); const f32x4 cv = *(const LAS f32x4*)(cact + 4 * k);
                acc0 += w * cv[0]; acc1 += w * cv[1]; acc2 += w * cv[2]; acc3 += w * cv[3]; }
            f32x4* pp = (f32x4*)(part + (size_t)ks * 4 * NMOD) + cgp;
            pp[0] = acc0; pp[NCG] = acc1; pp[2 * NCG] = acc2; pp[3 * NCG] = acc3;
        }
        __syncthreads();
    }
    {
        float* tab = (float*)(ws + WS_ROPE);
        for (int i = gtid; i < SEQ * 64; i += NGT) { const int pos = i >> 6, f = i & 63; const float inv = powf(10000.0f, -(float)f * (1.0f / 64.0f)); const float ang = (float)pos * inv;
            float sn, cs; sincosf(ang, &sn, &cs); tab[2 * i] = cs; tab[2 * i + 1] = sn; }
    }
    {
        LAS float* scr = (LAS float*)(lds + wave * 16640);
        constexpr int NITEMS = 6 * (DM / 64) * (DFF / 64) + (DM / 64) * (NIN / 64) + (DM / 64) * (DM / 64);
        int it = gw;
        if (it < NITEMS) {
            f32x4 va[16], vb[16];
            TrItem cur = tr_decode(a, it); tr_load(cur, va, lane);
            for (;;) {
                const int nx = it + NGW; const bool more = nx < NITEMS; TrItem nxt = cur;
                if (more) { nxt = tr_decode(a, nx); tr_load(nxt, vb, lane); }
                tr_store(cur, va, scr, lane);
                if (!more) break;
#pragma unroll
                for (int i = 0; i < 16; ++i) va[i] = vb[i];
                cur = nxt; it = nx;
            }
        }
    }
}
__device__ __forceinline__ void p0b_quant_weights(const Args& a, LAS unsigned char* lds, int lane, int wave) {
    (void)lds;
    const int NGW = gridDim.x * NWAVES;
    for (int r = blockIdx.x * NWAVES + wave; r < 2 * NGU + NIN; r += NGW) {
        const int mt = r >= 2 * NGU ? 2 : (r >= NGU ? 1 : 0), j = r - mt * NGU;
        unsigned char* rowp = a.ws + (mt == 0 ? WS_WGU1 : (mt == 1 ? WS_WGU2 : WS_WIN)) + (size_t)j * (DM * 2);
        float* cm = (float*)(a.ws + WS_CMAX) + mt * NGU;
        const u32x4* p = (const u32x4*)rowp + 4 * lane;
        u32x4 w[4]; float v[32];
#pragma unroll
        for (int i = 0; i < 4; ++i) w[i] = p[i];
#pragma unroll
        for (int i = 0; i < 4; ++i) { v[8 * i] = bf_lo(w[i].x); v[8 * i + 1] = bf_hi(w[i].x); v[8 * i + 2] = bf_lo(w[i].y); v[8 * i + 3] = bf_hi(w[i].y); v[8 * i + 4] = bf_lo(w[i].z); v[8 * i + 5] = bf_hi(w[i].z); v[8 * i + 6] = bf_lo(w[i].w); v[8 * i + 7] = bf_hi(w[i].w); }
        float mx = 0.f;
#pragma unroll
        for (int i = 0; i < 32; ++i) mx = __builtin_fmaxf(mx, __builtin_fabsf(v[i]));
        mx = __builtin_fmaxf(wave_max(mx), 1e-30f);
        const float inv = 127.0f / mx;
        u32x4 o0, o1;
        o0.x = pk4_i8(v[0] * inv, v[1] * inv, v[2] * inv, v[3] * inv); o0.y = pk4_i8(v[4] * inv, v[5] * inv, v[6] * inv, v[7] * inv); o0.z = pk4_i8(v[8] * inv, v[9] * inv, v[10] * inv, v[11] * inv); o0.w = pk4_i8(v[12] * inv, v[13] * inv, v[14] * inv, v[15] * inv);
        o1.x = pk4_i8(v[16] * inv, v[17] * inv, v[18] * inv, v[19] * inv); o1.y = pk4_i8(v[20] * inv, v[21] * inv, v[22] * inv, v[23] * inv); o1.z = pk4_i8(v[24] * inv, v[25] * inv, v[26] * inv, v[27] * inv); o1.w = pk4_i8(v[28] * inv, v[29] * inv, v[30] * inv, v[31] * inv);
        asm volatile("" ::: "memory");
        u32x4* q = (u32x4*)rowp + 2 * lane;
        q[0] = o0; q[1] = o1;
        if (lane == 0) cm[j] = mx;
    }
}
__device__ __forceinline__ void p0b_modreduce(const Args& a, int tid) {
    const float* part = (const float*)(a.ws + WS_MODP); float* mod = (float*)(a.ws + WS_MOD);
    for (int i = blockIdx.x * NTHR + tid; i < NB * NMOD; i += gridDim.x * NTHR) { const int n = i % NMOD; float s = a.in[I_BADA][n];
#pragma unroll 4
        for (int ks = 0; ks < KSPLIT; ++ks) s += part[(size_t)ks * 4 * NMOD + i];
        mod[i] = s; }
}

template <bool XIN16> struct XRow { u32x4 w[XIN16 ? 4 : 8]; };
template <bool XIN16> __device__ __forceinline__ void xrow_load(XRow<XIN16>& r, const void* xin, size_t row, int lane) {
    if (XIN16) {
#pragma unroll
        for (int j = 0; j < 4; ++j) r.w[j] = __builtin_nontemporal_load((const u32x4*)((const bf16*)xin + row * DM + 8 * (lane + 64 * j)));
    } else {
#pragma unroll
        for (int j = 0; j < 4; ++j) { const u32x4* p = (const u32x4*)((const float*)xin + row * DM + 8 * (lane + 64 * j)); r.w[2 * j] = __builtin_nontemporal_load(p); r.w[2 * j + 1] = __builtin_nontemporal_load(p + 1); }
    }
}
template <bool XIN16> __device__ __forceinline__ void xrow_unpack(const XRow<XIN16>& r, f32x4 (&x)[8]) {
    if (XIN16) {
#pragma unroll
        for (int j = 0; j < 4; ++j) { const u32x4 w = r.w[j]; x[2 * j] = (f32x4){bf_lo(w.x), bf_hi(w.x), bf_lo(w.y), bf_hi(w.y)}; x[2 * j + 1] = (f32x4){bf_lo(w.z), bf_hi(w.z), bf_lo(w.w), bf_hi(w.w)}; }
    } else {
#pragma unroll
        for (int q = 0; q < 8; ++q) x[q] = __builtin_bit_cast(f32x4, r.w[q]);
    }
}
template <bool HAS_RES, bool HAS_H, bool XIN16, bool XOUT16, bool HQ8 = false>
__device__ __forceinline__ void rowpass(const void* xin, const bf16* f, void* xout, bf16* hout, const float* post_g, const float* gate, float coef,
                                        const float* pre_g, const float* sc, const float* sh, int lane, int wave, float* rowmax = nullptr) {
    const int NGW = gridDim.x * NWAVES;
    for (int grp = blockIdx.x * NWAVES + wave; grp < MT / 8; grp += NGW) {
        const int r0 = grp * 8, b = r0 >> 12;
        f32x4 A[8], Bm[8];
#pragma unroll
        for (int j = 0; j < 4; ++j)
#pragma unroll
            for (int hh = 0; hh < 2; ++hh) { const int col = 8 * (lane + 64 * j) + 4 * hh;
                if (HAS_RES) { const f32x4 g = *(const f32x4*)(gate + (size_t)b * NMOD + col), pg = *(const f32x4*)(post_g + col); A[2 * j + hh] = g * pg * coef; }
                if (HAS_H) { const f32x4 s = *(const f32x4*)(sc + (size_t)b * NMOD + col), pg = *(const f32x4*)(pre_g + col); Bm[2 * j + hh] = pg * (s + 1.0f); }
            }
        XRow<XIN16> xc, xn; u32x4 fc[4], fn[4];
        xrow_load<XIN16>(xc, xin, (size_t)r0, lane);
        if (HAS_RES) {
#pragma unroll
            for (int j = 0; j < 4; ++j) fc[j] = __builtin_nontemporal_load((const u32x4*)(f + (size_t)r0 * DM + 8 * (lane + 64 * j)));
        }
#pragma unroll 1
        for (int rr = 0; rr < 8; ++rr) {
            const size_t row = (size_t)(r0 + rr);
            { const size_t rn = rr < 7 ? row + 1 : row;
              xrow_load<XIN16>(xn, xin, rn, lane);
              if (HAS_RES) {
#pragma unroll
                  for (int j = 0; j < 4; ++j) fn[j] = __builtin_nontemporal_load((const u32x4*)(f + rn * DM + 8 * (lane + 64 * j)));
              } }
            f32x4 x[8]; xrow_unpack<XIN16>(xc, x);
            if (HAS_RES) {
                float ss = 0.f;
#pragma unroll
                for (int j = 0; j < 4; ++j)
#pragma unroll
                    for (int e = 0; e < 4; ++e) { const float lo = bf_lo(fc[j][e]), hi = bf_hi(fc[j][e]); ss += lo * lo + hi * hi; }
                const float r1 = __builtin_amdgcn_rsqf(wave_sum(ss) * (1.0f / DM) + EPS);
#pragma unroll
                for (int j = 0; j < 4; ++j) { const u32x4 w = fc[j];
                    x[2 * j] += A[2 * j] * (f32x4){bf_lo(w.x), bf_hi(w.x), bf_lo(w.y), bf_hi(w.y)} * r1; x[2 * j + 1] += A[2 * j + 1] * (f32x4){bf_lo(w.z), bf_hi(w.z), bf_lo(w.w), bf_hi(w.w)} * r1; }
                if (XOUT16) {
#pragma unroll
                    for (int j = 0; j < 4; ++j) { u32x4 w; w.x = pk2(x[2 * j][0], x[2 * j][1]); w.y = pk2(x[2 * j][2], x[2 * j][3]); w.z = pk2(x[2 * j + 1][0], x[2 * j + 1][1]); w.w = pk2(x[2 * j + 1][2], x[2 * j + 1][3]);
                        *(u32x4*)((bf16*)xout + row * DM + 8 * (lane + 64 * j)) = w;
                        x[2 * j] = (f32x4){bf_lo(w.x), bf_hi(w.x), bf_lo(w.y), bf_hi(w.y)}; x[2 * j + 1] = (f32x4){bf_lo(w.z), bf_hi(w.z), bf_lo(w.w), bf_hi(w.w)}; }
                } else {
#pragma unroll
                    for (int j = 0; j < 4; ++j) { f32x4* p = (f32x4*)((float*)xout + row * DM + 8 * (lane + 64 * j)); p[0] = x[2 * j]; p[1] = x[2 * j + 1]; }
                }
            }
            if (HAS_H) {
                float ss = 0.f;
#pragma unroll
                for (int q = 0; q < 8; ++q) ss += (x[q][0] * x[q][0] + x[q][1] * x[q][1]) + (x[q][2] * x[q][2] + x[q][3] * x[q][3]);
                const float r2 = __builtin_amdgcn_rsqf(wave_sum(ss) * (1.0f / DM) + EPS);
                if (HQ8) {
                    float mx = 0.f;
#pragma unroll
                    for (int j = 0; j < 4; ++j) { const f32x4* shp = (const f32x4*)(sh + (size_t)b * NMOD + 8 * (lane + 64 * j));
                        x[2 * j] = x[2 * j] * r2 * Bm[2 * j] + shp[0]; x[2 * j + 1] = x[2 * j + 1] * r2 * Bm[2 * j + 1] + shp[1]; }
#pragma unroll
                    for (int q = 0; q < 8; ++q)
#pragma unroll
                        for (int e = 0; e < 4; ++e) mx = __builtin_fmaxf(mx, __builtin_fabsf(x[q][e]));
                    mx = __builtin_fmaxf(wave_max(mx), 1e-30f);
                    const float inv = 127.0f / mx;
#pragma unroll
                    for (int j = 0; j < 4; ++j) { u32x2 w; w.x = pk4_i8(x[2 * j][0] * inv, x[2 * j][1] * inv, x[2 * j][2] * inv, x[2 * j][3] * inv);
                        w.y = pk4_i8(x[2 * j + 1][0] * inv, x[2 * j + 1][1] * inv, x[2 * j + 1][2] * inv, x[2 * j + 1][3] * inv);
                        *(u32x2*)((unsigned char*)hout + row * (DM * 2) + 8 * (lane + 64 * j)) = w; }
                    if (lane == 0) rowmax[row] = mx;
                } else {
#pragma unroll
                for (int j = 0; j < 4; ++j) { const f32x4* shp = (const f32x4*)(sh + (size_t)b * NMOD + 8 * (lane + 64 * j));
                    const f32x4 h0 = x[2 * j] * r2 * Bm[2 * j] + shp[0], h1 = x[2 * j + 1] * r2 * Bm[2 * j + 1] + shp[1];
                    u32x4 w; w.x = pk2(h0[0], h0[1]); w.y = pk2(h0[2], h0[3]); w.z = pk2(h1[0], h1[1]); w.w = pk2(h1[2], h1[3]);
                    *(u32x4*)(hout + row * DM + 8 * (lane + 64 * j)) = w; }
                }
            }
            xc = xn;
            if (HAS_RES) {
#pragma unroll
                for (int j = 0; j < 4; ++j) fc[j] = fn[j];
            }
        }
    }
}

__device__ __forceinline__ unsigned swz(unsigned row, unsigned ch) { return 256u * row + 16u * (ch ^ (((row & 7u) << 1) | ((row >> 3) & 1u))); }
__device__ __forceinline__ s16x4 vtr(const LAS unsigned char* p) { return __builtin_bit_cast(s16x4, __builtin_amdgcn_ds_read_tr16_b64_v4i16((LAS s16x4*)p)); }
struct AttnItem { int dsh, b, h, r, m0; size_t obase; };
__device__ __forceinline__ AttnItem attn_decode(int idx) {
    AttnItem it; const int p = idx >> 10, rem = idx & 1023, t = rem & 31; it.b = rem >> 8; it.h = (rem >> 5) & 7; it.dsh = 2 * p;
    const int ngrp = (SEQ >> it.dsh) >> 7; it.r = t / ngrp; it.m0 = (t % ngrp) * 128; it.obase = (size_t)p; return it;
}
__device__ __forceinline__ void attn_issue(const AttnItem& it, const bf16* __restrict__ Kb, const bf16* __restrict__ Vb, int tid, u32x4 (&kreg)[8], u32x4 (&vreg)[8]) {
    const int ch = tid & 15, rr = tid >> 4, L = SEQ >> it.dsh;
    const size_t bh = (size_t)it.b * SEQ * AW + (size_t)it.h * 128 + 8 * ch;
#pragma unroll
    for (int i = 0; i < 8; ++i) { int km = it.m0 - 64 + 32 * i + rr; km = km < 0 ? 0 : (km > L - 1 ? L - 1 : km); const size_t off = bh + (size_t)((km << it.dsh) + it.r) * AW;
        kreg[i] = *(const u32x4*)(Kb + off); vreg[i] = *(const u32x4*)(Vb + off); }
}
__device__ __forceinline__ void attn_phase(const Args& a, LAS unsigned char* lds, int tid, int lane, int wave) {
    unsigned char* ws = a.ws;
    const bf16 *Q = (const bf16*)(ws + WS_Q), *Kb = (const bf16*)(ws + WS_K), *Vb = (const bf16*)(ws + WS_V);
    LAS unsigned char* kimg = lds; LAS unsigned char* vimg = lds + 65536;
    const int fr = lane & 15, fq = lane >> 4, G = gridDim.x;
    const unsigned q4 = (unsigned)(lane & 15) >> 2, p4 = (unsigned)lane & 3u;
    constexpr int NITEM = 3 * NB * NH * 32;
    const bool xcd_order = (G == 256);
    const int istep = xcd_order ? 32 : G;
    int idx = xcd_order ? ((int)(blockIdx.x & 7) * (NITEM / 8) + (int)(blockIdx.x >> 3)) : (int)blockIdx.x;
    const int iend = xcd_order ? ((int)(blockIdx.x & 7) + 1) * (NITEM / 8) : NITEM;
    if (idx >= iend) return;
    u32x4 kreg[8], vreg[8];
    AttnItem it = attn_decode(idx);
    attn_issue(it, Kb, Vb, tid, kreg, vreg);
    for (;;) {
        const int L = SEQ >> it.dsh, m0 = it.m0 + 16 * wave;
        const size_t bh = (size_t)it.b * SEQ * AW + (size_t)it.h * 128;
        const int qpos = ((m0 + fr) << it.dsh) + it.r;
        bf16x8 qf[4];
        { const bf16x8* qp = (const bf16x8*)(Q + bh + (size_t)qpos * AW) + fq;
#pragma unroll
          for (int kk = 0; kk < 4; ++kk) qf[kk] = qp[4 * kk]; }
        __syncthreads();
        { const unsigned ch = tid & 15, rr = tid >> 4;
#pragma unroll
          for (int i = 0; i < 8; ++i) { const unsigned o = swz(32u * i + rr, ch); *(LAS u32x4*)(kimg + o) = kreg[i]; *(LAS u32x4*)(vimg + o) = vreg[i]; } }
        __syncthreads();
        const int nidx = idx + istep; const bool has_next = nidx < iend;
        AttnItem nit = it;
        if (has_next) { nit = attn_decode(nidx); attn_issue(nit, Kb, Vb, tid, kreg, vreg); }
        f32x4 s[10];
        const unsigned wrow = 16u * wave;
#pragma unroll
        for (int blk = 0; blk < 9; ++blk) {
            f32x4 acc = {0.f, 0.f, 0.f, 0.f};
#pragma unroll
            for (int kk = 0; kk < 4; ++kk) { const bf16x8 kf = *(const LAS bf16x8*)(kimg + swz(wrow + 16u * blk + fr, 4u * kk + fq)); acc = __builtin_amdgcn_mfma_f32_16x16x32_bf16(kf, qf[kk], acc, 0, 0, 0); }
            s[blk] = acc;
        }
        float mx = -1e30f;
#pragma unroll
        for (int j = 0; j < 4; ++j) { s[0][j] = (4 * fq + j - fr >= 0) ? s[0][j] : -1e30f; s[8][j] = (4 * fq + j - fr <= 0) ? s[8][j] : -1e30f; }
        if (m0 < 64 || m0 + 80 > L) {
#pragma unroll
            for (int blk = 0; blk < 9; ++blk)
#pragma unroll
                for (int j = 0; j < 4; ++j) { const int km = m0 - 64 + 16 * blk + 4 * fq + j; s[blk][j] = (km >= 0 && km < L) ? s[blk][j] : -1e30f; }
        }
#pragma unroll
        for (int blk = 0; blk < 9; ++blk)
#pragma unroll
            for (int j = 0; j < 4; ++j) mx = fmaxf(mx, s[blk][j]);
        mx = fmaxf(mx, __shfl_xor(mx, 16)); mx = fmaxf(mx, __shfl_xor(mx, 32));
        float l = 0.f;
#pragma unroll
        for (int blk = 0; blk < 9; ++blk)
#pragma unroll
            for (int j = 0; j < 4; ++j) { const float p = __builtin_amdgcn_exp2f(s[blk][j] - mx); s[blk][j] = p; l += p; }
        s[9] = (f32x4){0.f, 0.f, 0.f, 0.f};
        l += __shfl_xor(l, 16); l += __shfl_xor(l, 32);
        f32x4 o[8];
#pragma unroll
        for (int c = 0; c < 8; ++c) o[c] = (f32x4){0.f, 0.f, 0.f, 0.f};
#pragma unroll
        for (int ks = 0; ks < 5; ++ks) {
            u32x4 pw; pw.x = pk2(s[2 * ks][0], s[2 * ks][1]); pw.y = pk2(s[2 * ks][2], s[2 * ks][3]); pw.z = pk2(s[2 * ks + 1][0], s[2 * ks + 1][1]); pw.w = pk2(s[2 * ks + 1][2], s[2 * ks + 1][3]);
            const bf16x8 pb = __builtin_bit_cast(bf16x8, pw);
            const unsigned r0 = wrow + 32u * ks + 4u * fq + q4, r1 = (ks == 4) ? r0 : r0 + 16u;
#pragma unroll
            for (int c = 0; c < 8; ++c) {
                const s16x4 a0 = vtr(vimg + swz(r0, 2u * c + (p4 >> 1)) + 8u * (p4 & 1u));
                const s16x4 a1 = vtr(vimg + swz(r1, 2u * c + (p4 >> 1)) + 8u * (p4 & 1u));
                const bf16x8 av = {a0[0], a0[1], a0[2], a0[3], a1[0], a1[1], a1[2], a1[3]};
                o[c] = __builtin_amdgcn_mfma_f32_16x16x32_bf16(av, pb, o[c], 0, 0, 0);
            }
        }
        const float inv = 1.0f / l;
        bf16* op = (bf16*)(ws + WS_O + it.obase * 32 * MiB) + bh + (size_t)qpos * AW + 4 * fq;
#pragma unroll
        for (int c = 0; c < 8; ++c) { u32x2 w; w.x = pk2(o[c][0] * inv, o[c][1] * inv); w.y = pk2(o[c][2] * inv, o[c][3] * inv); *(u32x2*)(op + 16 * c) = w; }
        if (fq == 0) ((float*)(ws + WS_LSE) + it.obase * MT * NH)[((size_t)it.b * SEQ + qpos) * NH + it.h] = mx + __log2f(l);
        if (!has_next) break;
        it = nit; idx = nidx;
    }
}

__device__ __forceinline__ void unpack16(const u32x4 a, const u32x4 b, float* v) {
    v[0] = bf_lo(a.x); v[1] = bf_hi(a.x); v[2] = bf_lo(a.y); v[3] = bf_hi(a.y); v[4] = bf_lo(a.z); v[5] = bf_hi(a.z); v[6] = bf_lo(a.w); v[7] = bf_hi(a.w);
    v[8] = bf_lo(b.x); v[9] = bf_hi(b.x); v[10] = bf_lo(b.y); v[11] = bf_hi(b.y); v[12] = bf_lo(b.z); v[13] = bf_hi(b.z); v[14] = bf_lo(b.w); v[15] = bf_hi(b.w);
}
__device__ __forceinline__ void store16(bf16* p, const float* v) {
    u32x4 a, b; a.x = pk2(v[0], v[1]); a.y = pk2(v[2], v[3]); a.z = pk2(v[4], v[5]); a.w = pk2(v[6], v[7]); b.x = pk2(v[8], v[9]); b.y = pk2(v[10], v[11]); b.z = pk2(v[12], v[13]); b.w = pk2(v[14], v[15]);
    ((u32x4*)p)[0] = a; ((u32x4*)p)[1] = b;
}
#ifndef RING
#define RING 4
#endif
__device__ __forceinline__ void mixpost_phase(const Args& a, LAS unsigned char* lds, int tid, int lane, int wave) {
    unsigned char* ws = a.ws;
    for (int i = tid; i < CK * 1024 / 4; i += NTHR) ((LAS f32x4*)lds)[i] = ((const f32x4*)a.in[I_CONVW])[i];
    __syncthreads();
    const bf16* U = (const bf16*)(ws + WS_U); bf16* MG = (bf16*)(ws + WS_H);
    const float* lse = (const float*)(ws + WS_LSE);
    const int NGW = gridDim.x * NWAVES, c0 = 16 * lane, head = lane >> 3;
    for (int grp = blockIdx.x * NWAVES + wave; grp < MT / 4; grp += NGW) {
        const int row0 = grp * 4, b = row0 >> 12, s0 = row0 & 4095;
#pragma unroll 1
        for (int t = 0; t < 4; ++t) {
            const size_t row = (size_t)(row0 + t);
            float l0 = lse[row * NH + head], l1 = lse[(size_t)MT * NH + row * NH + head], l2 = lse[(size_t)2 * MT * NH + row * NH + head];
            const u32x4* p0 = (const u32x4*)((const bf16*)(ws + WS_O) + row * AW + c0); const u32x4 a00 = p0[0], a01 = p0[1];
            const u32x4* p1 = (const u32x4*)((const bf16*)(ws + WS_O + 32 * MiB) + row * AW + c0); const u32x4 a10 = p1[0], a11 = p1[1];
            const u32x4* p2 = (const u32x4*)((const bf16*)(ws + WS_O + 64 * MiB) + row * AW + c0); const u32x4 a20 = p2[0], a21 = p2[1];
            const float mx = fmaxf(l0, fmaxf(l1, l2)); float w0 = __builtin_amdgcn_exp2f(l0 - mx), w1 = __builtin_amdgcn_exp2f(l1 - mx), w2 = __builtin_amdgcn_exp2f(l2 - mx);
            const float iw = 1.0f / (w0 + w1 + w2); w0 *= iw; w1 *= iw; w2 *= iw;
            float v[16], acc[16];
            unpack16(a00, a01, v);
#pragma unroll
            for (int i = 0; i < 16; ++i) acc[i] = w0 * v[i];
            unpack16(a10, a11, v);
#pragma unroll
            for (int i = 0; i < 16; ++i) acc[i] += w1 * v[i];
            unpack16(a20, a21, v);
#pragma unroll
            for (int i = 0; i < 16; ++i) acc[i] += w2 * v[i];
            float ss = 0.f;
#pragma unroll
            for (int i = 0; i < 16; ++i) ss += acc[i] * acc[i];
            const float rs = __builtin_amdgcn_rsqf(wave_sum(ss) * (1.0f / AW) + EPS);
#pragma unroll
            for (int i = 0; i < 16; i += 4) { const f32x4 g = *(const f32x4*)(a.in[I_AOG] + c0 + i); acc[i] *= rs * g[0]; acc[i + 1] *= rs * g[1]; acc[i + 2] *= rs * g[2]; acc[i + 3] *= rs * g[3]; }
            store16(MG + row * DM + c0, acc);
        }
        float cacc[4][16];
#pragma unroll
        for (int hc = 0; hc < 2; ++hc) {
            const int cc0 = c0 + 8 * hc;
            f32x2 cacc2[4][4], win[4][4]; u32x4 ring[RING];
#define CONV_ISSUE(dst, sp_) do { const int sp = (sp_); const bool ok = (sp >= 0) && (sp < SEQ); dst = *(const u32x4*)(U + ((size_t)b * SEQ + (ok ? sp : 0)) * AW + cc0); if (!ok) dst = (u32x4){0u, 0u, 0u, 0u}; } while (0)
#define CONV_UNPACK(slot, src) do { const u32x4 q0 = src; win[slot][0] = (f32x2){bf_lo(q0.x), bf_hi(q0.x)}; win[slot][1] = (f32x2){bf_lo(q0.y), bf_hi(q0.y)}; win[slot][2] = (f32x2){bf_lo(q0.z), bf_hi(q0.z)}; win[slot][3] = (f32x2){bf_lo(q0.w), bf_hi(q0.w)}; } while (0)
#pragma unroll
            for (int j = 0; j < RING; ++j) CONV_ISSUE(ring[j], s0 - 12 + j);
            { u32x4 w3; CONV_ISSUE(w3, s0 - 15); CONV_UNPACK(0, w3); CONV_ISSUE(w3, s0 - 14); CONV_UNPACK(1, w3); CONV_ISSUE(w3, s0 - 13); CONV_UNPACK(2, w3); }
#pragma unroll
            for (int t = 0; t < 4; ++t)
#pragma unroll
                for (int i = 0; i < 4; ++i) cacc2[t][i] = (f32x2){0.f, 0.f};
#pragma unroll 1
            for (int kb = 0; kb < 32; kb += RING) {
#pragma unroll
                for (int j = 0; j < RING; ++j) { const int k = kb + j;
                    if (k < CK) {
                        CONV_UNPACK((j + 3) & 3, ring[j]);
                        if (k + RING < CK) CONV_ISSUE(ring[j], s0 - 12 + k + RING);
                        f32x2 w[4];
#pragma unroll
                        for (int i = 0; i < 2; ++i) { const f32x4 wv = *(const LAS f32x4*)(lds + ((size_t)k * 1024 + cc0 + 4 * i) * 4); w[2 * i] = (f32x2){wv[0], wv[1]}; w[2 * i + 1] = (f32x2){wv[2], wv[3]}; }
#pragma unroll
                        for (int t = 0; t < 4; ++t)
#pragma unroll
                            for (int i = 0; i < 4; ++i) cacc2[t][i] = __builtin_elementwise_fma(w[i], win[(t + j) & 3][i], cacc2[t][i]);
                    } }
            }
#undef CONV_ISSUE
#undef CONV_UNPACK
#pragma unroll
            for (int t = 0; t < 4; ++t)
#pragma unroll
                for (int i = 0; i < 4; ++i) { cacc[t][8 * hc + 2 * i] = cacc2[t][i][0]; cacc[t][8 * hc + 2 * i + 1] = cacc2[t][i][1]; }
        }
        asm volatile("" ::: "memory");
        float cb[16], lg[16], lb[16], og[16];
#pragma unroll
        for (int i = 0; i < 16; i += 4) { const f32x4 x0 = *(const f32x4*)(a.in[I_CONVB] + c0 + i), x1 = *(const f32x4*)(a.in[I_LNG] + c0 + i), x2 = *(const f32x4*)(a.in[I_LNB] + c0 + i), x3 = *(const f32x4*)(a.in[I_COG] + c0 + i);
#pragma unroll
            for (int e = 0; e < 4; ++e) { cb[i + e] = x0[e]; lg[i + e] = x1[e]; lb[i + e] = x2[e]; og[i + e] = x3[e]; } }
#pragma unroll
        for (int t = 0; t < 4; ++t) {
            float sm = 0.f;
#pragma unroll
            for (int i = 0; i < 16; ++i) { cacc[t][i] += cb[i]; sm += cacc[t][i]; }
            const float mu = wave_sum(sm) * (1.0f / 1024.0f); float sv = 0.f;
#pragma unroll
            for (int i = 0; i < 16; ++i) { cacc[t][i] -= mu; sv += cacc[t][i] * cacc[t][i]; }
            const float rs = __builtin_amdgcn_rsqf(wave_sum(sv) * (1.0f / 1024.0f) + EPS); float s2 = 0.f;
#pragma unroll
            for (int i = 0; i < 16; ++i) { const float y = cacc[t][i] * rs * lg[i] + lb[i]; const float z = y * pg8::sigmoid_f(y); cacc[t][i] = z; s2 += z * z; }
            const float r2 = __builtin_amdgcn_rsqf(wave_sum(s2) * (1.0f / 1024.0f) + EPS);
#pragma unroll
            for (int i = 0; i < 16; ++i) cacc[t][i] *= r2 * og[i];
            store16(MG + (size_t)(row0 + t) * DM + 1024 + c0, cacc[t]);
        }
    }
}

#define XB_TMO      128
#define XB_XCNT(j)  (256  + 64 * (j))
#define XB_XSUB(j)  (1280 + 64 * (j))
#define XB_XGEN(j)  (2304 + 64 * (j))
#define XB_TOP      3328
#define XB_TOPGEN   3392
#define XCD_BAR_WORDS 3456
#define XB_SPIN_CAP (1u << 18)

__device__ __forceinline__ unsigned xb_ld(unsigned* p)              { return __hip_atomic_load(p, __ATOMIC_RELAXED, __HIP_MEMORY_SCOPE_AGENT); }
__device__ __forceinline__ unsigned xb_add(unsigned* p, unsigned v) { return __hip_atomic_fetch_add(p, v, __ATOMIC_RELAXED, __HIP_MEMORY_SCOPE_AGENT); }
__device__ __forceinline__ unsigned xb_xcc_id() { return (unsigned)__builtin_amdgcn_s_getreg((3 << 11) | 20) & 0xFu; }
#define XB_SPIN(cond, bar) do { unsigned _sp = 0; while (cond) { __builtin_amdgcn_s_sleep(1); \
    if ((++_sp & 255u) == 0u) { if (xb_ld(&(bar)[XB_TMO])) break; if (_sp > XB_SPIN_CAP) { atomicAdd(&(bar)[XB_TMO], 1u); break; } } } } while (0)

struct XcdBarrier {
    unsigned* bar; unsigned x;
    volatile LAS unsigned* st;
};

__device__ __forceinline__ XcdBarrier xcd_barrier_post(unsigned* bar, volatile LAS unsigned* st) {
    XcdBarrier b; b.bar = bar; b.x = xb_xcc_id(); b.st = st;
    if (threadIdx.x == 0) (void)xb_add(&bar[XB_XCNT(b.x)], 1u);
    return b;
}
__device__ __forceinline__ void xcd_barrier_complete(unsigned* bar, unsigned x, unsigned& nloc, unsigned& nx) {
    const unsigned G = gridDim.x * gridDim.y * gridDim.z;
    unsigned sum, cnt, mine, sp = 0u;
    for (;;) {
        sum = 0u; cnt = 0u; mine = 0u;
#pragma unroll
        for (unsigned j = 0; j < 16; ++j) { const unsigned c = xb_ld(&bar[XB_XCNT(j)]); sum += c; cnt += (c > 0u) ? 1u : 0u; mine = (j == x) ? c : mine; }
        if (sum == G) break;
        __builtin_amdgcn_s_sleep(1);
        if ((++sp & 255u) == 0u) { if (xb_ld(&bar[XB_TMO])) break; if (sp > XB_SPIN_CAP) { atomicAdd(&bar[XB_TMO], 1u); break; } }
    }
    nloc = mine > 0u ? mine : 1u; nx = cnt > 0u ? cnt : 1u;
}

__device__ __forceinline__ void xcd_barrier(const XcdBarrier& b) {
    asm volatile("s_waitcnt vmcnt(0)" ::: "memory");
    __syncthreads();
    if (threadIdx.x == 0) {
        unsigned* bar = b.bar;
        __builtin_amdgcn_s_waitcnt(0);
        unsigned nloc = b.st[0], nx = b.st[1];
        if (nloc == 0u) { xcd_barrier_complete(bar, b.x, nloc, nx); b.st[0] = nloc; b.st[1] = nx; }
        const unsigned old = xb_add(&bar[XB_XSUB(b.x)], 1u);
        const unsigned gen = old / nloc;
        if (old + 1u == (gen + 1u) * nloc) {
            __builtin_amdgcn_fence(__ATOMIC_RELEASE, "agent");
            asm volatile("s_waitcnt vmcnt(0)" ::: "memory");
            const unsigned og = xb_add(&bar[XB_TOP], 1u);
            const unsigned tg = og / nx;
            if (og + 1u == (tg + 1u) * nx) xb_add(&bar[XB_TOPGEN], 1u);
            else XB_SPIN(xb_ld(&bar[XB_TOPGEN]) == tg, bar);
            __builtin_amdgcn_fence(__ATOMIC_ACQUIRE, "agent");
            xb_add(&bar[XB_XGEN(b.x)], 1u);
            asm volatile("s_waitcnt vmcnt(0)" ::: "memory");
        } else {
            XB_SPIN(xb_ld(&bar[XB_XGEN(b.x)]) == gen, bar);
            __builtin_amdgcn_fence(__ATOMIC_ACQUIRE, "agent");
            asm volatile("s_waitcnt vmcnt(0)" ::: "memory");
        }
    }
    __syncthreads();
}


__global__ void __launch_bounds__(NTHR, 2) fwd_megakernel(Args a) {
    extern __shared__ __attribute__((aligned(16))) unsigned char lds_raw[];
    LAS unsigned char* lds = (LAS unsigned char*)lds_raw;
    cg::grid_group grid = cg::this_grid();
    volatile LAS unsigned* bst = (volatile LAS unsigned*)(lds + 147456 - 64);
    if (threadIdx.x < 2) bst[threadIdx.x] = 0u;
    __syncthreads();
    const XcdBarrier bar = xcd_barrier_post((unsigned*)(a.ws + WS_CTL), bst);
    const int tid0 = threadIdx.x, wave = __builtin_amdgcn_readfirstlane(tid0 >> 6), G = gridDim.x;
#define FRESH() int tid = tid0; asm volatile("" : "+v"(tid)); const int lane = tid & 63; (void)lane;
    unsigned char* ws = a.ws;
    const float* mod = (const float*)(ws + WS_MOD);
    bf16 *HB = (bf16*)(ws + WS_H), *FB = (bf16*)(ws + WS_F), *ACT = (bf16*)(ws + WS_ACT);

    { FRESH();
    p0_prologue(a, lds, tid, lane, wave);
    }
    if (a.ws == nullptr) grid.sync();
    xcd_barrier(bar);
    { FRESH();
    p0b_modreduce(a, tid);
    p0b_quant_weights(a, lds, lane, wave);
    }
    xcd_barrier(bar);
    { FRESH();
    rowpass<false, true, false, false, true>(a.in[I_X], nullptr, nullptr, HB, nullptr, nullptr, 0.f, a.in[I_F1PRE], mod + 1 * DM, mod + 0 * DM, lane, wave, (float*)(ws + WS_RMAX));
    }
    xcd_barrier(bar);
    { FRESH();
    { pg8::Gemm g{HB, (const bf16*)(ws + WS_WGU1), MT, NGU, DM / 2, DM}; pg8::StaticOrder S; S.init(MT, NGU, G, (int)blockIdx.x); S.wg = WG_GU;
      pg8::EpiSwiGLUQ E{ACT, DFF, (const float*)(ws + WS_RMAX), (const float*)(ws + WS_CMAX)};
      pg8::gemm_phase<pg8::EpiSwiGLUQ, pg8::StaticOrder, true, true, true>(lds, g, S, E); }
    }
    xcd_barrier(bar);
    { FRESH();
    { pg8::Gemm g{ACT, (const bf16*)(ws + WS_WD1), MT, DM, DFF}; pg8::StaticOrder S; S.init(MT, DM, G, (int)blockIdx.x); S.wg = WG_DN; pg8::EpiPlain E{FB, DM};
      pg8::gemm_phase<pg8::EpiPlain, pg8::StaticOrder, true, true>(lds, g, S, E); }
    }
    xcd_barrier(bar);
    { FRESH();
    rowpass<true, true, false, true, true>(a.in[I_X], FB, a.out, HB, a.in[I_F1POST], mod + 2 * DM, 0.5f, a.in[I_MIXPRE], mod + 4 * DM, mod + 3 * DM, lane, wave, (float*)(ws + WS_RMAX));
    }
    xcd_barrier(bar);
    { FRESH();
    { pg8::Gemm g{HB, (const bf16*)(ws + WS_WIN), MT, NIN, DM / 2, DM}; pg8::StaticOrder S; S.init(MT, NIN, G, (int)blockIdx.x); S.wg = WG_IN;
      pg8::EpiInQ E{(bf16*)(ws + WS_Q), (bf16*)(ws + WS_K), (bf16*)(ws + WS_V), (bf16*)(ws + WS_U), (const float*)(ws + WS_ROPE), 0.08838834764831845f * 1.4426950408889634f,
                    (const float*)(ws + WS_RMAX), (const float*)(ws + WS_CMAX) + 2 * NGU};
      pg8::gemm_phase<pg8::EpiInQ, pg8::StaticOrder, true, true, true>(lds, g, S, E); }
    }
    xcd_barrier(bar);
    { FRESH();
    attn_phase(a, lds, tid, lane, wave);
    }
    xcd_barrier(bar);
    { FRESH();
    mixpost_phase(a, lds, tid, lane, wave);
    }
    xcd_barrier(bar);
    { FRESH();
    { pg8::Gemm g{HB, (const bf16*)(ws + WS_WOUT), MT, DM, DM}; pg8::StaticOrder S; S.init(MT, DM, G, (int)blockIdx.x); S.wg = WG_DN; pg8::EpiPlain E{FB, DM};
      pg8::gemm_phase<pg8::EpiPlain, pg8::StaticOrder, true, true>(lds, g, S, E); }
    }
    xcd_barrier(bar);
    { FRESH();
    rowpass<true, true, true, true, true>(a.out, FB, ws + WS_O, HB, a.in[I_MIXPOST], mod + 5 * DM, 1.0f, a.in[I_F2PRE], mod + 7 * DM, mod + 6 * DM, lane, wave, (float*)(ws + WS_RMAX));
    }
    xcd_barrier(bar);
    { FRESH();
    { pg8::Gemm g{HB, (const bf16*)(ws + WS_WGU2), MT, NGU, DM / 2, DM}; pg8::StaticOrder S; S.init(MT, NGU, G, (int)blockIdx.x); S.wg = WG_GU;
      pg8::EpiSwiGLUQ E{ACT, DFF, (const float*)(ws + WS_RMAX), (const float*)(ws + WS_CMAX) + NGU};
      pg8::gemm_phase<pg8::EpiSwiGLUQ, pg8::StaticOrder, true, true, true>(lds, g, S, E); }
    }
    xcd_barrier(bar);
    { FRESH();
    { pg8::Gemm g{ACT, (const bf16*)(ws + WS_WD2), MT, DM, DFF}; pg8::StaticOrder S; S.init(MT, DM, G, (int)blockIdx.x); S.wg = WG_DN; pg8::EpiPlain E{FB, DM};
      pg8::gemm_phase<pg8::EpiPlain, pg8::StaticOrder, true, true>(lds, g, S, E); }
    }
    xcd_barrier(bar);
    { FRESH();
    rowpass<true, false, true, false>(ws + WS_O, FB, a.out, nullptr, a.in[I_F2POST], mod + 8 * DM, 0.5f, nullptr, nullptr, nullptr, lane, wave);
    }
}

extern "C" void kernel_launch(void* const* d_in, const int* in_sizes, int n_in, void* d_out, int out_size, void* d_ws, size_t ws_size, hipStream_t stream) {
    static int grid = 0;
    if (grid == 0) {
        if (n_in != 24 || out_size != MT * DM || ws_size < WS_END) { fprintf(stderr, "kernel_launch: unexpected shapes (n_in %d, out %d, ws %zu); nothing launched\n", n_in, out_size, ws_size); grid = -1; return; }
        int dev = 0, cus = 0, per_cu = 0;
        (void)hipGetDevice(&dev); (void)hipDeviceGetAttribute(&cus, hipDeviceAttributeMultiprocessorCount, dev);
        if (hipFuncSetAttribute((const void*)fwd_megakernel, hipFuncAttributeMaxDynamicSharedMemorySize, LDS_BYTES) != hipSuccess) { fprintf(stderr, "kernel_launch: hipFuncSetAttribute failed\n"); grid = -1; return; }
        if (hipOccupancyMaxActiveBlocksPerMultiprocessor(&per_cu, (const void*)fwd_megakernel, NTHR, LDS_BYTES) != hipSuccess || per_cu < 1) { fprintf(stderr, "kernel_launch: occupancy query says %d\n", per_cu); per_cu = 1; }
        (void)hipGetLastError();
        grid = cus * 1;
        if (grid <= 0) grid = 256;
    }
    if (grid < 0) return;
    if (hipMemsetAsync((char*)d_ws + WS_CTL, 0, CTL_BYTES, stream) != hipSuccess) { fprintf(stderr, "kernel_launch: memset of the barrier words failed\n"); return; }
    Args a{};
    for (int i = 0; i < 24; ++i) a.in[i] = (const float*)d_in[i];
    a.out = (float*)d_out; a.ws = (unsigned char*)d_ws;
    void* args[] = {&a};
    hipError_t e = hipLaunchCooperativeKernel((const void*)fwd_megakernel, dim3(grid), dim3(NTHR), args, LDS_BYTES, stream);
    if (e != hipSuccess) fprintf(stderr, "cooperative launch failed: %s (grid %d)\n", hipGetErrorString(e), grid);
}
```
